# Optimizing an MI355X kernel written in HIP

```python
import math
import jax, jax.numpy as jnp
from jax import lax
import numpy as np


D_MODEL = 1024
BATCH = 16
SEQ = 2048
DEPTH = 1

ATT_HEADS = 8
ATT_HEAD_DIM = 64
IDX_HEADS = 8
IDX_DIM = 64
TOPK_MAX = 256
Q_BLOCK = 128
ML_HEADS = 4
ML_HEAD_DIM = 128
ML_CHUNK = 64
CONV_WIDTH = 4
D_FF = 4 * D_MODEL
PLE_DIM = 256
ROPE_THETA = 10000.0
LN_EPS = 1e-5
DEEPNORM_ALPHA = (2.0 * DEPTH) ** 0.25
DEEPNORM_BETA = (8.0 * DEPTH) ** -0.25
IDX_W_SCALE = (IDX_HEADS ** -0.5) * (IDX_DIM ** -0.5)

ATT_W = ATT_HEADS * ATT_HEAD_DIM
IDX_QW = IDX_HEADS * IDX_DIM
ML_W = ML_HEADS * ML_HEAD_DIM
SPLIT_SPEC = (
    ('att_q', ATT_W), ('att_k', ATT_HEAD_DIM), ('att_v', ATT_HEAD_DIM),
    ('idx_q', IDX_QW), ('idx_k', IDX_DIM), ('idx_w', IDX_HEADS),
    ('ml_q', ML_W), ('ml_k', ML_W), ('ml_v', ML_W),
    ('ml_i', ML_HEADS), ('ml_f', ML_HEADS), ('ml_o', ML_W),
    ('gate_a', D_MODEL), ('gate_b', D_MODEL),
)
SPLIT_NAMES = tuple(n for n, _ in SPLIT_SPEC)
SPLIT_OFFSETS = tuple(int(o) for o in np.cumsum([w for _, w in SPLIT_SPEC])[:-1])
W_IN_COLS = sum(w for _, w in SPLIT_SPEC)

kernel_name = 'hybrid_dsa_mlstm_block'


def layer_norm(x, g, b):
    xf = x.astype(jnp.float32)
    mu = jnp.mean(xf, axis=-1, keepdims=True)
    var = jnp.mean(jnp.square(xf - mu), axis=-1, keepdims=True)
    y = (xf - mu) * lax.rsqrt(var + LN_EPS) * g.astype(jnp.float32) + b.astype(jnp.float32)
    return y.astype(x.dtype)


def rope_tables(positions, dim):
    inv_freq = 1.0 / (ROPE_THETA ** (jnp.arange(0, dim, 2, dtype=jnp.float32) / dim))
    ang = positions.astype(jnp.float32)[..., None] * inv_freq
    return jnp.cos(ang), jnp.sin(ang)


def apply_rope(x, cos, sin):
    xf = x.astype(jnp.float32)
    x1, x2 = jnp.split(xf, 2, axis=-1)
    c = cos[:, :, None, :]
    s = sin[:, :, None, :]
    return jnp.concatenate([x1 * c - x2 * s, x2 * c + x1 * s], axis=-1).astype(x.dtype)


def dsa_attention(q, k, v, qi, ki, wi):
    B, S = q.shape[0], q.shape[1]
    k_sel = min(TOPK_MAX, S // 4)
    nb = S // Q_BLOCK
    kv = jnp.concatenate([k, v], axis=-1)
    ki32 = ki.astype(jnp.float32)
    key_pos = jnp.arange(S)

    def to_blocks(a):
        return jnp.moveaxis(a.reshape((B, nb, Q_BLOCK) + a.shape[2:]), 1, 0)

    def block(args):
        qb, qib, wb, t0 = args
        tq = t0 + jnp.arange(Q_BLOCK)
        causal = key_pos[None, :] <= tq[:, None]
        logits = jnp.einsum('bthd,bsd->bths', qib.astype(jnp.float32), ki32)
        score = jnp.einsum('bths,bth->bts', jax.nn.relu(logits), wb.astype(jnp.float32) * IDX_W_SCALE)
        score = jnp.where(causal[None], score, -jnp.inf)
        _, idx = lax.top_k(score, k_sel)
        kvg = jax.vmap(lambda a, i: a[i])(kv, idx)
        kg, vg = jnp.split(kvg, 2, axis=-1)
        valid = idx <= tq[None, :, None]
        s = jnp.einsum('bthd,btkd->bthk', qb, kg).astype(jnp.float32) * (ATT_HEAD_DIM ** -0.5)
        s = jnp.where(valid[:, :, None, :], s, -jnp.inf)
        pr = jax.nn.softmax(s, axis=-1)
        return jnp.einsum('bthk,btkd->bthd', pr.astype(vg.dtype), vg)

    out = lax.map(block, (to_blocks(q), to_blocks(qi), to_blocks(wi), jnp.arange(nb) * Q_BLOCK))
    return jnp.moveaxis(out, 0, 1).reshape(B, S, ATT_W)


def causal_dwconv(x, w, b):
    C = x.shape[-1]
    y = lax.conv_general_dilated(x, w[:, None, :], window_strides=(1,), padding=[(CONV_WIDTH - 1, 0)],
                                 dimension_numbers=('NWC', 'WIO', 'NWC'), feature_group_count=C)
    return y + b


def mlstm(q, k, v, i_pre, f_pre):
    B, S, H, d = q.shape
    L = ML_CHUNK
    nc = S // L

    def chunks4(a):
        return a.astype(jnp.float32).reshape(B, nc, L, H, d).transpose(1, 0, 3, 2, 4)

    def chunks3(a):
        return a.astype(jnp.float32).reshape(B, nc, L, H).transpose(1, 0, 3, 2)

    log_f = jax.nn.log_sigmoid(f_pre.astype(jnp.float32))
    tril = jnp.tril(jnp.ones((L, L), dtype=bool))

    def step(carry, xs):
        C, n, m = carry
        qc, kc, vc, ic, lfc = xs
        b = jnp.cumsum(lfc, axis=-1)
        dmat = b[..., :, None] - b[..., None, :] + ic[..., None, :]
        dmat = jnp.where(tril, dmat, -jnp.inf)
        inter = b + m[..., None]
        m_row = jnp.maximum(jnp.max(dmat, axis=-1), inter)
        w_intra = jnp.exp(dmat - m_row[..., None])
        w_inter = jnp.exp(inter - m_row)
        s = jnp.einsum('bhld,bhsd->bhls', qc, kc) * w_intra
        num = w_inter[..., None] * jnp.einsum('bhld,bhde->bhle', qc, C) + jnp.einsum('bhls,bhse->bhle', s, vc)
        den = w_inter * jnp.einsum('bhld,bhd->bhl', qc, n) + jnp.sum(s, axis=-1)
        h = num / jnp.maximum(jnp.abs(den), jnp.exp(-m_row))[..., None]
        b_last = b[..., -1]
        g = b_last[..., None] - b + ic
        m_new = jnp.maximum(b_last + m, jnp.max(g, axis=-1))
        w_k = jnp.exp(g - m_new[..., None])
        decay = jnp.exp(b_last + m - m_new)
        C = decay[..., None, None] * C + jnp.einsum('bhs,bhsd,bhse->bhde', w_k, kc, vc)
        n = decay[..., None] * n + jnp.einsum('bhs,bhsd->bhd', w_k, kc)
        return (C, n, m_new), h

    init = (jnp.zeros((B, H, d, d), jnp.float32), jnp.zeros((B, H, d), jnp.float32), jnp.zeros((B, H), jnp.float32))
    _, hs = lax.scan(step, init, (chunks4(q), chunks4(k), chunks4(v), chunks3(i_pre), chunks3(log_f)))
    return hs.transpose(1, 0, 3, 2, 4).reshape(B, S, H, d)


def head_norm(h, g):
    mu = jnp.mean(h, axis=-1, keepdims=True)
    var = jnp.mean(jnp.square(h - mu), axis=-1, keepdims=True)
    return (h - mu) * lax.rsqrt(var + LN_EPS) * g.astype(jnp.float32).reshape(ML_HEADS, ML_HEAD_DIM)


def setup_inputs(seed: int = 0) -> dict:
    key = jax.random.key(seed)
    ks = jax.random.split(key, 24)
    f32 = jnp.float32
    nrm = lambda k, shape, scale: jax.random.normal(k, shape, f32) * scale
    offsets = jax.random.randint(ks[2], (BATCH,), 0, 4096, dtype=jnp.int32)
    positions = offsets[:, None] + jnp.arange(SEQ, dtype=jnp.int32)[None, :]
    b_f = jnp.broadcast_to(jnp.linspace(3.0, 6.0, ML_HEADS, dtype=f32), (DEPTH, ML_HEADS))
    return {
        'x': nrm(ks[0], (BATCH, SEQ, D_MODEL), 1.0),
        'p': nrm(ks[1], (DEPTH, BATCH, SEQ, PLE_DIM), 1.0),
        'positions': positions,
        'w_in': nrm(ks[3], (DEPTH, D_MODEL, W_IN_COLS), D_MODEL ** -0.5),
        'conv_w': nrm(ks[4], (DEPTH, CONV_WIDTH, 2 * ML_W), CONV_WIDTH ** -0.5),
        'conv_b': nrm(ks[5], (DEPTH, 2 * ML_W), 0.01),
        'b_igate': nrm(ks[6], (DEPTH, ML_HEADS), 0.1),
        'b_fgate': b_f + nrm(ks[7], (DEPTH, ML_HEADS), 0.1),
        'ml_norm_g': 1.0 + nrm(ks[8], (DEPTH, ML_W), 0.02),
        'w_up_a': nrm(ks[9], (DEPTH, ATT_W, D_MODEL), ATT_W ** -0.5),
        'w_up_b': nrm(ks[10], (DEPTH, ML_W, D_MODEL), ML_W ** -0.5),
        'w_out': nrm(ks[11], (DEPTH, D_MODEL, D_MODEL), D_MODEL ** -0.5 * DEEPNORM_BETA),
        'ln1_g': 1.0 + nrm(ks[12], (DEPTH, D_MODEL), 0.02),
        'ln1_b': nrm(ks[13], (DEPTH, D_MODEL), 0.02),
        'w_ff1': nrm(ks[14], (DEPTH, D_MODEL, D_FF), D_MODEL ** -0.5),
        'w_ff2': nrm(ks[15], (DEPTH, D_FF, D_MODEL), D_FF ** -0.5 * DEEPNORM_BETA),
        'w_ple_gate': nrm(ks[16], (DEPTH, D_MODEL, D_MODEL), D_MODEL ** -0.5),
        'w_ple_proj': nrm(ks[17], (DEPTH, PLE_DIM, D_MODEL), PLE_DIM ** -0.5 * DEEPNORM_BETA),
        'ln2_g': 1.0 + nrm(ks[18], (DEPTH, D_MODEL), 0.02),
        'ln2_b': nrm(ks[19], (DEPTH, D_MODEL), 0.02),
    }


def reference(x, p, positions, w_in, conv_w, conv_b, b_igate, b_fgate, ml_norm_g, w_up_a, w_up_b, w_out,
              ln1_g, ln1_b, w_ff1, w_ff2, w_ple_gate, w_ple_proj, ln2_g, ln2_b):
    B, S, _ = x.shape
    cos_a, sin_a = rope_tables(positions, ATT_HEAD_DIM)
    cos_i, sin_i = rope_tables(positions, IDX_DIM)
    h = x
    for l in range(DEPTH):
        parts = dict(zip(SPLIT_NAMES, jnp.split(h @ w_in[l], SPLIT_OFFSETS, axis=-1)))
        q_a = apply_rope(parts['att_q'].reshape(B, S, ATT_HEADS, ATT_HEAD_DIM), cos_a, sin_a)
        k_a = apply_rope(parts['att_k'][:, :, None, :], cos_a, sin_a)[:, :, 0]
        q_i = apply_rope(parts['idx_q'].reshape(B, S, IDX_HEADS, IDX_DIM), cos_i, sin_i)
        k_i = apply_rope(parts['idx_k'][:, :, None, :], cos_i, sin_i)[:, :, 0]
        y_a = dsa_attention(q_a, k_a, parts['att_v'], q_i, k_i, parts['idx_w'])
        qk = jax.nn.silu(causal_dwconv(jnp.concatenate([parts['ml_q'], parts['ml_k']], axis=-1), conv_w[l], conv_b[l]))
        mq, mk = jnp.split(qk, 2, axis=-1)
        mq = mq.reshape(B, S, ML_HEADS, ML_HEAD_DIM)
        mk = mk.reshape(B, S, ML_HEADS, ML_HEAD_DIM) * (ML_HEAD_DIM ** -0.5)
        mv = parts['ml_v'].reshape(B, S, ML_HEADS, ML_HEAD_DIM)
        hm = mlstm(mq, mk, mv, parts['ml_i'] + b_igate[l], parts['ml_f'] + b_fgate[l])
        hm = head_norm(hm, ml_norm_g[l]).reshape(B, S, ML_W).astype(x.dtype)
        y_b = jax.nn.sigmoid(parts['ml_o']) * hm
        merged = jax.nn.sigmoid(parts['gate_a']) * (y_a @ w_up_a[l]) + jax.nn.sigmoid(parts['gate_b']) * (y_b @ w_up_b[l])
        h = layer_norm(DEEPNORM_ALPHA * h + merged @ w_out[l], ln1_g[l], ln1_b[l])
        ff = jnp.square(jax.nn.relu(h @ w_ff1[l])) @ w_ff2[l]
        r = DEEPNORM_ALPHA * h + ff
        r = r + jax.nn.sigmoid(r @ w_ple_gate[l]) * (p[l] @ w_ple_proj[l])
        h = layer_norm(r, ln2_g[l], ln2_b[l])
    return h
```

```cpp
#include <hip/hip_runtime.h>
#include <hip/hip_cooperative_groups.h>
#include <cstdio>
#include <cstdint>
namespace cg = cooperative_groups;
#define MK_ONE 1
namespace pg8 {
#define PG8_LAS __attribute__((address_space(3)))
typedef unsigned short bf16_t;
typedef short bf16x8 __attribute__((ext_vector_type(8)));
typedef float f32x4 __attribute__((ext_vector_type(4)));
typedef unsigned u32x4 __attribute__((ext_vector_type(4)));
constexpr int BM = 256, BK = 64, HALF = 128, HTB = HALF * BK * 2  , STAGE_BYTES = 8 * HTB, NXCD = 8, WGM = 8;

__host__ __device__ __forceinline__ int lds_byte(int r, int c) { const int st = (r >> 4) * 2 + (c >> 5), rr = r & 15, cc = c & 31, ob = rr * 64 + cc * 2; return st * 1024 + (ob ^ (((ob >> 9) & 1) << 5)); }
__host__ __device__ __forceinline__ void stage_rc(int b, int& R, int& C) { const int st = b / 1024, sb = b % 1024, swz = sb ^ (((sb >> 9) & 1) << 5); R = (st >> 1) * 16 + swz / 64; C = (st & 1) * 32 + (swz % 64) / 2; }
__host__ __device__ __forceinline__ int perm32(int rho) { const int n = rho >> 4, i = rho & 15; return 8 * (i >> 2) + 4 * n + (i & 3); }

struct Unit { int pm, pn; };
struct Gemm { const bf16_t* A; const bf16_t* Bt; int M, N, K; };

struct StaticOrder {
    int nM, nN, nwg, G, c;
    __host__ __device__ void init(int M, int N, int G_, int c_) { nM = M / BM; nN = N / BM; nwg = nM * nN; G = G_; c = c_; }
    __host__ __device__ bool next(int i, Unit& u) const {
        const long L = (long)i * G + c; if (L >= nwg) return false;
        int wgid = (int)L; { const int q = nwg / NXCD, r = nwg % NXCD, xcd = wgid % NXCD, off = wgid / NXCD; wgid = (xcd < r ? xcd * (q + 1) : r * (q + 1) + (xcd - r) * q) + off; }
        const int nig = WGM * nN, gid = wgid / nig, fm = gid * WGM, gsz = (nM - fm) < WGM ? (nM - fm) : WGM;
        u.pm = fm + ((wgid % nig) % gsz); u.pn = (wgid % nig) / gsz; return true;
    }
    __device__ __forceinline__ void a_ready(const Unit&) const {}
    __device__ __forceinline__ void done(const Unit&) const {}
};

__device__ __forceinline__ unsigned cvt_pk_bf16(float lo, float hi) { unsigned r; asm volatile("v_cvt_pk_bf16_f32 %0, %1, %2" : "=v"(r) : "v"(lo), "v"(hi)); return r; }
template <class Epi, class Sched, bool ALIGN_EPI = false, bool SP2 = false>
__device__ __forceinline__ void gemm_phase(PG8_LAS unsigned char* lds, const Gemm g, const Sched& S, const Epi& E) {
    const int tid = threadIdx.x, wid = __builtin_amdgcn_readfirstlane(tid >> 6), lane = tid & 63, wr = wid >> 2, wc = wid & 3, fr = lane & 15, fq = lane >> 4;
    const int K = g.K, nt = K / BK;
    unsigned voffA[2], voffB[2];
#pragma unroll
    for (int i = 0; i < 2; ++i) { int R, C; stage_rc(tid * 16 + i * 8192, R, C); const int Rb = Epi::PERM ? ((R & ~31) + perm32(R & 31)) : R;
        voffA[i] = (unsigned)(R * K + C) * 2u; voffB[i] = (unsigned)(Rb * K + C) * 2u; }
    const size_t kstep = (size_t)(BK * 2);
    const size_t hstep = (size_t)HALF * K * 2;
    const size_t tstep = 2 * hstep;
    const unsigned ldsw = (unsigned)wid * 1024u;
    const int aoff = lds_byte(wr * 64 + fr, fq * 8), boff = lds_byte(wc * 32 + fr, fq * 8);
#define PG8_SA(b, h) (((b) * 2 + (h)) * HTB)
#define PG8_SB(b, h) ((4 + (b) * 2 + (h)) * HTB)
#define PG8_STAGE(bufoff, gbase, voff) do { _Pragma("unroll") for (int _i = 0; _i < 2; ++_i) \
        __builtin_amdgcn_global_load_lds((const unsigned*)((const char*)(gbase) + (voff)[_i]), (PG8_LAS unsigned*)(lds + (bufoff) + ldsw + _i * 8192), 16, 0, 0); } while (0)
#define PG8_LDA(dst, b, h) do { _Pragma("unroll") for (int m = 0; m < 4; ++m) _Pragma("unroll") for (int k = 0; k < 2; ++k) dst[m][k] = *(const PG8_LAS bf16x8*)(lds + PG8_SA(b, h) + aoff + m * 2048 + k * 1024); } while (0)
#define PG8_LDB(dst, b, h) do { _Pragma("unroll") for (int n = 0; n < 2; ++n) _Pragma("unroll") for (int k = 0; k < 2; ++k) dst[n][k] = *(const PG8_LAS bf16x8*)(lds + PG8_SB(b, h) + boff + n * 2048 + k * 1024); } while (0)
#define PG8_MMA(ai, bj, At, Bt) do { __builtin_amdgcn_s_setprio(1); _Pragma("unroll") for (int m = 0; m < 4; ++m) _Pragma("unroll") for (int n = 0; n < 2; ++n) _Pragma("unroll") for (int k = 0; k < 2; ++k) \
        acc[ai][bj][m][n] = __builtin_amdgcn_mfma_f32_16x16x32_bf16(Bt[n][k], At[m][k], acc[ai][bj][m][n], 0, 0, 0); __builtin_amdgcn_s_setprio(0); } while (0)
#define PG8_WAIT_V(n) asm volatile("s_waitcnt vmcnt(" #n ")" ::: "memory")
#define PG8_WAIT_L(n) asm volatile("s_waitcnt lgkmcnt(" #n ")" ::: "memory")
#define PG8_BAR __builtin_amdgcn_s_barrier()
#define PG8_SCHED __builtin_amdgcn_sched_barrier(0)
    Unit cur, nxt; int ui = 0;
    if (!S.next(0, cur)) return;
    f32x4 acc[2][2][4][2];
#pragma unroll
    for (int a = 0; a < 2; ++a)
#pragma unroll
        for (int b = 0; b < 2; ++b)
#pragma unroll
            for (int m = 0; m < 4; ++m)
#pragma unroll
                for (int n = 0; n < 2; ++n) acc[a][b][m][n] = (f32x4){0.f, 0.f, 0.f, 0.f};
    bf16x8 At[4][2], B0[2][2], B1[2][2];
    const char* cA = (const char*)g.A + (size_t)cur.pm * tstep; const char* cB = (const char*)g.Bt + (size_t)cur.pn * tstep;
    S.a_ready(cur);
    if constexpr (SP2) {
        PG8_STAGE(PG8_SB(0, 0), cB, voffB); PG8_STAGE(PG8_SB(0, 1), cB + hstep, voffB); PG8_STAGE(PG8_SA(0, 0), cA, voffA); PG8_STAGE(PG8_SA(0, 1), cA + hstep, voffA);
        if (wr == 1) PG8_BAR;
        PG8_WAIT_V(2); PG8_BAR;
        PG8_STAGE(PG8_SB(1, 0), cB + kstep, voffB); PG8_STAGE(PG8_SA(1, 0), cA + kstep, voffA); PG8_STAGE(PG8_SB(1, 1), cB + hstep + kstep, voffB);
        PG8_WAIT_V(6); PG8_BAR;
    } else {
        PG8_STAGE(PG8_SB(0, 0), cB, voffB); PG8_STAGE(PG8_SA(0, 0), cA, voffA); PG8_STAGE(PG8_SB(0, 1), cB + hstep, voffB); PG8_STAGE(PG8_SA(0, 1), cA + hstep, voffA);
        if (wr == 1) PG8_BAR;
        PG8_WAIT_V(4); PG8_BAR;
        PG8_STAGE(PG8_SB(1, 0), cB + kstep, voffB); PG8_STAGE(PG8_SA(1, 0), cA + kstep, voffA); PG8_STAGE(PG8_SB(1, 1), cB + hstep + kstep, voffB);
        PG8_WAIT_V(6); PG8_BAR;
    }
    for (;;) {
        const bool has_next = S.next(ui + 1, nxt);
        const char* nA = has_next ? (const char*)g.A + (size_t)nxt.pm * tstep : cA; const char* nB = has_next ? (const char*)g.Bt + (size_t)nxt.pn * tstep : cB;
        for (int t = 0; t < nt; t += 2) {
            const bool last = (t == nt - 2);
            const char* a1 = cA + (size_t)(t + 1) * kstep;
            const char* a2 = last ? nA : cA + (size_t)(t + 2) * kstep; const char* b2 = last ? nB : cB + (size_t)(t + 2) * kstep;
            const char* a3 = a2 + kstep; const char* b3 = b2 + kstep;
            if (last && has_next) S.a_ready(nxt);
            if constexpr (SP2) {
            PG8_LDB(B0, 0, 0); PG8_LDB(B1, 0, 1); PG8_SCHED; PG8_LDA(At, 0, 0); PG8_STAGE(PG8_SA(1, 1), a1 + hstep, voffA);
            PG8_WAIT_V(8); PG8_WAIT_L(0); PG8_BAR; PG8_MMA(0, 0, At, B0); PG8_MMA(0, 1, At, B1); PG8_BAR; PG8_SCHED;
            PG8_LDA(At, 0, 1); PG8_STAGE(PG8_SB(0, 0), b2, voffB); PG8_STAGE(PG8_SB(0, 1), b2 + hstep, voffB); PG8_STAGE(PG8_SA(0, 0), a2, voffA);
            PG8_WAIT_V(8); PG8_WAIT_L(0); PG8_BAR; PG8_MMA(1, 0, At, B0); PG8_MMA(1, 1, At, B1); PG8_BAR; PG8_SCHED;
            PG8_LDB(B0, 1, 0); PG8_LDB(B1, 1, 1); PG8_SCHED; PG8_LDA(At, 1, 0); PG8_STAGE(PG8_SA(0, 1), a2 + hstep, voffA);
            PG8_WAIT_V(8); PG8_WAIT_L(0); PG8_BAR; PG8_MMA(0, 0, At, B0); PG8_MMA(0, 1, At, B1); PG8_BAR; PG8_SCHED;
            PG8_LDA(At, 1, 1); PG8_STAGE(PG8_SB(1, 0), b3, voffB); PG8_STAGE(PG8_SB(1, 1), b3 + hstep, voffB); PG8_STAGE(PG8_SA(1, 0), a3, voffA);
            PG8_WAIT_V(8); PG8_WAIT_L(0); PG8_BAR; PG8_MMA(1, 0, At, B0); PG8_MMA(1, 1, At, B1); PG8_BAR; PG8_SCHED;
            } else {
            PG8_LDB(B0, 0, 0); PG8_SCHED; PG8_LDA(At, 0, 0); PG8_STAGE(PG8_SA(1, 1), a1 + hstep, voffA);
            PG8_WAIT_L(8); PG8_BAR; PG8_WAIT_L(0); PG8_MMA(0, 0, At, B0); PG8_BAR; PG8_SCHED;
            PG8_LDB(B1, 0, 1); PG8_STAGE(PG8_SB(0, 0), b2, voffB);
            PG8_BAR; PG8_WAIT_L(0); PG8_MMA(0, 1, At, B1); PG8_BAR;
            PG8_LDA(At, 0, 1); PG8_STAGE(PG8_SA(0, 0), a2, voffA);
            PG8_BAR; PG8_WAIT_L(0); PG8_MMA(1, 0, At, B0); PG8_BAR; PG8_SCHED;
            PG8_STAGE(PG8_SB(0, 1), b2 + hstep, voffB);
            PG8_WAIT_V(6); PG8_BAR; PG8_MMA(1, 1, At, B1); PG8_BAR;
            PG8_LDB(B0, 1, 0); PG8_SCHED; PG8_LDA(At, 1, 0); PG8_STAGE(PG8_SA(0, 1), a2 + hstep, voffA);
            PG8_WAIT_L(8); PG8_BAR; PG8_WAIT_L(0); PG8_MMA(0, 0, At, B0); PG8_BAR; PG8_SCHED;
            PG8_LDB(B1, 1, 1); PG8_STAGE(PG8_SB(1, 0), b3, voffB);
            PG8_BAR; PG8_WAIT_L(0); PG8_MMA(0, 1, At, B1); PG8_BAR;
            PG8_LDA(At, 1, 1); PG8_STAGE(PG8_SA(1, 0), a3, voffA);
            PG8_BAR; PG8_WAIT_L(0); PG8_MMA(1, 0, At, B0); PG8_BAR; PG8_SCHED;
            PG8_STAGE(PG8_SB(1, 1), b3 + hstep, voffB);
            PG8_WAIT_V(6); PG8_BAR; PG8_MMA(1, 1, At, B1); PG8_BAR;
            }
        }
        if constexpr (ALIGN_EPI) { if (wr == 0) PG8_BAR; }
        if constexpr (!Epi::AFTER_DRAIN) { E(acc, cur, wr, wc, fr, fq); S.done(cur); }
        if (!has_next) break;
#pragma unroll
        for (int a = 0; a < 2; ++a)
#pragma unroll
            for (int b = 0; b < 2; ++b)
#pragma unroll
                for (int m = 0; m < 4; ++m)
#pragma unroll
                    for (int n = 0; n < 2; ++n) acc[a][b][m][n] = (f32x4){0.f, 0.f, 0.f, 0.f};
        cur = nxt; cA = nA; cB = nB; ++ui;
        if constexpr (ALIGN_EPI) { if (wr == 1) PG8_BAR; }
    }
    PG8_WAIT_V(0);
    if constexpr (!ALIGN_EPI) { if (wr == 0) PG8_BAR; }
    PG8_BAR;
    if constexpr (Epi::AFTER_DRAIN) { E.fused(acc, cur, wr, wc, fr, fq, lds, wid, lane); S.done(cur); }
#undef PG8_SA
#undef PG8_SB
#undef PG8_STAGE
#undef PG8_LDA
#undef PG8_LDB
#undef PG8_MMA
#undef PG8_WAIT_V
#undef PG8_WAIT_L
#undef PG8_BAR
#undef PG8_SCHED
}
}

#ifndef MK_ONE
#define MK_ONE 1
#endif
#define GAS __attribute__((address_space(1)))
#define LAS __attribute__((address_space(3)))
typedef unsigned short bf16;
typedef short bf16x8 __attribute__((ext_vector_type(8)));
typedef float f32x4 __attribute__((ext_vector_type(4)));
typedef unsigned u32x4 __attribute__((ext_vector_type(4)));
typedef unsigned u32x2 __attribute__((ext_vector_type(2)));

constexpr int NWAVES = 8, NTHR = 512;
constexpr int M = 32768, SEQ = 2048, NB = 16, D = 1024, FF = 4096, PLE = 256;
constexpr int NWIN = 3328, WIN_LD = 5328;
constexpr float LN_EPS = 1e-5f;
constexpr float ALPHA = 1.189207115002721f;
constexpr float IDX_W_SCALE = 0.04419417382415922f;
constexpr float QA_SCALE = 0.125f * 1.4426950408889634f;
constexpr float MLK_SCALE = 0.08838834764831845f;
constexpr int LDS_BYTES = 147456;
constexpr int NPHASE = 12;

constexpr size_t MiB = 1u << 20;
constexpr size_t WS_WIN = 1 * MiB, WS_WGA = 8 * MiB, WS_WGB = 10 * MiB, WS_WUA = 12 * MiB, WS_WUB = 13 * MiB, WS_WOUT = 14 * MiB,
                 WS_WFF1 = 16 * MiB, WS_WFF2 = 24 * MiB, WS_WPG = 32 * MiB, WS_WPP = 34 * MiB;
constexpr size_t WS_COS = 35 * MiB, WS_SIN = 39 * MiB, WS_WI = 43 * MiB, WS_IG = 44 * MiB, WS_LF = 44 * MiB + 512 * 1024;
constexpr size_t WS_KA = 45 * MiB, WS_KI = 49 * MiB, WS_VAT = 53 * MiB;
constexpr size_t WS_BCUM = 57 * MiB, WS_CS = 58 * MiB, WS_MST = 59 * MiB, WS_DN = 60 * MiB, WS_NST = 61 * MiB, WS_CST = 208 * MiB;
constexpr size_t WS_XB = 64 * MiB, WS_PB = 128 * MiB, WS_QA = 144 * MiB, WS_QI = 176 * MiB, WS_MLQK = 208 * MiB, WS_MLV = 272 * MiB,
                 WS_MLO = 304 * MiB, WS_QC = 336 * MiB, WS_DC = 400 * MiB, WS_END = 464 * MiB;
constexpr size_t WS_TMP = 336 * MiB, WS_MRG = 400 * MiB, WS_H1 = 64 * MiB, WS_HF = 144 * MiB, WS_RB = 400 * MiB, WS_PROJ = 144 * MiB;

__device__ __forceinline__ unsigned f2bf(float f) { unsigned u = __builtin_bit_cast(unsigned, f); return (u + 0x7fffu + ((u >> 16) & 1u)) >> 16; }
typedef float f32x2_t __attribute__((ext_vector_type(2)));
typedef __bf16 bf16x2_t __attribute__((ext_vector_type(2)));
__device__ __forceinline__ unsigned pk2(float lo, float hi) { f32x2_t v = {lo, hi}; bf16x2_t b = __builtin_convertvector(v, bf16x2_t); return __builtin_bit_cast(unsigned, b); }
__device__ __forceinline__ float bflo(unsigned w) { return __builtin_bit_cast(float, w << 16); }
__device__ __forceinline__ float bfhi(unsigned w) { return __builtin_bit_cast(float, w & 0xffff0000u); }
__device__ __forceinline__ float sigmoidf_(float x) { return __builtin_amdgcn_rcpf(1.0f + __expf(-x)); }
#define LDS_WAIT() asm volatile("s_waitcnt lgkmcnt(0)" ::: "memory")

__constant__ double INVF[32] = {1.0, 0.7498942093324559, 0.5623413251903491, 0.4216965034285822, 0.31622776601683794, 0.23713737056616552, 0.1778279410038923, 0.1333521432163324,
    0.1, 0.07498942093324558, 0.05623413251903491, 0.042169650342858224, 0.03162277660168379, 0.023713737056616554, 0.01778279410038923, 0.01333521432163324,
    0.01, 0.007498942093324558, 0.005623413251903491, 0.004216965034285823, 0.0031622776601683794, 0.0023713737056616554, 0.0017782794100389228, 0.001333521432163324,
    0.001, 0.0007498942093324559, 0.0005623413251903491, 0.00042169650342858224, 0.00031622776601683794, 0.00023713737056616554, 0.00017782794100389227, 0.0001333521432163324};

struct Args {
    const float* in[20]; float* out; unsigned char* ws; int ph_lo, ph_hi;
};
enum { I_X = 0, I_P, I_POS, I_WIN, I_CONVW, I_CONVB, I_BIG, I_BFG, I_MLNG, I_WUA, I_WUB, I_WOUT, I_LN1G, I_LN1B, I_WFF1, I_WFF2, I_WPG, I_WPP, I_LN2G, I_LN2B };

__device__ __forceinline__ int win_src(int n) {
    if (n < 512) { const int hh = n >> 6, j = n & 63; return hh * 64 + (j >> 1) + 32 * (j & 1); }
    if (n < 1024) { const int mm = n - 512, hh = mm >> 6, j = mm & 63; return 640 + hh * 64 + (j >> 1) + 32 * (j & 1); }
    if (n < 1280) { const int mm = n - 1024;
        if (mm < 64) return 512 + (mm >> 1) + 32 * (mm & 1);
        if (mm < 128) { const int j = mm - 64; return 1152 + (j >> 1) + 32 * (j & 1); }
        if (mm < 192) return 576 + (mm - 128);
        if (mm < 200) return 1216 + (mm - 192);
        if (mm < 204) return 2760 + (mm - 200);
        if (mm < 208) return 2764 + (mm - 204);
        return -1; }
    if (n < 2304) return 1224 + (n - 1280);
    if (n < 2816) return 2248 + (n - 2304);
    return 2768 + (n - 2816);
}

template <class SrcF>
__device__ __forceinline__ void transpose_item(const float* W, int K, int ldw, bf16* WT, int Nrows, LAS float* scr, int item, int lane, SrcF src) {
    const int nblk = Nrows / 32, kb = item / nblk, nb = item % nblk, k0 = 64 * kb, n0 = 32 * nb;
    const int sc = src(n0 + (lane & 31));
#pragma unroll 8
    for (int i = 0; i < 32; ++i) { const int kk = 2 * i + (lane >> 5); scr[kk * 33 + (lane & 31)] = sc >= 0 ? W[(size_t)(k0 + kk) * ldw + sc] : 0.f; }
    LDS_WAIT(); asm volatile("" ::: "memory");
    const int c = lane & 7;
#pragma unroll
    for (int j = 0; j < 4; ++j) { const int n = (lane >> 3) + 8 * j; const LAS float* s = scr + (8 * c) * 33 + n;
        u32x4 o; o.x = pk2(s[0 * 33], s[1 * 33]); o.y = pk2(s[2 * 33], s[3 * 33]); o.z = pk2(s[4 * 33], s[5 * 33]); o.w = pk2(s[6 * 33], s[7 * 33]);
        *(u32x4*)(WT + (size_t)(n0 + n) * K + k0 + 8 * c) = o; }
    LDS_WAIT(); asm volatile("" ::: "memory");
}

struct EpiWin {
    static constexpr bool PERM = true, AFTER_DRAIN = false;
    bf16 *QA, *QI, *KA, *KI, *VAT, *MLQK, *MLV, *MLO; float *WI, *IG, *LF; const float *COS, *SIN, *b_ig, *b_fg;
    __device__ __forceinline__ void operator()(const f32x4 (&acc)[2][2][4][2], const pg8::Unit& u, int wr, int wc, int fr, int fq) const {
        const int pn = u.pn, row0 = u.pm * 256 + wr * 64 + fr;
#pragma unroll
        for (int ai = 0; ai < 2; ++ai)
#pragma unroll
            for (int m = 0; m < 4; ++m) { const int r = row0 + ai * 128 + m * 16;
#pragma unroll
                for (int bj = 0; bj < 2; ++bj) { const int cl = bj * 128 + wc * 32 + 8 * fq; f32x4 v0 = acc[ai][bj][m][0], v1 = acc[ai][bj][m][1];
                    const bool rope = (pn < 4) || (pn == 4 && cl < 128);
                    if (rope) {
                        const int i0 = (cl & 63) >> 1;
                        const f32x4 c = *(const f32x4*)(COS + (unsigned)r * 32 + i0), s = *(const f32x4*)(SIN + (unsigned)r * 32 + i0);
                        const float sc = (pn < 2) ? QA_SCALE : 1.0f;
                        f32x4 o0, o1;
                        o0[0] = (v0[0] * c[0] - v0[1] * s[0]) * sc; o0[1] = (v0[1] * c[0] + v0[0] * s[0]) * sc;
                        o0[2] = (v0[2] * c[1] - v0[3] * s[1]) * sc; o0[3] = (v0[3] * c[1] + v0[2] * s[1]) * sc;
                        o1[0] = (v1[0] * c[2] - v1[1] * s[2]) * sc; o1[1] = (v1[1] * c[2] + v1[0] * s[2]) * sc;
                        o1[2] = (v1[2] * c[3] - v1[3] * s[3]) * sc; o1[3] = (v1[3] * c[3] + v1[2] * s[3]) * sc;
                        bf16* dst;
                        if (pn < 2) dst = QA + (unsigned)r * 512 + pn * 256 + cl;
                        else if (pn < 4) dst = QI + (unsigned)r * 512 + (pn - 2) * 256 + cl;
                        else dst = (cl < 64) ? (KA + (unsigned)r * 64 + cl) : (KI + (unsigned)r * 64 + (cl - 64));
                        u32x4 w; w.x = pk2(o0[0], o0[1]); w.y = pk2(o0[2], o0[3]); w.z = pk2(o1[0], o1[1]); w.w = pk2(o1[2], o1[3]);
                        *(u32x4*)dst = w;
                    } else if (pn == 4) {
                        if (cl < 192) { const int d0 = cl - 128, b = r >> 11, t = r & 2047; bf16* base = VAT + ((unsigned)(b * 64 + d0)) * 2048 + t;
#pragma unroll
                            for (int j = 0; j < 4; ++j) { base[(unsigned)j * 2048] = (bf16)f2bf(v0[j]); base[(unsigned)(j + 4) * 2048] = (bf16)f2bf(v1[j]); } }
                        else if (cl == 192) { *(f32x4*)(WI + (unsigned)r * 8) = v0 * IDX_W_SCALE; *(f32x4*)(WI + (unsigned)r * 8 + 4) = v1 * IDX_W_SCALE; }
                        else if (cl == 200) { f32x4 ig, lf;
#pragma unroll
                            for (int j = 0; j < 4; ++j) { ig[j] = v0[j] + b_ig[j]; const float f = v1[j] + b_fg[j]; lf[j] = fminf(f, 0.f) - log1pf(__expf(-fabsf(f))); }
                            *(f32x4*)(IG + (unsigned)r * 4) = ig; *(f32x4*)(LF + (unsigned)r * 4) = lf; }
                    } else {
                        bf16* dst;
                        if (pn < 9) dst = MLQK + (unsigned)r * 1024 + (pn - 5) * 256 + cl;
                        else if (pn < 11) dst = MLV + (unsigned)r * 512 + (pn - 9) * 256 + cl;
                        else { dst = MLO + (unsigned)r * 512 + (pn - 11) * 256 + cl;
#pragma unroll
                            for (int j = 0; j < 4; ++j) { v0[j] = sigmoidf_(v0[j]); v1[j] = sigmoidf_(v1[j]); } }
                        u32x4 w; w.x = pk2(v0[0], v0[1]); w.y = pk2(v0[2], v0[3]); w.z = pk2(v1[0], v1[1]); w.w = pk2(v1[2], v1[3]);
                        *(u32x4*)dst = w;
                    }
                }
                asm volatile("" ::: "memory"); }
    }
};

template <int MODE> struct EpiB {
    static constexpr bool PERM = true, AFTER_DRAIN = false;
    bf16* O; float* OF; const bf16* IB; const float* IF; int ldc;
    __device__ __forceinline__ void operator()(const f32x4 (&acc)[2][2][4][2], const pg8::Unit& u, int wr, int wc, int fr, int fq) const {
        const int row0 = u.pm * 256 + wr * 64 + fr, col0 = u.pn * 256 + wc * 32 + 8 * fq;
#pragma unroll
        for (int ai = 0; ai < 2; ++ai)
#pragma unroll
            for (int m = 0; m < 4; ++m) { const unsigned ro = (unsigned)(row0 + ai * 128 + m * 16) * ldc + col0;
#pragma unroll
                for (int bj = 0; bj < 2; ++bj) { const unsigned off = ro + bj * 128; f32x4 v0 = acc[ai][bj][m][0], v1 = acc[ai][bj][m][1];
                    if (MODE == 0) {
#pragma unroll
                        for (int j = 0; j < 4; ++j) { v0[j] = sigmoidf_(v0[j]); v1[j] = sigmoidf_(v1[j]); }
                    } else if (MODE == 3) {
#pragma unroll
                        for (int j = 0; j < 4; ++j) { const float a = fmaxf(v0[j], 0.f), b = fmaxf(v1[j], 0.f); v0[j] = a * a; v1[j] = b * b; }
                    } else {
                        const u32x4 t = *(const u32x4*)(IB + off);
                        v0[0] *= bflo(t.x); v0[1] *= bfhi(t.x); v0[2] *= bflo(t.y); v0[3] *= bfhi(t.y);
                        v1[0] *= bflo(t.z); v1[1] *= bfhi(t.z); v1[2] *= bflo(t.w); v1[3] *= bfhi(t.w);
                        if (MODE == 2) { v0 += *(const f32x4*)(IF + off); v1 += *(const f32x4*)(IF + off + 4); }
                    }
                    if (MODE == 1) { *(f32x4*)(OF + off) = v0; *(f32x4*)(OF + off + 4) = v1; }
                    else { u32x4 w; w.x = pk2(v0[0], v0[1]); w.y = pk2(v0[2], v0[3]); w.z = pk2(v1[0], v1[1]); w.w = pk2(v1[2], v1[3]); *(u32x4*)(O + off) = w; }
                }
                if (MODE == 1 || MODE == 2) asm volatile("" ::: "memory"); }
    }
};
template <int MODE> struct EpiF {
    static constexpr bool PERM = false, AFTER_DRAIN = false;
    float* OF; bf16* O; const float* IF; const bf16* IB; int ldc;
    __device__ __forceinline__ void operator()(const f32x4 (&acc)[2][2][4][2], const pg8::Unit& u, int wr, int wc, int fr, int fq) const {
        const int row0 = u.pm * 256 + wr * 64 + fr, col0 = u.pn * 256 + wc * 32 + 4 * fq;
#pragma unroll
        for (int ai = 0; ai < 2; ++ai)
#pragma unroll
            for (int m = 0; m < 4; ++m) { const unsigned ro = (unsigned)(row0 + ai * 128 + m * 16) * ldc + col0;
#pragma unroll
                for (int bj = 0; bj < 2; ++bj)
#pragma unroll
                    for (int n = 0; n < 2; ++n) { const unsigned off = ro + bj * 128 + n * 16; f32x4 v = acc[ai][bj][m][n];
                        if (MODE == 0) { v += ALPHA * *(const f32x4*)(IF + off); *(f32x4*)(OF + off) = v; }
                        else if (MODE == 1) { const u32x2 t = *(const u32x2*)(IB + off);
                            v[0] += ALPHA * bflo(t.x); v[1] += ALPHA * bfhi(t.x); v[2] += ALPHA * bflo(t.y); v[3] += ALPHA * bfhi(t.y);
                            *(f32x4*)(OF + off) = v; u32x2 w; w.x = pk2(v[0], v[1]); w.y = pk2(v[2], v[3]); *(u32x2*)(O + off) = w; }
                        else if (MODE == 2) { *(f32x4*)(OF + off) = v; }
                        else { const f32x4 pr = *(const f32x4*)(IF + off); f32x4 r = *(const f32x4*)(OF + off);
#pragma unroll
                            for (int j = 0; j < 4; ++j) r[j] += sigmoidf_(v[j]) * pr[j];
                            *(f32x4*)(OF + off) = r; }
                    }
                if (MODE != 2) asm volatile("" ::: "memory"); }
    }
};

__device__ __forceinline__ float wave_sum(float v) {
#pragma unroll
    for (int o = 1; o < 64; o <<= 1) v += __shfl_xor(v, o);
    return v;
}
__device__ __forceinline__ float wave_max(float v) {
#pragma unroll
    for (int o = 1; o < 64; o <<= 1) v = fmaxf(v, __shfl_xor(v, o));
    return v;
}
#define MFMA16(a, b, c) __builtin_amdgcn_mfma_f32_16x16x32_bf16((a), (b), (c), 0, 0, 0)

template <bool TO_BF16>
__device__ __forceinline__ void ln_row(const float* xrow, const float* gam, const float* bet, float* of, bf16* ob, int lane) {
    const f32x4* xr = (const f32x4*)xrow + lane;
    f32x4 v[4]; float s = 0.f;
#pragma unroll
    for (int j = 0; j < 4; ++j) { v[j] = xr[64 * j]; s += (v[j][0] + v[j][1]) + (v[j][2] + v[j][3]); }
    const float mean = wave_sum(s) * (1.f / 1024.f); float s2 = 0.f;
#pragma unroll
    for (int j = 0; j < 4; ++j) { v[j] = v[j] - mean; s2 += (v[j][0] * v[j][0] + v[j][1] * v[j][1]) + (v[j][2] * v[j][2] + v[j][3] * v[j][3]); }
    const float rstd = 1.f / sqrtf(wave_sum(s2) * (1.f / 1024.f) + LN_EPS);
#pragma unroll
    for (int j = 0; j < 4; ++j) { const f32x4 g = ((const f32x4*)gam)[lane + 64 * j], b = ((const f32x4*)bet)[lane + 64 * j]; const f32x4 o = v[j] * rstd * g + b;
        if (TO_BF16) { u32x2 w; w.x = pk2(o[0], o[1]); w.y = pk2(o[2], o[3]); ((u32x2*)ob)[lane + 64 * j] = w; }
        else ((f32x4*)of)[lane + 64 * j] = o; }
}

constexpr int SC_LD = 2052;
constexpr int MK_OFF = 16 * SC_LD * 4;
__device__ __forceinline__ void mixa_unit(const bf16* QI, const bf16* KI, const float* WI, bf16* QA  , const bf16* KA, const bf16* VAT,
                                          LAS unsigned char* lds, int b, int qt) {
    const int tid = threadIdx.x, w = __builtin_amdgcn_readfirstlane(tid >> 6), lane = tid & 63, n = lane & 15, g = lane >> 4;
    const int rowbase = b * SEQ + qt * 16, nk16 = qt + 1;
    LAS float* SC = (LAS float*)lds;
    LAS unsigned long long* MK = (LAS unsigned long long*)(lds + MK_OFF);
    const f32x4 zero4 = {0.f, 0.f, 0.f, 0.f};
    {
        bf16x8 qf[8][2];
        const bf16* qrow = QI + (size_t)(rowbase + n) * 512 + 8 * g;
#pragma unroll
        for (int h = 0; h < 8; ++h) { qf[h][0] = *(const bf16x8*)(qrow + h * 64); qf[h][1] = *(const bf16x8*)(qrow + h * 64 + 32); }
        const f32x4 w0 = *(const f32x4*)(WI + (size_t)(rowbase + n) * 8), w1 = *(const f32x4*)(WI + (size_t)(rowbase + n) * 8 + 4);
        const float wv[8] = {w0[0], w0[1], w0[2], w0[3], w1[0], w1[1], w1[2], w1[3]};
        const bf16* kbase = KI + (size_t)(b * SEQ + n) * 64 + 8 * g;
        for (int kt = w; kt < nk16; kt += 8) {
            const bf16x8 k0 = *(const bf16x8*)(kbase + (size_t)kt * 1024), k1 = *(const bf16x8*)(kbase + (size_t)kt * 1024 + 32);
            f32x4 sc = zero4;
#pragma unroll
            for (int h = 0; h < 8; ++h) { f32x4 a = MFMA16(k0, qf[h][0], zero4); a = MFMA16(k1, qf[h][1], a);
#pragma unroll
                for (int i = 0; i < 4; ++i) sc[i] += fmaxf(a[i], 0.f) * wv[h]; }
            if (kt == qt) {
#pragma unroll
                for (int i = 0; i < 4; ++i) if (4 * g + i > n) sc[i] = -INFINITY; }
            *(LAS f32x4*)(SC + n * SC_LD + kt * 16 + 4 * g) = sc;
        }
    }
    __syncthreads();
#pragma unroll 1
    for (int qq = 0; qq < 2; ++qq) {
        const int nq = 2 * w + qq, t = qt * 16 + nq, Lr = 16 * nk16, nj = (Lr + 63) >> 6;
        unsigned key[32];
#pragma unroll
        for (int j = 0; j < 32; ++j) { const int idx = lane + 64 * j; float v = -INFINITY; if (j < nj && idx < Lr) v = SC[nq * SC_LD + idx];
            const unsigned uu = __builtin_bit_cast(unsigned, v); key[j] = (uu & 0x80000000u) ? ~uu : (uu | 0x80000000u); }
        if (t + 1 <= 256) {
#pragma unroll
            for (int j = 0; j < 32; ++j) { const unsigned long long mm = __ballot(lane + 64 * j <= t); if (lane == 0) MK[nq * 32 + j] = mm; }
        } else {
            unsigned T = 0u; bool exact = false;
#pragma unroll 1
            for (int bit = 31; bit >= 0; --bit) {
                const unsigned cand = T | (1u << bit); int cnt = 0;
#pragma unroll
                for (int j = 0; j < 32; ++j) if (j < nj) cnt += __popcll(__ballot(key[j] >= cand));
                if (cnt >= 256) { T = cand; if (cnt == 256) { exact = true; break; } }
            }
            int need = 0x7fffffff;
            if (!exact) { int cgt = 0;
#pragma unroll
                for (int j = 0; j < 32; ++j) if (j < nj) cgt += __popcll(__ballot(key[j] > T));
                need = 256 - cgt; }
            int tb = 0; const unsigned long long ltm = (1ull << lane) - 1ull;
#pragma unroll
            for (int j = 0; j < 32; ++j) {
                unsigned long long selm = 0ull;
                if (j < nj) { const bool eq = key[j] == T; const unsigned long long eqm = __ballot(eq);
                    const int myrank = tb + __popcll(eqm & ltm);
                    selm = __ballot(key[j] > T || (eq && myrank < need)); tb += __popcll(eqm); }
                if (lane == 0) MK[nq * 32 + j] = selm;
            }
        }
    }
    __syncthreads();
    {
        const bf16* qrow = QA + (size_t)(rowbase + n) * 512 + w * 64 + 8 * g;
        const bf16x8 qa0 = *(const bf16x8*)qrow, qa1 = *(const bf16x8*)(qrow + 32);
        f32x4 o[4] = {zero4, zero4, zero4, zero4}; float mrun = -1e30f, lsum = 0.f;
        const bf16* kb_ptr = KA + (size_t)(b * SEQ + n) * 64 + 8 * g;
        const bf16* vt_ptr = VAT + (size_t)(b * 64 + n) * 2048 + 4 * g;
        const int nkb = (nk16 + 1) >> 1;
        for (int kb = 0; kb < nkb; ++kb) {
            f32x4 st[2];
#pragma unroll
            for (int tt = 0; tt < 2; ++tt) { const bf16* kp = kb_ptr + (size_t)(2 * kb + tt) * 1024;
                const bf16x8 k0 = *(const bf16x8*)kp, k1 = *(const bf16x8*)(kp + 32);
                st[tt] = MFMA16(k0, qa0, zero4); st[tt] = MFMA16(k1, qa1, st[tt]); }
            const unsigned long long mw = MK[n * 32 + (kb >> 1)];
            const unsigned hs = ((kb & 1) ? (unsigned)(mw >> 32) : (unsigned)mw) >> (4 * g);
            float bm = -INFINITY;
#pragma unroll
            for (int tt = 0; tt < 2; ++tt)
#pragma unroll
                for (int i = 0; i < 4; ++i) { const bool sel = (hs >> (16 * tt + i)) & 1u; st[tt][i] = sel ? st[tt][i] : -INFINITY; bm = fmaxf(bm, st[tt][i]); }
            bm = fmaxf(bm, __shfl_xor(bm, 16)); bm = fmaxf(bm, __shfl_xor(bm, 32));
            const float mn = fmaxf(mrun, bm), alpha = __builtin_amdgcn_exp2f(mrun - mn); mrun = mn;
            float ps = 0.f;
#pragma unroll
            for (int tt = 0; tt < 2; ++tt)
#pragma unroll
                for (int i = 0; i < 4; ++i) { st[tt][i] = __builtin_amdgcn_exp2f(st[tt][i] - mn); ps += st[tt][i]; }
            lsum = lsum * alpha + ps;
            u32x4 pw; pw.x = pk2(st[0][0], st[0][1]); pw.y = pk2(st[0][2], st[0][3]); pw.z = pk2(st[1][0], st[1][1]); pw.w = pk2(st[1][2], st[1][3]);
            const bf16x8 pb = __builtin_bit_cast(bf16x8, pw);
#pragma unroll
            for (int dt = 0; dt < 4; ++dt) { const bf16* vp = vt_ptr + (size_t)dt * 16 * 2048 + 32 * kb;
                const u32x2 lo = *(const u32x2*)vp, hi = *(const u32x2*)(vp + 16);
                u32x4 vv; vv.x = lo.x; vv.y = lo.y; vv.z = hi.x; vv.w = hi.y;
                o[dt] = o[dt] * alpha; o[dt] = MFMA16(__builtin_bit_cast(bf16x8, vv), pb, o[dt]); }
        }
        lsum += __shfl_xor(lsum, 16); lsum += __shfl_xor(lsum, 32);
        const float inv = 1.0f / lsum;
        bf16* orow = QA + (size_t)(rowbase + n) * 512 + w * 64 + 4 * g;
#pragma unroll
        for (int dt = 0; dt < 4; ++dt) { u32x2 ww; ww.x = pk2(o[dt][0] * inv, o[dt][1] * inv); ww.y = pk2(o[dt][2] * inv, o[dt][3] * inv); *(u32x2*)(orow + dt * 16) = ww; }
    }
    __syncthreads();
}

constexpr int KW_LD = 72;
__device__ __forceinline__ void m1_unit(const bf16* MLQK, const bf16* MLV, const float* IG, const float* LF, const float* conv_w, const float* conv_b,
                                        bf16* QC, bf16* DC, float* DN, float* BCUM, float* CS, LAS unsigned char* lds, int unit) {
    const int c = unit & 31, bh = unit >> 5, h = bh & 3, b = bh >> 2;
    const int tid = threadIdx.x, w = __builtin_amdgcn_readfirstlane(tid >> 6), lane = tid & 63, n = lane & 15, g = lane >> 4;
    const int rowbase = b * SEQ + c * 64;
    LAS float* WK = (LAS float*)lds;
    LAS bf16* KWT = (LAS bf16*)(lds + 1024);
    LAS bf16* VT = (LAS bf16*)(lds + 1024 + 128 * KW_LD * 2);
    if (w == 0) {
        const float lf = LF[(size_t)(rowbase + lane) * 4 + h], ig = IG[(size_t)(rowbase + lane) * 4 + h];
        float bc = lf;
#pragma unroll
        for (int o = 1; o < 64; o <<= 1) { const float tt = __shfl_up(bc, o); if (lane >= o) bc += tt; }
        const float bl = __shfl(bc, 63), gj = bl - bc + ig, mg = wave_max(gj);
        WK[lane] = __expf(gj - mg);
        BCUM[(size_t)(rowbase + lane) * 4 + h] = bc;
        if (lane == 0) { CS[unit * 2] = bl; CS[unit * 2 + 1] = mg; }
    }
    __syncthreads();
    {
        const int isk = (tid >> 4) & 1, cgi = tid & 15, rl = tid >> 5;
        const int ch = isk * 512 + h * 128 + cgi * 8;
        float cw[4][8], cb[8];
#pragma unroll
        for (int j = 0; j < 4; ++j) { const f32x4 a = *(const f32x4*)(conv_w + j * 1024 + ch), bb = *(const f32x4*)(conv_w + j * 1024 + ch + 4);
            cw[j][0] = a[0]; cw[j][1] = a[1]; cw[j][2] = a[2]; cw[j][3] = a[3]; cw[j][4] = bb[0]; cw[j][5] = bb[1]; cw[j][6] = bb[2]; cw[j][7] = bb[3]; }
        { const f32x4 a = *(const f32x4*)(conv_b + ch), bb = *(const f32x4*)(conv_b + ch + 4);
            cb[0] = a[0]; cb[1] = a[1]; cb[2] = a[2]; cb[3] = a[3]; cb[4] = bb[0]; cb[5] = bb[1]; cb[6] = bb[2]; cb[7] = bb[3]; }
        float x[7][8];
#pragma unroll
        for (int rr = 0; rr < 7; ++rr) { const int tl = c * 64 + 4 * rl + rr - 3;
            u32x4 t = {0u, 0u, 0u, 0u};
            if (tl >= 0) t = *(const u32x4*)(MLQK + (size_t)(b * SEQ + tl) * 1024 + ch);
            x[rr][0] = bflo(t.x); x[rr][1] = bfhi(t.x); x[rr][2] = bflo(t.y); x[rr][3] = bfhi(t.y); x[rr][4] = bflo(t.z); x[rr][5] = bfhi(t.z); x[rr][6] = bflo(t.w); x[rr][7] = bfhi(t.w); }
#pragma unroll
        for (int oo = 0; oo < 4; ++oo) { const int jr = 4 * rl + oo; float y[8];
#pragma unroll
            for (int e = 0; e < 8; ++e) { float a = cb[e];
#pragma unroll
                for (int j = 0; j < 4; ++j) a += cw[j][e] * x[oo + j][e];
                a = a * sigmoidf_(a); y[e] = isk ? a * MLK_SCALE : a; }
            u32x4 wv; wv.x = pk2(y[0], y[1]); wv.y = pk2(y[2], y[3]); wv.z = pk2(y[4], y[5]); wv.w = pk2(y[6], y[7]);
            *(u32x4*)(QC + (size_t)(rowbase + jr) * 1024 + ch) = wv;
            if (isk) { const float wk = WK[jr];
#pragma unroll
                for (int e = 0; e < 8; ++e) KWT[(cgi * 8 + e) * KW_LD + jr] = (bf16)f2bf(y[e] * wk); }
        }
#pragma unroll
        for (int q = 0; q < 2; ++q) { const int idx = tid + 512 * q, row = idx >> 4, cgv = idx & 15;
            const u32x4 t = *(const u32x4*)(MLV + (size_t)(rowbase + row) * 512 + h * 128 + cgv * 8);
            LAS bf16* vp = VT + (cgv * 8) * KW_LD + row;
            vp[0 * KW_LD] = (bf16)(t.x & 0xffffu); vp[1 * KW_LD] = (bf16)(t.x >> 16); vp[2 * KW_LD] = (bf16)(t.y & 0xffffu); vp[3 * KW_LD] = (bf16)(t.y >> 16);
            vp[4 * KW_LD] = (bf16)(t.z & 0xffffu); vp[5 * KW_LD] = (bf16)(t.z >> 16); vp[6 * KW_LD] = (bf16)(t.w & 0xffffu); vp[7 * KW_LD] = (bf16)(t.w >> 16); }
    }
    __syncthreads();
    {
        f32x4 acc[8];
#pragma unroll
        for (int et = 0; et < 8; ++et) acc[et] = (f32x4){0.f, 0.f, 0.f, 0.f};
#pragma unroll
        for (int ks = 0; ks < 2; ++ks) { const bf16x8 a = *(const LAS bf16x8*)(KWT + (16 * w + n) * KW_LD + 32 * ks + 8 * g);
#pragma unroll
            for (int et = 0; et < 8; ++et) { const bf16x8 bfr = *(const LAS bf16x8*)(VT + (16 * et + n) * KW_LD + 32 * ks + 8 * g); acc[et] = MFMA16(a, bfr, acc[et]); } }
        bf16* dcu = DC + (size_t)unit * 16384;
#pragma unroll
        for (int et = 0; et < 8; ++et) { u32x2 ww; ww.x = pk2(acc[et][0], acc[et][1]); ww.y = pk2(acc[et][2], acc[et][3]); *(u32x2*)(dcu + (16 * et + n) * 128 + 16 * w + 4 * g) = ww; }
        if (tid < 128) { float s = 0.f;
#pragma unroll 8
            for (int j = 0; j < 64; ++j) s += __builtin_bit_cast(float, (unsigned)KWT[tid * KW_LD + j] << 16);
            DN[(size_t)unit * 128 + tid] = s; }
    }
    __syncthreads();
}

constexpr int CT_LD = 136;
__device__ __forceinline__ void m3_unit(const bf16* QC, bf16* MLV  , const bf16* MLO, const float* IG, const float* BCUM, const float* MST,
                                        const bf16* DC, const float* DN, const float* gnorm, LAS unsigned char* lds, int unit) {
    const int c = unit & 31, bh = unit >> 5, h = bh & 3, b = bh >> 2;
    const int tid = threadIdx.x, w = __builtin_amdgcn_readfirstlane(tid >> 6), lane = tid & 63, n = lane & 15, g = lane >> 4;
    const int rowbase = b * SEQ + c * 64;
    LAS float* U = (LAS float*)lds; LAS float* R = U + 64; LAS float* WINT = U + 128; LAS float* EMR = U + 192; LAS float* NS = U + 256; LAS float* XCH = U + 384;
    LAS bf16* CT = (LAS bf16*)(lds + 4096);
    LAS bf16* KS = (LAS bf16*)(lds + 4096 + 128 * CT_LD * 2);
    LAS bf16* VT = (LAS bf16*)(lds + 4096 + 128 * CT_LD * 2 + 64 * CT_LD * 2);
    if (w == 0) {
        const float bc = BCUM[(size_t)(rowbase + lane) * 4 + h], ig = IG[(size_t)(rowbase + lane) * 4 + h], mc = MST[unit];
        const float uu = ig - bc; float a = uu;
#pragma unroll
        for (int o = 1; o < 64; o <<= 1) { const float tt = __shfl_up(a, o); if (lane >= o) a = fmaxf(a, tt); }
        const float mrow = bc + fmaxf(a, mc);
        U[lane] = uu; R[lane] = bc - mrow; WINT[lane] = __expf(bc + mc - mrow); EMR[lane] = __expf(-mrow);
    }
    {
        const bf16* dcu = DC + (size_t)unit * 16384;
#pragma unroll
        for (int q = 0; q < 4; ++q) { const int idx = tid + 512 * q, e = idx >> 4, dg = idx & 15; *(LAS u32x4*)(CT + e * CT_LD + dg * 8) = *(const u32x4*)(dcu + idx * 8); }
#pragma unroll
        for (int q = 0; q < 2; ++q) { const int idx = tid + 512 * q, s = idx >> 4, dg = idx & 15;
            *(LAS u32x4*)(KS + s * CT_LD + dg * 8) = *(const u32x4*)(QC + (size_t)(rowbase + s) * 1024 + 512 + h * 128 + dg * 8); }
#pragma unroll
        for (int q = 0; q < 2; ++q) { const int idx = tid + 512 * q, row = idx >> 4, cgv = idx & 15;
            const u32x4 t = *(const u32x4*)(MLV + (size_t)(rowbase + row) * 512 + h * 128 + cgv * 8);
            LAS bf16* vp = VT + (cgv * 8) * KW_LD + row;
            vp[0 * KW_LD] = (bf16)(t.x & 0xffffu); vp[1 * KW_LD] = (bf16)(t.x >> 16); vp[2 * KW_LD] = (bf16)(t.y & 0xffffu); vp[3 * KW_LD] = (bf16)(t.y >> 16);
            vp[4 * KW_LD] = (bf16)(t.z & 0xffffu); vp[5 * KW_LD] = (bf16)(t.z >> 16); vp[6 * KW_LD] = (bf16)(t.w & 0xffffu); vp[7 * KW_LD] = (bf16)(t.w >> 16); }
        if (tid < 128) NS[tid] = DN[(size_t)unit * 128 + tid];
    }
    __syncthreads();
#ifdef M3_LITE
    {
        const int lt = w & 3, eh = w >> 2, l = 16 * lt + n;
#pragma unroll
        for (int j = 0; j < 4; ++j) { const int e0 = 16 * (4 * eh + j) + 4 * g; float y[4];
#pragma unroll
            for (int i = 0; i < 4; ++i) { const int e = e0 + i;
                y[i] = 0.f;
                if (M3_LITE & 1) y[i] += __builtin_bit_cast(float, (unsigned)CT[e * CT_LD + ((l * 2 + 1) & 127)] << 16);
                if (M3_LITE & 2) y[i] += __builtin_bit_cast(float, (unsigned)KS[l * CT_LD + e] << 16);
                if (M3_LITE & 4) y[i] += __builtin_bit_cast(float, (unsigned)VT[e * KW_LD + l] << 16);
                if (M3_LITE & 8) y[i] += NS[e];
                if (M3_LITE & 16) y[i] += U[l] + R[l];
                if (M3_LITE & 32) y[i] += WINT[l] + EMR[l]; }
            const size_t off = (size_t)(rowbase + l) * 512 + h * 128 + e0;
            u32x2 ww; ww.x = pk2(y[0], y[1]); ww.y = pk2(y[2], y[3]); *(u32x2*)(MLV + off) = ww; }
        __syncthreads();
        return;
    }
#endif
    const int lt = w & 3, eh = w >> 2, l = 16 * lt + n;
    bf16x8 qf[4];
    { const bf16* qrow = QC + (size_t)(rowbase + l) * 1024 + h * 128 + 8 * g;
#pragma unroll
        for (int ks = 0; ks < 4; ++ks) qf[ks] = *(const bf16x8*)(qrow + 32 * ks); }
    const f32x4 zero4 = {0.f, 0.f, 0.f, 0.f};
    f32x4 sw[4]; const float Rl = R[l], wint = WINT[l], emr = EMR[l];
    float dsum = 0.f;
#pragma unroll
    for (int st = 0; st < 4; ++st) {
        sw[st] = zero4;
        if (st <= lt) { f32x4 acc = zero4;
#pragma unroll
            for (int ks = 0; ks < 4; ++ks) { const bf16x8 a = *(const LAS bf16x8*)(KS + (16 * st + n) * CT_LD + 32 * ks + 8 * g); acc = MFMA16(a, qf[ks], acc); }
#pragma unroll
            for (int i = 0; i < 4; ++i) { const int s = 16 * st + 4 * g + i; const float wgt = (s <= l) ? __expf(U[s] + Rl) : 0.f; sw[st][i] = acc[i] * wgt; dsum += sw[st][i]; } }
    }
    dsum += __shfl_xor(dsum, 16); dsum += __shfl_xor(dsum, 32);
    float qn = 0.f;
#pragma unroll
    for (int ks = 0; ks < 4; ++ks) { const u32x4 qq = __builtin_bit_cast(u32x4, qf[ks]); const LAS float* np = NS + 32 * ks + 8 * g;
        qn += bflo(qq.x) * np[0] + bfhi(qq.x) * np[1] + bflo(qq.y) * np[2] + bfhi(qq.y) * np[3] + bflo(qq.z) * np[4] + bfhi(qq.z) * np[5] + bflo(qq.w) * np[6] + bfhi(qq.w) * np[7]; }
    qn += __shfl_xor(qn, 16); qn += __shfl_xor(qn, 32);
    const float den = wint * qn + dsum;
    const float rden = 1.0f / fmaxf(fabsf(den), emr);
    f32x4 hv[4]; float s1 = 0.f;
#pragma unroll
    for (int j = 0; j < 4; ++j) { const int et = 4 * eh + j;
        f32x4 accS = zero4, accC = zero4;
#pragma unroll
        for (int kb = 0; kb < 2; ++kb) if (2 * kb <= lt) {
            u32x4 pw; pw.x = pk2(sw[2 * kb][0], sw[2 * kb][1]); pw.y = pk2(sw[2 * kb][2], sw[2 * kb][3]); pw.z = pk2(sw[2 * kb + 1][0], sw[2 * kb + 1][1]); pw.w = pk2(sw[2 * kb + 1][2], sw[2 * kb + 1][3]);
            const LAS bf16* vp = VT + (16 * et + n) * KW_LD + 32 * kb + 4 * g;
            const u32x2 lo = *(const LAS u32x2*)vp, hi = *(const LAS u32x2*)(vp + 16);
            u32x4 vv; vv.x = lo.x; vv.y = lo.y; vv.z = hi.x; vv.w = hi.y;
            accS = MFMA16(__builtin_bit_cast(bf16x8, vv), __builtin_bit_cast(bf16x8, pw), accS); }
#pragma unroll
        for (int ks = 0; ks < 4; ++ks) { const bf16x8 a = *(const LAS bf16x8*)(CT + (16 * et + n) * CT_LD + 32 * ks + 8 * g); accC = MFMA16(a, qf[ks], accC); }
#pragma unroll
        for (int i = 0; i < 4; ++i) { hv[j][i] = (wint * accC[i] + accS[i]) * rden; s1 += hv[j][i]; }
    }
    s1 += __shfl_xor(s1, 16); s1 += __shfl_xor(s1, 32);
    const float mloc = s1 * (1.f / 64.f); float q2 = 0.f;
#pragma unroll
    for (int j = 0; j < 4; ++j)
#pragma unroll
        for (int i = 0; i < 4; ++i) { const float dd = hv[j][i] - mloc; q2 += dd * dd; }
    q2 += __shfl_xor(q2, 16); q2 += __shfl_xor(q2, 32);
    if (g == 0) { XCH[(l * 2 + eh) * 2] = mloc; XCH[(l * 2 + eh) * 2 + 1] = q2; }
    __syncthreads();
    {
        const float mo = XCH[(l * 2 + (eh ^ 1)) * 2], qo = XCH[(l * 2 + (eh ^ 1)) * 2 + 1];
        const float mean = 0.5f * (mloc + mo), dm = mloc - mo, m2 = q2 + qo + 32.f * dm * dm;
        const float rstd = 1.0f / sqrtf(m2 * (1.f / 128.f) + LN_EPS);
#pragma unroll
        for (int j = 0; j < 4; ++j) { const int e0 = 16 * (4 * eh + j) + 4 * g;
            const f32x4 gn = *(const f32x4*)(gnorm + h * 128 + e0);
            const size_t off = (size_t)(rowbase + l) * 512 + h * 128 + e0;
            const u32x2 so = *(const u32x2*)(MLO + off);
            const float y0 = (hv[j][0] - mean) * rstd * gn[0] * bflo(so.x), y1 = (hv[j][1] - mean) * rstd * gn[1] * bfhi(so.x);
            const float y2 = (hv[j][2] - mean) * rstd * gn[2] * bflo(so.y), y3 = (hv[j][3] - mean) * rstd * gn[3] * bfhi(so.y);
            u32x2 ww; ww.x = pk2(y0, y1); ww.y = pk2(y2, y3); *(u32x2*)(MLV + off) = ww; }
    }
    __syncthreads();
}

__global__ void __launch_bounds__(NTHR, 2) fwd_kernel(Args args) {
    extern __shared__ __attribute__((aligned(16))) unsigned char lds_raw[];
    LAS unsigned char* lds = (LAS unsigned char*)lds_raw;
    cg::grid_group grid = cg::this_grid();
    const int tid = threadIdx.x, lane = tid & 63, wave = __builtin_amdgcn_readfirstlane(tid >> 6);
    const int G = gridDim.x, bx = blockIdx.x;
    const int gw = bx * NWAVES + wave, NGW = G * NWAVES;
    const int gt = bx * NTHR + tid, NGT = G * NTHR;
    unsigned char* ws = args.ws;
    const int lo = args.ph_lo, hi = args.ph_hi;
#ifndef PH_MASK
#define PH_MASK 0xfff
#endif
#define IN(k) (((PH_MASK >> (k)) & 1) && lo <= (k) && (k) < hi)
#define SEAM(k) do { if (IN(k) && IN((k) + 1)) { __builtin_amdgcn_fence(__ATOMIC_RELEASE, "agent"); asm volatile("s_waitcnt vmcnt(0) lgkmcnt(0)" ::: "memory"); grid.sync(); \
    __builtin_amdgcn_fence(__ATOMIC_ACQUIRE, "agent"); asm volatile("s_waitcnt vmcnt(0)" ::: "memory"); __syncthreads(); } } while (0)
    float* OUT = args.out;
#define PHASE_PTRS() unsigned char* wsb = ws; asm volatile("" : "+s"(wsb)); \
    bf16* WinT = (bf16*)(wsb + WS_WIN); bf16* WgaT = (bf16*)(wsb + WS_WGA); bf16* WgbT = (bf16*)(wsb + WS_WGB); bf16* WuaT = (bf16*)(wsb + WS_WUA); bf16* WubT = (bf16*)(wsb + WS_WUB); \
    bf16* WoutT = (bf16*)(wsb + WS_WOUT); bf16* Wff1T = (bf16*)(wsb + WS_WFF1); bf16* Wff2T = (bf16*)(wsb + WS_WFF2); bf16* WpgT = (bf16*)(wsb + WS_WPG); bf16* WppT = (bf16*)(wsb + WS_WPP); \
    float* COS = (float*)(wsb + WS_COS); float* SIN = (float*)(wsb + WS_SIN); float* WI = (float*)(wsb + WS_WI); float* IG = (float*)(wsb + WS_IG); float* LF = (float*)(wsb + WS_LF); \
    bf16* KA = (bf16*)(wsb + WS_KA); bf16* KI = (bf16*)(wsb + WS_KI); bf16* VAT = (bf16*)(wsb + WS_VAT); \
    float* BCUM = (float*)(wsb + WS_BCUM); float* CS = (float*)(wsb + WS_CS); float* MST = (float*)(wsb + WS_MST); float* DN = (float*)(wsb + WS_DN); \
    bf16* XB = (bf16*)(wsb + WS_XB); bf16* PB = (bf16*)(wsb + WS_PB); bf16* QA = (bf16*)(wsb + WS_QA); bf16* QI = (bf16*)(wsb + WS_QI); bf16* MLQK = (bf16*)(wsb + WS_MLQK); \
    bf16* MLV = (bf16*)(wsb + WS_MLV); bf16* MLO = (bf16*)(wsb + WS_MLO); bf16* QC = (bf16*)(wsb + WS_QC); bf16* DC = (bf16*)(wsb + WS_DC); \
    bf16* TMP = (bf16*)(wsb + WS_TMP); bf16* MRG = (bf16*)(wsb + WS_MRG); bf16* H1 = (bf16*)(wsb + WS_H1); bf16* HF = (bf16*)(wsb + WS_HF); bf16* RB = (bf16*)(wsb + WS_RB); \
    float* PROJ = (float*)(wsb + WS_PROJ); bf16* CST = (bf16*)(wsb + WS_CST); float* NST = (float*)(wsb + WS_NST); (void)CST; (void)NST; \
    (void)WinT; (void)WgaT; (void)WgbT; (void)WuaT; (void)WubT; (void)WoutT; (void)Wff1T; (void)Wff2T; (void)WpgT; (void)WppT; (void)COS; (void)SIN; (void)WI; (void)IG; (void)LF; (void)KA; (void)KI; (void)VAT; \
    (void)BCUM; (void)CS; (void)MST; (void)DN; (void)XB; (void)PB; (void)QA; (void)QI; (void)MLQK; (void)MLV; (void)MLO; (void)QC; (void)DC; (void)TMP; (void)MRG; (void)H1; (void)HF; (void)RB; (void)PROJ
#define LAUNDER_I(v) asm volatile("" : "+s"(v))

    if (IN(0)) { PHASE_PTRS();
        LAS float* scr = (LAS float*)(lds + wave * 16384);
        const float* w_in = args.in[I_WIN]; const float* x = args.in[I_X];
        constexpr int I_A = 16 * (NWIN / 32), I_G = 16 * 32, I_U = 8 * 32, I_O = 16 * 32, I_1 = 16 * 128, I_2 = 64 * 32, I_PG = 16 * 32, I_PP = 4 * 32;
        constexpr int NITEMS = I_A + 2 * I_G + 2 * I_U + I_O + I_1 + I_2 + I_PG + I_PP;
        for (int it = gw; it < NITEMS; it += NGW) {
            int r = it;
            if (r < I_A) { transpose_item(w_in, 1024, WIN_LD, WinT, NWIN, scr, r, lane, [](int n) { return win_src(n); }); continue; } r -= I_A;
            if (r < I_G) { transpose_item(w_in, 1024, WIN_LD, WgaT, 1024, scr, r, lane, [](int n) { return 3280 + n; }); continue; } r -= I_G;
            if (r < I_G) { transpose_item(w_in, 1024, WIN_LD, WgbT, 1024, scr, r, lane, [](int n) { return 4304 + n; }); continue; } r -= I_G;
            if (r < I_U) { transpose_item(args.in[I_WUA], 512, 1024, WuaT, 1024, scr, r, lane, [](int n) { return n; }); continue; } r -= I_U;
            if (r < I_U) { transpose_item(args.in[I_WUB], 512, 1024, WubT, 1024, scr, r, lane, [](int n) { return n; }); continue; } r -= I_U;
            if (r < I_O) { transpose_item(args.in[I_WOUT], 1024, 1024, WoutT, 1024, scr, r, lane, [](int n) { return n; }); continue; } r -= I_O;
            if (r < I_1) { transpose_item(args.in[I_WFF1], 1024, 4096, Wff1T, 4096, scr, r, lane, [](int n) { return n; }); continue; } r -= I_1;
            if (r < I_2) { transpose_item(args.in[I_WFF2], 4096, 1024, Wff2T, 1024, scr, r, lane, [](int n) { return n; }); continue; } r -= I_2;
            if (r < I_PG) { transpose_item(args.in[I_WPG], 1024, 1024, WpgT, 1024, scr, r, lane, [](int n) { return n; }); continue; } r -= I_PG;
            transpose_item(args.in[I_WPP], 256, 1024, WppT, 1024, scr, r, lane, [](int n) { return n; });
        }
        for (int i = gt; i < M * D / 8; i += NGT) { const f32x4 a = ((const f32x4*)x)[2 * i], b = ((const f32x4*)x)[2 * i + 1];
            u32x4 o; o.x = pk2(a[0], a[1]); o.y = pk2(a[2], a[3]); o.z = pk2(b[0], b[1]); o.w = pk2(b[2], b[3]); ((u32x4*)XB)[i] = o; }
        { const float* p = args.in[I_P];
            for (int i = gt; i < M * PLE / 8; i += NGT) { const f32x4 a = ((const f32x4*)p)[2 * i], b = ((const f32x4*)p)[2 * i + 1];
                u32x4 o; o.x = pk2(a[0], a[1]); o.y = pk2(a[2], a[3]); o.z = pk2(b[0], b[1]); o.w = pk2(b[2], b[3]); ((u32x4*)PB)[i] = o; } }
        { const int* pos = (const int*)args.in[I_POS];
            for (int i = gt; i < M * 32; i += NGT) { const int m = i >> 5, f = i & 31; const double a = (double)pos[m] * INVF[f] * 0.15915494309189535;
                const float rev = (float)(a - floor(a)); COS[i] = __builtin_amdgcn_cosf(rev); SIN[i] = __builtin_amdgcn_sinf(rev); } }
    }
    SEAM(0);
    if (IN(1)) { PHASE_PTRS();
        int Kv = D; LAUNDER_I(Kv); pg8::Gemm gm{XB, WinT, M, NWIN, Kv}; pg8::StaticOrder S; S.init(M, NWIN, G, bx);
        EpiWin E{QA, QI, KA, KI, VAT, MLQK, MLV, MLO, WI, IG, LF, COS, SIN, args.in[I_BIG], args.in[I_BFG]};
        pg8::gemm_phase<EpiWin, pg8::StaticOrder, true, true>(lds, gm, S, E);
    }
    SEAM(1);
    if (IN(2)) { PHASE_PTRS();
#ifdef NO_MIXA
        for (int i = gt; i < M * 512 / 8; i += NGT) ((u32x4*)QA)[i] = (u32x4){0u, 0u, 0u, 0u};
#else
        for (int pr = bx; pr < NB * 64; pr += G) { const int b = pr >> 6, j = pr & 63;
            mixa_unit(QI, KI, WI, QA, KA, VAT, lds, b, 127 - j);
            mixa_unit(QI, KI, WI, QA, KA, VAT, lds, b, j); }
#endif
        for (int u = bx; u < 2048; u += G) m1_unit(MLQK, MLV, IG, LF, args.in[I_CONVW], args.in[I_CONVB], QC, DC, DN, BCUM, CS, lds, u);
    }
    SEAM(2);
    if (IN(3)) { PHASE_PTRS();
        for (int item = gt; item < 64 * 2048; item += NGT) { const int bh = item >> 11, rem = item & 2047;
            float st[8] = {0.f, 0.f, 0.f, 0.f, 0.f, 0.f, 0.f, 0.f}; float m = 0.f;
#pragma unroll 4
            for (int c = 0; c < 32; ++c) { const float bl = CS[(bh * 32 + c) * 2], mg = CS[(bh * 32 + c) * 2 + 1];
                const float mn = fmaxf(bl + m, mg), a = __expf(bl + m - mn), s = __expf(mg - mn); m = mn;
                const u32x4 d = *(const u32x4*)(DC + (size_t)(bh * 32 + c) * 16384 + rem * 8);
                u32x4 o; o.x = pk2(st[0], st[1]); o.y = pk2(st[2], st[3]); o.z = pk2(st[4], st[5]); o.w = pk2(st[6], st[7]); *(u32x4*)(CST + (size_t)(bh * 32 + c) * 16384 + rem * 8) = o;
                st[0] = a * st[0] + s * bflo(d.x); st[1] = a * st[1] + s * bfhi(d.x); st[2] = a * st[2] + s * bflo(d.y); st[3] = a * st[3] + s * bfhi(d.y);
                st[4] = a * st[4] + s * bflo(d.z); st[5] = a * st[5] + s * bfhi(d.z); st[6] = a * st[6] + s * bflo(d.w); st[7] = a * st[7] + s * bfhi(d.w); } }
        for (int item = gt; item < 64 * 128; item += NGT) { const int bh = item >> 7, dd = item & 127; float st = 0.f, m = 0.f;
            for (int c = 0; c < 32; ++c) { const float bl = CS[(bh * 32 + c) * 2], mg = CS[(bh * 32 + c) * 2 + 1];
                if (dd == 0) MST[bh * 32 + c] = m;
                const float mn = fmaxf(bl + m, mg), a = __expf(bl + m - mn), s = __expf(mg - mn); m = mn;
                const float d = DN[(size_t)(bh * 32 + c) * 128 + dd]; NST[(size_t)(bh * 32 + c) * 128 + dd] = st; st = a * st + s * d; } }
    }
    SEAM(3);
    if (IN(4)) { PHASE_PTRS();
        for (int u = bx; u < 2048; u += G) m3_unit(QC, MLV, MLO, IG, BCUM, MST, CST, NST, args.in[I_MLNG], lds, u);
    }
    SEAM(4);
    if (IN(5)) { PHASE_PTRS();
        pg8::StaticOrder S; S.init(M, D, G, bx);
        { int Kv = D; LAUNDER_I(Kv); pg8::Gemm gm{XB, WgaT, M, D, Kv}; EpiB<0> E{TMP, nullptr, nullptr, nullptr, D}; pg8::gemm_phase<EpiB<0>, pg8::StaticOrder, true, true>(lds, gm, S, E); }
        { int Kv = 512; LAUNDER_I(Kv); pg8::Gemm gm{QA, WuaT, M, D, Kv}; EpiB<1> E{nullptr, OUT, TMP, nullptr, D}; pg8::gemm_phase<EpiB<1>, pg8::StaticOrder, true, true>(lds, gm, S, E); }
        { int Kv = D; LAUNDER_I(Kv); pg8::Gemm gm{XB, WgbT, M, D, Kv}; EpiB<0> E{TMP, nullptr, nullptr, nullptr, D}; pg8::gemm_phase<EpiB<0>, pg8::StaticOrder, true, true>(lds, gm, S, E); }
        { int Kv = 512; LAUNDER_I(Kv); pg8::Gemm gm{MLV, WubT, M, D, Kv}; EpiB<2> E{MRG, nullptr, TMP, OUT, D}; pg8::gemm_phase<EpiB<2>, pg8::StaticOrder, true, true>(lds, gm, S, E); }
    }
    SEAM(5);
    if (IN(6)) { PHASE_PTRS();
        pg8::StaticOrder S; S.init(M, D, G, bx);
        int Kv = D; LAUNDER_I(Kv); pg8::Gemm gm{MRG, WoutT, M, D, Kv}; EpiF<0> E{OUT, nullptr, args.in[I_X], nullptr, D}; pg8::gemm_phase<EpiF<0>, pg8::StaticOrder, true, true>(lds, gm, S, E);
    }
    SEAM(6);
    if (IN(7)) { PHASE_PTRS(); for (int m = gw; m < M; m += NGW) ln_row<true>(OUT + (size_t)m * D, args.in[I_LN1G], args.in[I_LN1B], nullptr, H1 + (size_t)m * D, lane); }
    SEAM(7);
    if (IN(8)) { PHASE_PTRS();
        pg8::StaticOrder S; S.init(M, FF, G, bx);
        int Kv = D; LAUNDER_I(Kv); pg8::Gemm gm{H1, Wff1T, M, FF, Kv}; EpiB<3> E{HF, nullptr, nullptr, nullptr, FF}; pg8::gemm_phase<EpiB<3>, pg8::StaticOrder, true, true>(lds, gm, S, E);
    }
    SEAM(8);
    if (IN(9)) { PHASE_PTRS();
        pg8::StaticOrder S; S.init(M, D, G, bx);
        int Kv = FF; LAUNDER_I(Kv); pg8::Gemm gm{HF, Wff2T, M, D, Kv}; EpiF<1> E{OUT, RB, nullptr, H1, D}; pg8::gemm_phase<EpiF<1>, pg8::StaticOrder, true, true>(lds, gm, S, E);
    }
    SEAM(9);
    if (IN(10)) { PHASE_PTRS();
        pg8::StaticOrder S; S.init(M, D, G, bx);
#if !defined(P10_ONLY) || P10_ONLY == 1
        { int Kv = PLE; LAUNDER_I(Kv); pg8::Gemm gm{PB, WppT, M, D, Kv}; EpiF<2> E{PROJ, nullptr, nullptr, nullptr, D}; pg8::gemm_phase<EpiF<2>, pg8::StaticOrder, true, true>(lds, gm, S, E); }
#endif
#if !defined(P10_ONLY) || P10_ONLY == 2
        { int Kv = D; LAUNDER_I(Kv); pg8::Gemm gm{RB, WpgT, M, D, Kv}; EpiF<3> E{OUT, nullptr, PROJ, nullptr, D}; pg8::gemm_phase<EpiF<3>, pg8::StaticOrder, true, true>(lds, gm, S, E); }
#endif
    }
    SEAM(10);
    if (IN(11)) { PHASE_PTRS(); for (int m = gw; m < M; m += NGW) ln_row<false>(OUT + (size_t)m * D, args.in[I_LN2G], args.in[I_LN2B], OUT + (size_t)m * D, nullptr, lane); }
#undef IN
#undef SEAM
}

extern "C" void kernel_launch(void* const* d_in, const int* in_sizes, int n_in, void* d_out, int out_size, void* d_ws, size_t ws_size, hipStream_t stream) {
    static int grid = 0;
    if (grid == 0) {
        if (n_in != 20 || out_size != M * D || ws_size < WS_END) { fprintf(stderr, "kernel_launch: unexpected problem shape (n_in %d, out %d, ws %zu)\n", n_in, out_size, ws_size); grid = -1; return; }
        int dev = 0, cus = 0, per_cu = 0;
        hipGetDevice(&dev); hipDeviceGetAttribute(&cus, hipDeviceAttributeMultiprocessorCount, dev);
        if (hipFuncSetAttribute((const void*)fwd_kernel, hipFuncAttributeMaxDynamicSharedMemorySize, LDS_BYTES) != hipSuccess) { fprintf(stderr, "kernel_launch: hipFuncSetAttribute failed\n"); grid = -1; return; }
        if (hipOccupancyMaxActiveBlocksPerMultiprocessor(&per_cu, (const void*)fwd_kernel, NTHR, LDS_BYTES) != hipSuccess || per_cu < 1) { fprintf(stderr, "kernel_launch: occupancy query says %d\n", per_cu); per_cu = 1; }
        (void)hipGetLastError();
        grid = cus * (per_cu > 1 ? 1 : per_cu);
        if (grid <= 0) { grid = -1; return; }
    }
    if (grid < 0) return;
    Args a{};
    for (int i = 0; i < 20; ++i) a.in[i] = (const float*)d_in[i];
    a.out = (float*)d_out; a.ws = (unsigned char*)d_ws;
#if MK_ONE
    a.ph_lo = 0; a.ph_hi = NPHASE;
    void* params[] = {&a};
    hipError_t e = hipLaunchCooperativeKernel((const void*)fwd_kernel, dim3(grid), dim3(NTHR), params, LDS_BYTES, stream);
    if (e != hipSuccess) fprintf(stderr, "cooperative launch failed: %s (grid %d)\n", hipGetErrorString(e), grid);
#else
    for (int ph = 0; ph < NPHASE; ++ph) { a.ph_lo = ph; a.ph_hi = ph + 1; hipLaunchKernelGGL(fwd_kernel, dim3(grid), dim3(NTHR), LDS_BYTES, stream, a); }
#endif
}
```

```cpp
#include <hip/hip_runtime.h>
#include <hip/hip_cooperative_groups.h>
#include <cstdio>
#include <cstdint>
namespace cg = cooperative_groups;
#define MK_ONE 1
namespace pg8 {
#define PG8_LAS __attribute__((address_space(3)))
typedef unsigned short bf16_t;
typedef short bf16x8 __attribute__((ext_vector_type(8)));
typedef float f32x4 __attribute__((ext_vector_type(4)));
typedef unsigned u32x4 __attribute__((ext_vector_type(4)));
constexpr int BM = 256, BK = 64, HALF = 128, HTB = HALF * BK * 2  , STAGE_BYTES = 8 * HTB, NXCD = 8, WGM = 8;

__host__ __device__ __forceinline__ int lds_byte(int r, int c) { const int st = (r >> 4) * 2 + (c >> 5), rr = r & 15, cc = c & 31, ob = rr * 64 + cc * 2; return st * 1024 + (ob ^ (((ob >> 9) & 1) << 5)); }
__host__ __device__ __forceinline__ void stage_rc(int b, int& R, int& C) { const int st = b / 1024, sb = b % 1024, swz = sb ^ (((sb >> 9) & 1) << 5); R = (st >> 1) * 16 + swz / 64; C = (st & 1) * 32 + (swz % 64) / 2; }
__host__ __device__ __forceinline__ int perm32(int rho) { const int n = rho >> 4, i = rho & 15; return 8 * (i >> 2) + 4 * n + (i & 3); }

struct Unit { int pm, pn; };
struct Gemm { const bf16_t* A; const bf16_t* Bt; int M, N, K; };

struct StaticOrder {
    int nM, nN, nwg, G, c;
    __host__ __device__ void init(int M, int N, int G_, int c_) { nM = M / BM; nN = N / BM; nwg = nM * nN; G = G_; c = c_; }
    __host__ __device__ bool next(int i, Unit& u) const {
        const long L = (long)i * G + c; if (L >= nwg) return false;
        int wgid = (int)L; { const int q = nwg / NXCD, r = nwg % NXCD, xcd = wgid % NXCD, off = wgid / NXCD; wgid = (xcd < r ? xcd * (q + 1) : r * (q + 1) + (xcd - r) * q) + off; }
        const int nig = WGM * nN, gid = wgid / nig, fm = gid * WGM, gsz = (nM - fm) < WGM ? (nM - fm) : WGM;
        u.pm = fm + ((wgid % nig) % gsz); u.pn = (wgid % nig) / gsz; return true;
    }
    __device__ __forceinline__ void a_ready(const Unit&) const {}
    __device__ __forceinline__ void done(const Unit&) const {}
};

__device__ __forceinline__ unsigned cvt_pk_bf16(float lo, float hi) { unsigned r; asm volatile("v_cvt_pk_bf16_f32 %0, %1, %2" : "=v"(r) : "v"(lo), "v"(hi)); return r; }
template <class Epi, class Sched, bool ALIGN_EPI = false, bool SP2 = false>
__device__ __forceinline__ void gemm_phase(PG8_LAS unsigned char* lds, const Gemm g, const Sched& S, const Epi& E) {
    const int tid = threadIdx.x, wid = __builtin_amdgcn_readfirstlane(tid >> 6), lane = tid & 63, wr = wid >> 2, wc = wid & 3, fr = lane & 15, fq = lane >> 4;
    const int K = g.K, nt = K / BK;
    unsigned voffA[2], voffB[2];
#pragma unroll
    for (int i = 0; i < 2; ++i) { int R, C; stage_rc(tid * 16 + i * 8192, R, C); const int Rb = Epi::PERM ? ((R & ~31) + perm32(R & 31)) : R;
        voffA[i] = (unsigned)(R * K + C) * 2u; voffB[i] = (unsigned)(Rb * K + C) * 2u; }
    const size_t kstep = (size_t)(BK * 2);
    const size_t hstep = (size_t)HALF * K * 2;
    const size_t tstep = 2 * hstep;
    const unsigned ldsw = (unsigned)wid * 1024u;
    const int aoff = lds_byte(wr * 64 + fr, fq * 8), boff = lds_byte(wc * 32 + fr, fq * 8);
#define PG8_SA(b, h) (((b) * 2 + (h)) * HTB)
#define PG8_SB(b, h) ((4 + (b) * 2 + (h)) * HTB)
#define PG8_STAGE(bufoff, gbase, voff) do { _Pragma("unroll") for (int _i = 0; _i < 2; ++_i) \
        __builtin_amdgcn_global_load_lds((const unsigned*)((const char*)(gbase) + (voff)[_i]), (PG8_LAS unsigned*)(lds + (bufoff) + ldsw + _i * 8192), 16, 0, 0); } while (0)
#define PG8_LDA(dst, b, h) do { _Pragma("unroll") for (int m = 0; m < 4; ++m) _Pragma("unroll") for (int k = 0; k < 2; ++k) dst[m][k] = *(const PG8_LAS bf16x8*)(lds + PG8_SA(b, h) + aoff + m * 2048 + k * 1024); } while (0)
#define PG8_LDB(dst, b, h) do { _Pragma("unroll") for (int n = 0; n < 2; ++n) _Pragma("unroll") for (int k = 0; k < 2; ++k) dst[n][k] = *(const PG8_LAS bf16x8*)(lds + PG8_SB(b, h) + boff + n * 2048 + k * 1024); } while (0)
#define PG8_MMA(ai, bj, At, Bt) do { __builtin_amdgcn_s_setprio(1); _Pragma("unroll") for (int m = 0; m < 4; ++m) _Pragma("unroll") for (int n = 0; n < 2; ++n) _Pragma("unroll") for (int k = 0; k < 2; ++k) \
        acc[ai][bj][m][n] = __builtin_amdgcn_mfma_f32_16x16x32_bf16(Bt[n][k], At[m][k], acc[ai][bj][m][n], 0, 0, 0); __builtin_amdgcn_s_setprio(0); } while (0)
#define PG8_WAIT_V(n) asm volatile("s_waitcnt vmcnt(" #n ")" ::: "memory")
#define PG8_WAIT_L(n) asm volatile("s_waitcnt lgkmcnt(" #n ")" ::: "memory")
#define PG8_BAR __builtin_amdgcn_s_barrier()
#define PG8_SCHED __builtin_amdgcn_sched_barrier(0)
    Unit cur, nxt; int ui = 0;
    if (!S.next(0, cur)) return;
    f32x4 acc[2][2][4][2];
#pragma unroll
    for (int a = 0; a < 2; ++a)
#pragma unroll
        for (int b = 0; b < 2; ++b)
#pragma unroll
            for (int m = 0; m < 4; ++m)
#pragma unroll
                for (int n = 0; n < 2; ++n) acc[a][b][m][n] = (f32x4){0.f, 0.f, 0.f, 0.f};
    bf16x8 At[4][2], B0[2][2], B1[2][2];
    const char* cA = (const char*)g.A + (size_t)cur.pm * tstep; const char* cB = (const char*)g.Bt + (size_t)cur.pn * tstep;
    S.a_ready(cur);
    if constexpr (SP2) {
        PG8_STAGE(PG8_SB(0, 0), cB, voffB); PG8_STAGE(PG8_SB(0, 1), cB + hstep, voffB); PG8_STAGE(PG8_SA(0, 0), cA, voffA); PG8_STAGE(PG8_SA(0, 1), cA + hstep, voffA);
        if (wr == 1) PG8_BAR;
        PG8_WAIT_V(2); PG8_BAR;
        PG8_STAGE(PG8_SB(1, 0), cB + kstep, voffB); PG8_STAGE(PG8_SA(1, 0), cA + kstep, voffA); PG8_STAGE(PG8_SB(1, 1), cB + hstep + kstep, voffB);
        PG8_WAIT_V(6); PG8_BAR;
    } else {
        PG8_STAGE(PG8_SB(0, 0), cB, voffB); PG8_STAGE(PG8_SA(0, 0), cA, voffA); PG8_STAGE(PG8_SB(0, 1), cB + hstep, voffB); PG8_STAGE(PG8_SA(0, 1), cA + hstep, voffA);
        if (wr == 1) PG8_BAR;
        PG8_WAIT_V(4); PG8_BAR;
        PG8_STAGE(PG8_SB(1, 0), cB + kstep, voffB); PG8_STAGE(PG8_SA(1, 0), cA + kstep, voffA); PG8_STAGE(PG8_SB(1, 1), cB + hstep + kstep, voffB);
        PG8_WAIT_V(6); PG8_BAR;
    }
    for (;;) {
        const bool has_next = S.next(ui + 1, nxt);
        const char* nA = has_next ? (const char*)g.A + (size_t)nxt.pm * tstep : cA; const char* nB = has_next ? (const char*)g.Bt + (size_t)nxt.pn * tstep : cB;
        for (int t = 0; t < nt; t += 2) {
            const bool last = (t == nt - 2);
            const char* a1 = cA + (size_t)(t + 1) * kstep;
            const char* a2 = last ? nA : cA + (size_t)(t + 2) * kstep; const char* b2 = last ? nB : cB + (size_t)(t + 2) * kstep;
            const char* a3 = a2 + kstep; const char* b3 = b2 + kstep;
            if (last && has_next) S.a_ready(nxt);
            if constexpr (SP2) {
            PG8_LDB(B0, 0, 0); PG8_LDB(B1, 0, 1); PG8_SCHED; PG8_LDA(At, 0, 0); PG8_STAGE(PG8_SA(1, 1), a1 + hstep, voffA);
            PG8_WAIT_V(8); PG8_WAIT_L(0); PG8_BAR; PG8_MMA(0, 0, At, B0); PG8_MMA(0, 1, At, B1); PG8_BAR; PG8_SCHED;
            PG8_LDA(At, 0, 1); PG8_STAGE(PG8_SB(0, 0), b2, voffB); PG8_STAGE(PG8_SB(0, 1), b2 + hstep, voffB); PG8_STAGE(PG8_SA(0, 0), a2, voffA);
            PG8_WAIT_V(8); PG8_WAIT_L(0); PG8_BAR; PG8_MMA(1, 0, At, B0); PG8_MMA(1, 1, At, B1); PG8_BAR; PG8_SCHED;
            PG8_LDB(B0, 1, 0); PG8_LDB(B1, 1, 1); PG8_SCHED; PG8_LDA(At, 1, 0); PG8_STAGE(PG8_SA(0, 1), a2 + hstep, voffA);
            PG8_WAIT_V(8); PG8_WAIT_L(0); PG8_BAR; PG8_MMA(0, 0, At, B0); PG8_MMA(0, 1, At, B1); PG8_BAR; PG8_SCHED;
            PG8_LDA(At, 1, 1); PG8_STAGE(PG8_SB(1, 0), b3, voffB); PG8_STAGE(PG8_SB(1, 1), b3 + hstep, voffB); PG8_STAGE(PG8_SA(1, 0), a3, voffA);
            PG8_WAIT_V(8); PG8_WAIT_L(0); PG8_BAR; PG8_MMA(1, 0, At, B0); PG8_MMA(1, 1, At, B1); PG8_BAR; PG8_SCHED;
            } else {
            PG8_LDB(B0, 0, 0); PG8_SCHED; PG8_LDA(At, 0, 0); PG8_STAGE(PG8_SA(1, 1), a1 + hstep, voffA);
            PG8_WAIT_L(8); PG8_BAR; PG8_WAIT_L(0); PG8_MMA(0, 0, At, B0); PG8_BAR; PG8_SCHED;
            PG8_LDB(B1, 0, 1); PG8_STAGE(PG8_SB(0, 0), b2, voffB);
            PG8_BAR; PG8_WAIT_L(0); PG8_MMA(0, 1, At, B1); PG8_BAR;
            PG8_LDA(At, 0, 1); PG8_STAGE(PG8_SA(0, 0), a2, voffA);
            PG8_BAR; PG8_WAIT_L(0); PG8_MMA(1, 0, At, B0); PG8_BAR; PG8_SCHED;
            PG8_STAGE(PG8_SB(0, 1), b2 + hstep, voffB);
            PG8_WAIT_V(6); PG8_BAR; PG8_MMA(1, 1, At, B1); PG8_BAR;
            PG8_LDB(B0, 1, 0); PG8_SCHED; PG8_LDA(At, 1, 0); PG8_STAGE(PG8_SA(0, 1), a2 + hstep, voffA);
            PG8_WAIT_L(8); PG8_BAR; PG8_WAIT_L(0); PG8_MMA(0, 0, At, B0); PG8_BAR; PG8_SCHED;
            PG8_LDB(B1, 1, 1); PG8_STAGE(PG8_SB(1, 0), b3, voffB);
            PG8_BAR; PG8_WAIT_L(0); PG8_MMA(0, 1, At, B1); PG8_BAR;
            PG8_LDA(At, 1, 1); PG8_STAGE(PG8_SA(1, 0), a3, voffA);
            PG8_BAR; PG8_WAIT_L(0); PG8_MMA(1, 0, At, B0); PG8_BAR; PG8_SCHED;
            PG8_STAGE(PG8_SB(1, 1), b3 + hstep, voffB);
            PG8_WAIT_V(6); PG8_BAR; PG8_MMA(1, 1, At, B1); PG8_BAR;
            }
        }
        if constexpr (ALIGN_EPI) { if (wr == 0) PG8_BAR; }
        if constexpr (!Epi::AFTER_DRAIN) { E(acc, cur, wr, wc, fr, fq); S.done(cur); }
        if (!has_next) break;
#pragma unroll
        for (int a = 0; a < 2; ++a)
#pragma unroll
            for (int b = 0; b < 2; ++b)
#pragma unroll
                for (int m = 0; m < 4; ++m)
#pragma unroll
                    for (int n = 0; n < 2; ++n) acc[a][b][m][n] = (f32x4){0.f, 0.f, 0.f, 0.f};
        cur = nxt; cA = nA; cB = nB; ++ui;
        if constexpr (ALIGN_EPI) { if (wr == 1) PG8_BAR; }
    }
    PG8_WAIT_V(0);
    if constexpr (!ALIGN_EPI) { if (wr == 0) PG8_BAR; }
    PG8_BAR;
    if constexpr (Epi::AFTER_DRAIN) { E.fused(acc, cur, wr, wc, fr, fq, lds, wid, lane); S.done(cur); }
#undef PG8_SA
#undef PG8_SB
#undef PG8_STAGE
#undef PG8_LDA
#undef PG8_LDB
#undef PG8_MMA
#undef PG8_WAIT_V
#undef PG8_WAIT_L
#undef PG8_BAR
#undef PG8_SCHED
}
}

#ifndef MK_ONE
#define MK_ONE 1
#endif
#define GAS __attribute__((address_space(1)))
#define LAS __attribute__((address_space(3)))
typedef unsigned short bf16;
typedef short bf16x8 __attribute__((ext_vector_type(8)));
typedef float f32x4 __attribute__((ext_vector_type(4)));
typedef unsigned u32x4 __attribute__((ext_vector_type(4)));
typedef unsigned u32x2 __attribute__((ext_vector_type(2)));

constexpr int NWAVES = 8, NTHR = 512;
constexpr int M = 32768, SEQ = 2048, NB = 16, D = 1024, FF = 4096, PLE = 256;
constexpr int NWIN = 3328, WIN_LD = 5328;
constexpr float LN_EPS = 1e-5f;
constexpr float ALPHA = 1.189207115002721f;
constexpr float IDX_W_SCALE = 0.04419417382415922f;
constexpr float QA_SCALE = 0.125f * 1.4426950408889634f;
constexpr float MLK_SCALE = 0.08838834764831845f;
constexpr int LDS_BYTES = 147456;
constexpr int NPHASE = 12;

constexpr size_t MiB = 1u << 20;
constexpr size_t WS_WIN = 1 * MiB, WS_WGA = 8 * MiB, WS_WGB = 10 * MiB, WS_WUA = 12 * MiB, WS_WUB = 13 * MiB, WS_WOUT = 14 * MiB,
                 WS_WFF1 = 16 * MiB, WS_WFF2 = 24 * MiB, WS_WPG = 32 * MiB, WS_WPP = 34 * MiB;
constexpr size_t WS_COS = 35 * MiB, WS_SIN = 39 * MiB, WS_WI = 43 * MiB, WS_IG = 44 * MiB, WS_LF = 44 * MiB + 512 * 1024;
constexpr size_t WS_KA = 45 * MiB, WS_KI = 49 * MiB, WS_VAT = 53 * MiB;
constexpr size_t WS_BCUM = 57 * MiB, WS_CS = 58 * MiB, WS_MST = 59 * MiB, WS_DN = 60 * MiB, WS_NST = 61 * MiB, WS_CST = 208 * MiB;
constexpr size_t WS_XB = 64 * MiB, WS_PB = 128 * MiB, WS_QA = 144 * MiB, WS_QI = 176 * MiB, WS_MLQK = 208 * MiB, WS_MLV = 272 * MiB,
                 WS_MLO = 304 * MiB, WS_QC = 336 * MiB, WS_DC = 400 * MiB, WS_END = 464 * MiB;
constexpr size_t WS_TMP = 336 * MiB, WS_MRG = 400 * MiB, WS_H1 = 64 * MiB, WS_HF = 144 * MiB, WS_RB = 400 * MiB, WS_PROJ = 144 * MiB;

__device__ __forceinline__ unsigned f2bf(float f) { unsigned u = __builtin_bit_cast(unsigned, f); return (u + 0x7fffu + ((u >> 16) & 1u)) >> 16; }
typedef float f32x2_t __attribute__((ext_vector_type(2)));
typedef __bf16 bf16x2_t __attribute__((ext_vector_type(2)));
__device__ __forceinline__ unsigned pk2(float lo, float hi) { f32x2_t v = {lo, hi}; bf16x2_t b = __builtin_convertvector(v, bf16x2_t); return __builtin_bit_cast(unsigned, b); }
__device__ __forceinline__ float bflo(unsigned w) { return __builtin_bit_cast(float, w << 16); }
__device__ __forceinline__ float bfhi(unsigned w) { return __builtin_bit_cast(float, w & 0xffff0000u); }
__device__ __forceinline__ float sigmoidf_(float x) { return __builtin_amdgcn_rcpf(1.0f + __expf(-x)); }
#define LDS_WAIT() asm volatile("s_waitcnt lgkmcnt(0)" ::: "memory")

__constant__ double INVF[32] = {1.0, 0.7498942093324559, 0.5623413251903491, 0.4216965034285822, 0.31622776601683794, 0.23713737056616552, 0.1778279410038923, 0.1333521432163324,
    0.1, 0.07498942093324558, 0.05623413251903491, 0.042169650342858224, 0.03162277660168379, 0.023713737056616554, 0.01778279410038923, 0.01333521432163324,
    0.01, 0.007498942093324558, 0.005623413251903491, 0.004216965034285823, 0.0031622776601683794, 0.0023713737056616554, 0.0017782794100389228, 0.001333521432163324,
    0.001, 0.0007498942093324559, 0.0005623413251903491, 0.00042169650342858224, 0.00031622776601683794, 0.00023713737056616554, 0.00017782794100389227, 0.0001333521432163324};

struct Args {
    const float* in[20]; float* out; unsigned char* ws; int ph_lo, ph_hi;
};
enum { I_X = 0, I_P, I_POS, I_WIN, I_CONVW, I_CONVB, I_BIG, I_BFG, I_MLNG, I_WUA, I_WUB, I_WOUT, I_LN1G, I_LN1B, I_WFF1, I_WFF2, I_WPG, I_WPP, I_LN2G, I_LN2B };

__device__ __forceinline__ int win_src(int n) {
    if (n < 512) { const int hh = n >> 6, j = n & 63; return hh * 64 + (j >> 1) + 32 * (j & 1); }
    if (n < 1024) { const int mm = n - 512, hh = mm >> 6, j = mm & 63; return 640 + hh * 64 + (j >> 1) + 32 * (j & 1); }
    if (n < 1280) { const int mm = n - 1024;
        if (mm < 64) return 512 + (mm >> 1) + 32 * (mm & 1);
        if (mm < 128) { const int j = mm - 64; return 1152 + (j >> 1) + 32 * (j & 1); }
        if (mm < 192) return 576 + (mm - 128);
        if (mm < 200) return 1216 + (mm - 192);
        if (mm < 204) return 2760 + (mm - 200);
        if (mm < 208) return 2764 + (mm - 204);
        return -1; }
    if (n < 2304) return 1224 + (n - 1280);
    if (n < 2816) return 2248 + (n - 2304);
    return 2768 + (n - 2816);
}

template <class SrcF>
__device__ __forceinline__ void transpose_item(const float* W, int K, int ldw, bf16* WT, int Nrows, LAS float* scr, int item, int lane, SrcF src) {
    const int nblk = Nrows / 32, kb = item / nblk, nb = item % nblk, k0 = 64 * kb, n0 = 32 * nb;
    const int sc = src(n0 + (lane & 31));
#pragma unroll 8
    for (int i = 0; i < 32; ++i) { const int kk = 2 * i + (lane >> 5); scr[kk * 33 + (lane & 31)] = sc >= 0 ? W[(size_t)(k0 + kk) * ldw + sc] : 0.f; }
    LDS_WAIT(); asm volatile("" ::: "memory");
    const int c = lane & 7;
#pragma unroll
    for (int j = 0; j < 4; ++j) { const int n = (lane >> 3) + 8 * j; const LAS float* s = scr + (8 * c) * 33 + n;
        u32x4 o; o.x = pk2(s[0 * 33], s[1 * 33]); o.y = pk2(s[2 * 33], s[3 * 33]); o.z = pk2(s[4 * 33], s[5 * 33]); o.w = pk2(s[6 * 33], s[7 * 33]);
        *(u32x4*)(WT + (size_t)(n0 + n) * K + k0 + 8 * c) = o; }
    LDS_WAIT(); asm volatile("" ::: "memory");
}

struct EpiWin {
    static constexpr bool PERM = true, AFTER_DRAIN = false;
    bf16 *QA, *QI, *KA, *KI, *VAT, *MLQK, *MLV, *MLO; float *WI, *IG, *LF; const float *COS, *SIN, *b_ig, *b_fg;
    __device__ __forceinline__ void operator()(const f32x4 (&acc)[2][2][4][2], const pg8::Unit& u, int wr, int wc, int fr, int fq) const {
        const int pn = u.pn, row0 = u.pm * 256 + wr * 64 + fr;
#pragma unroll
        for (int ai = 0; ai < 2; ++ai)
#pragma unroll
            for (int m = 0; m < 4; ++m) { const int r = row0 + ai * 128 + m * 16;
#pragma unroll
                for (int bj = 0; bj < 2; ++bj) { const int cl = bj * 128 + wc * 32 + 8 * fq; f32x4 v0 = acc[ai][bj][m][0], v1 = acc[ai][bj][m][1];
                    const bool rope = (pn < 4) || (pn == 4 && cl < 128);
                    if (rope) {
                        const int i0 = (cl & 63) >> 1;
                        const f32x4 c = *(const f32x4*)(COS + (unsigned)r * 32 + i0), s = *(const f32x4*)(SIN + (unsigned)r * 32 + i0);
                        const float sc = (pn < 2) ? QA_SCALE : 1.0f;
                        f32x4 o0, o1;
                        o0[0] = (v0[0] * c[0] - v0[1] * s[0]) * sc; o0[1] = (v0[1] * c[0] + v0[0] * s[0]) * sc;
                        o0[2] = (v0[2] * c[1] - v0[3] * s[1]) * sc; o0[3] = (v0[3] * c[1] + v0[2] * s[1]) * sc;
                        o1[0] = (v1[0] * c[2] - v1[1] * s[2]) * sc; o1[1] = (v1[1] * c[2] + v1[0] * s[2]) * sc;
                        o1[2] = (v1[2] * c[3] - v1[3] * s[3]) * sc; o1[3] = (v1[3] * c[3] + v1[2] * s[3]) * sc;
                        bf16* dst;
                        if (pn < 2) dst = QA + (unsigned)r * 512 + pn * 256 + cl;
                        else if (pn < 4) dst = QI + (unsigned)r * 512 + (pn - 2) * 256 + cl;
                        else dst = (cl < 64) ? (KA + (unsigned)r * 64 + cl) : (KI + (unsigned)r * 64 + (cl - 64));
                        u32x4 w; w.x = pk2(o0[0], o0[1]); w.y = pk2(o0[2], o0[3]); w.z = pk2(o1[0], o1[1]); w.w = pk2(o1[2], o1[3]);
                        *(u32x4*)dst = w;
                    } else if (pn == 4) {
                        if (cl < 192) { const int d0 = cl - 128, b = r >> 11, t = r & 2047; bf16* base = VAT + ((unsigned)(b * 64 + d0)) * 2048 + t;
#pragma unroll
                            for (int j = 0; j < 4; ++j) { base[(unsigned)j * 2048] = (bf16)f2bf(v0[j]); base[(unsigned)(j + 4) * 2048] = (bf16)f2bf(v1[j]); } }
                        else if (cl == 192) { *(f32x4*)(WI + (unsigned)r * 8) = v0 * IDX_W_SCALE; *(f32x4*)(WI + (unsigned)r * 8 + 4) = v1 * IDX_W_SCALE; }
                        else if (cl == 200) { f32x4 ig, lf;
#pragma unroll
                            for (int j = 0; j < 4; ++j) { ig[j] = v0[j] + b_ig[j]; const float f = v1[j] + b_fg[j]; lf[j] = fminf(f, 0.f) - log1pf(__expf(-fabsf(f))); }
                            *(f32x4*)(IG + (unsigned)r * 4) = ig; *(f32x4*)(LF + (unsigned)r * 4) = lf; }
                    } else {
                        bf16* dst;
                        if (pn < 9) dst = MLQK + (unsigned)r * 1024 + (pn - 5) * 256 + cl;
                        else if (pn < 11) dst = MLV + (unsigned)r * 512 + (pn - 9) * 256 + cl;
                        else { dst = MLO + (unsigned)r * 512 + (pn - 11) * 256 + cl;
#pragma unroll
                            for (int j = 0; j < 4; ++j) { v0[j] = sigmoidf_(v0[j]); v1[j] = sigmoidf_(v1[j]); } }
                        u32x4 w; w.x = pk2(v0[0], v0[1]); w.y = pk2(v0[2], v0[3]); w.z = pk2(v1[0], v1[1]); w.w = pk2(v1[2], v1[3]);
                        *(u32x4*)dst = w;
                    }
                }
                asm volatile("" ::: "memory"); }
    }
};

template <int MODE> struct EpiB {
    static constexpr bool PERM = true, AFTER_DRAIN = false;
    bf16* O; float* OF; const bf16* IB; const float* IF; int ldc;
    __device__ __forceinline__ void operator()(const f32x4 (&acc)[2][2][4][2], const pg8::Unit& u, int wr, int wc, int fr, int fq) const {
        const int row0 = u.pm * 256 + wr * 64 + fr, col0 = u.pn * 256 + wc * 32 + 8 * fq;
#pragma unroll
        for (int ai = 0; ai < 2; ++ai)
#pragma unroll
            for (int m = 0; m < 4; ++m) { const unsigned ro = (unsigned)(row0 + ai * 128 + m * 16) * ldc + col0;
#pragma unroll
                for (int bj = 0; bj < 2; ++bj) { const unsigned off = ro + bj * 128; f32x4 v0 = acc[ai][bj][m][0], v1 = acc[ai][bj][m][1];
                    if (MODE == 0) {
#pragma unroll
                        for (int j = 0; j < 4; ++j) { v0[j] = sigmoidf_(v0[j]); v1[j] = sigmoidf_(v1[j]); }
                    } else if (MODE == 3) {
#pragma unroll
                        for (int j = 0; j < 4; ++j) { const float a = fmaxf(v0[j], 0.f), b = fmaxf(v1[j], 0.f); v0[j] = a * a; v1[j] = b * b; }
                    } else {
                        const u32x4 t = *(const u32x4*)(IB + off);
                        v0[0] *= bflo(t.x); v0[1] *= bfhi(t.x); v0[2] *= bflo(t.y); v0[3] *= bfhi(t.y);
                        v1[0] *= bflo(t.z); v1[1] *= bfhi(t.z); v1[2] *= bflo(t.w); v1[3] *= bfhi(t.w);
                        if (MODE == 2) { v0 += *(const f32x4*)(IF + off); v1 += *(const f32x4*)(IF + off + 4); }
                    }
                    if (MODE == 1) { *(f32x4*)(OF + off) = v0; *(f32x4*)(OF + off + 4) = v1; }
                    else { u32x4 w; w.x = pk2(v0[0], v0[1]); w.y = pk2(v0[2], v0[3]); w.z = pk2(v1[0], v1[1]); w.w = pk2(v1[2], v1[3]); *(u32x4*)(O + off) = w; }
                }
                if (MODE == 1 || MODE == 2) asm volatile("" ::: "memory"); }
    }
};
template <int MODE> struct EpiF {
    static constexpr bool PERM = false, AFTER_DRAIN = false;
    float* OF; bf16* O; const float* IF; const bf16* IB; int ldc;
    __device__ __forceinline__ void operator()(const f32x4 (&acc)[2][2][4][2], const pg8::Unit& u, int wr, int wc, int fr, int fq) const {
        const int row0 = u.pm * 256 + wr * 64 + fr, col0 = u.pn * 256 + wc * 32 + 4 * fq;
#pragma unroll
        for (int ai = 0; ai < 2; ++ai)
#pragma unroll
            for (int m = 0; m < 4; ++m) { const unsigned ro = (unsigned)(row0 + ai * 128 + m * 16) * ldc + col0;
#pragma unroll
                for (int bj = 0; bj < 2; ++bj)
#pragma unroll
                    for (int n = 0; n < 2; ++n) { const unsigned off = ro + bj * 128 + n * 16; f32x4 v = acc[ai][bj][m][n];
                        if (MODE == 0) { v += ALPHA * *(const f32x4*)(IF + off); *(f32x4*)(OF + off) = v; }
                        else if (MODE == 1) { const u32x2 t = *(const u32x2*)(IB + off);
                            v[0] += ALPHA * bflo(t.x); v[1] += ALPHA * bfhi(t.x); v[2] += ALPHA * bflo(t.y); v[3] += ALPHA * bfhi(t.y);
                            *(f32x4*)(OF + off) = v; u32x2 w; w.x = pk2(v[0], v[1]); w.y = pk2(v[2], v[3]); *(u32x2*)(O + off) = w; }
                        else if (MODE == 2) { *(f32x4*)(OF + off) = v; }
                        else { const f32x4 pr = *(const f32x4*)(IF + off); f32x4 r = *(const f32x4*)(OF + off);
#pragma unroll
                            for (int j = 0; j < 4; ++j) r[j] += sigmoidf_(v[j]) * pr[j];
                            *(f32x4*)(OF + off) = r; }
                    }
                if (MODE != 2) asm volatile("" ::: "memory"); }
    }
};

__device__ __forceinline__ float wave_sum(float v) {
#pragma unroll
    for (int o = 1; o < 64; o <<= 1) v += __shfl_xor(v, o);
    return v;
}
__device__ __forceinline__ float wave_max(float v) {
#pragma unroll
    for (int o = 1; o < 64; o <<= 1) v = fmaxf(v, __shfl_xor(v, o));
    return v;
}
#define MFMA16(a, b, c) __builtin_amdgcn_mfma_f32_16x16x32_bf16((a), (b), (c), 0, 0, 0)

template <bool TO_BF16>
__device__ __forceinline__ void ln_row(const float* xrow, const float* gam, const float* bet, float* of, bf16* ob, int lane) {
    const f32x4* xr = (const f32x4*)xrow + lane;
    f32x4 v[4]; float s = 0.f;
#pragma unroll
    for (int j = 0; j < 4; ++j) { v[j] = xr[64 * j]; s += (v[j][0] + v[j][1]) + (v[j][2] + v[j][3]); }
    const float mean = wave_sum(s) * (1.f / 1024.f); float s2 = 0.f;
#pragma unroll
    for (int j = 0; j < 4; ++j) { v[j] = v[j] - mean; s2 += (v[j][0] * v[j][0] + v[j][1] * v[j][1]) + (v[j][2] * v[j][2] + v[j][3] * v[j][3]); }
    const float rstd = 1.f / sqrtf(wave_sum(s2) * (1.f / 1024.f) + LN_EPS);
#pragma unroll
    for (int j = 0; j < 4; ++j) { const f32x4 g = ((const f32x4*)gam)[lane + 64 * j], b = ((const f32x4*)bet)[lane + 64 * j]; const f32x4 o = v[j] * rstd * g + b;
        if (TO_BF16) { u32x2 w; w.x = pk2(o[0], o[1]); w.y = pk2(o[2], o[3]); ((u32x2*)ob)[lane + 64 * j] = w; }
        else ((f32x4*)of)[lane + 64 * j] = o; }
}

constexpr int SC_LD = 2052;
constexpr int MK_OFF = 16 * SC_LD * 4;
__device__ __forceinline__ void mixa_unit(const bf16* QI, const bf16* KI, const float* WI, bf16* QA  , const bf16* KA, const bf16* VAT,
                                          LAS unsigned char* lds, int b, int qt) {
    const int tid = threadIdx.x, w = __builtin_amdgcn_readfirstlane(tid >> 6), lane = tid & 63, n = lane & 15, g = lane >> 4;
    const int rowbase = b * SEQ + qt * 16, nk16 = qt + 1;
    LAS float* SC = (LAS float*)lds;
    LAS unsigned long long* MK = (LAS unsigned long long*)(lds + MK_OFF);
    const f32x4 zero4 = {0.f, 0.f, 0.f, 0.f};
    {
        bf16x8 qf[8][2];
        const bf16* qrow = QI + (size_t)(rowbase + n) * 512 + 8 * g;
#pragma unroll
        for (int h = 0; h < 8; ++h) { qf[h][0] = *(const bf16x8*)(qrow + h * 64); qf[h][1] = *(const bf16x8*)(qrow + h * 64 + 32); }
        const f32x4 w0 = *(const f32x4*)(WI + (size_t)(rowbase + n) * 8), w1 = *(const f32x4*)(WI + (size_t)(rowbase + n) * 8 + 4);
        const float wv[8] = {w0[0], w0[1], w0[2], w0[3], w1[0], w1[1], w1[2], w1[3]};
        const bf16* kbase = KI + (size_t)(b * SEQ + n) * 64 + 8 * g;
        bf16x8 nk0 = *(const bf16x8*)(kbase + (size_t)w * 1024), nk1 = *(const bf16x8*)(kbase + (size_t)w * 1024 + 32);
        for (int kt = w; kt < nk16; kt += 8) {
            const bf16x8 k0 = nk0, k1 = nk1;
            { const int ktn = (kt + 8 < nk16) ? kt + 8 : kt; nk0 = *(const bf16x8*)(kbase + (size_t)ktn * 1024); nk1 = *(const bf16x8*)(kbase + (size_t)ktn * 1024 + 32); }
            f32x4 sc = zero4;
#pragma unroll
            for (int h = 0; h < 8; ++h) { f32x4 a = MFMA16(k0, qf[h][0], zero4); a = MFMA16(k1, qf[h][1], a);
#pragma unroll
                for (int i = 0; i < 4; ++i) sc[i] += fmaxf(a[i], 0.f) * wv[h]; }
            if (kt == qt) {
#pragma unroll
                for (int i = 0; i < 4; ++i) if (4 * g + i > n) sc[i] = -INFINITY; }
            *(LAS f32x4*)(SC + n * SC_LD + kt * 16 + 4 * g) = sc;
        }
    }
    __syncthreads();
#pragma unroll 1
    for (int qq = 0; qq < 2; ++qq) {
        const int nq = 2 * w + qq, t = qt * 16 + nq, Lr = 16 * nk16, nj = (Lr + 63) >> 6;
        unsigned key[32];
#pragma unroll
        for (int j = 0; j < 32; ++j) { const int idx = lane + 64 * j; float v = -INFINITY; if (j < nj && idx < Lr) v = SC[nq * SC_LD + idx];
            const unsigned uu = __builtin_bit_cast(unsigned, v); key[j] = (uu & 0x80000000u) ? ~uu : (uu | 0x80000000u); }
        if (t + 1 <= 256) {
#pragma unroll
            for (int j = 0; j < 32; ++j) { const unsigned long long mm = __ballot(lane + 64 * j <= t); if (lane == 0) MK[nq * 32 + j] = mm; }
        } else {
            unsigned T = 0u; bool exact = false;
#pragma unroll 1
            for (int bit = 31; bit >= 0; --bit) {
                const unsigned cand = T | (1u << bit); int cnt = 0;
#pragma unroll
                for (int j = 0; j < 32; ++j) if (j < nj) cnt += __popcll(__ballot(key[j] >= cand));
                if (cnt >= 256) { T = cand; if (cnt == 256) { exact = true; break; } }
            }
            int need = 0x7fffffff;
            if (!exact) { int cgt = 0;
#pragma unroll
                for (int j = 0; j < 32; ++j) if (j < nj) cgt += __popcll(__ballot(key[j] > T));
                need = 256 - cgt; }
            int tb = 0; const unsigned long long ltm = (1ull << lane) - 1ull;
#pragma unroll
            for (int j = 0; j < 32; ++j) {
                unsigned long long selm = 0ull;
                if (j < nj) { const bool eq = key[j] == T; const unsigned long long eqm = __ballot(eq);
                    const int myrank = tb + __popcll(eqm & ltm);
                    selm = __ballot(key[j] > T || (eq && myrank < need)); tb += __popcll(eqm); }
                if (lane == 0) MK[nq * 32 + j] = selm;
            }
        }
    }
    __syncthreads();
    {
        constexpr int TLD = 72;
        LAS bf16* KT = (LAS bf16*)lds;
        LAS bf16* VTT = (LAS bf16*)(lds + 2 * 64 * TLD * 2);
        const bf16* qrow = QA + (size_t)(rowbase + n) * 512 + w * 64 + 8 * g;
        const bf16x8 qa0 = *(const bf16x8*)qrow, qa1 = *(const bf16x8*)(qrow + 32);
        f32x4 o[4] = {zero4, zero4, zero4, zero4}; float mrun = -1e30f, lsum = 0.f;
        const int nT = (nk16 + 3) >> 2;
        const int srow = tid >> 3, sch = tid & 7;
        const bf16* kg = KA + (size_t)(b * SEQ + srow) * 64 + sch * 8;
        const bf16* vg = VAT + (size_t)(b * 64 + srow) * 2048 + sch * 8;
        u32x4 rk = *(const u32x4*)kg, rv = *(const u32x4*)vg;
        *(LAS u32x4*)(KT + srow * TLD + sch * 8) = rk; *(LAS u32x4*)(VTT + srow * TLD + sch * 8) = rv;
        __syncthreads();
        for (int T = 0; T < nT; ++T) {
            const int buf = T & 1;
            if (T + 1 < nT) { rk = *(const u32x4*)(kg + (size_t)(T + 1) * 4096); rv = *(const u32x4*)(vg + (T + 1) * 64); }
            const LAS bf16* kt = KT + buf * 64 * TLD; const LAS bf16* vt = VTT + buf * 64 * TLD;
            const unsigned long long mw = MK[n * 32 + T];
#pragma unroll
            for (int kb2 = 0; kb2 < 2; ++kb2) {
                f32x4 st[2];
#pragma unroll
                for (int tt = 0; tt < 2; ++tt) { const LAS bf16* kp = kt + (32 * kb2 + 16 * tt + n) * TLD + 8 * g;
                    const bf16x8 k0 = *(const LAS bf16x8*)kp, k1 = *(const LAS bf16x8*)(kp + 32);
                    st[tt] = MFMA16(k0, qa0, zero4); st[tt] = MFMA16(k1, qa1, st[tt]); }
                const unsigned hs = (kb2 ? (unsigned)(mw >> 32) : (unsigned)mw) >> (4 * g);
                float bm = -INFINITY;
#pragma unroll
                for (int tt = 0; tt < 2; ++tt)
#pragma unroll
                    for (int i = 0; i < 4; ++i) { const bool sel = (hs >> (16 * tt + i)) & 1u; st[tt][i] = sel ? st[tt][i] : -INFINITY; bm = fmaxf(bm, st[tt][i]); }
                bm = fmaxf(bm, __shfl_xor(bm, 16)); bm = fmaxf(bm, __shfl_xor(bm, 32));
                const float mn = fmaxf(mrun, bm), alpha = __builtin_amdgcn_exp2f(mrun - mn); mrun = mn;
                float ps = 0.f;
#pragma unroll
                for (int tt = 0; tt < 2; ++tt)
#pragma unroll
                    for (int i = 0; i < 4; ++i) { st[tt][i] = __builtin_amdgcn_exp2f(st[tt][i] - mn); ps += st[tt][i]; }
                lsum = lsum * alpha + ps;
                u32x4 pw; pw.x = pk2(st[0][0], st[0][1]); pw.y = pk2(st[0][2], st[0][3]); pw.z = pk2(st[1][0], st[1][1]); pw.w = pk2(st[1][2], st[1][3]);
                const bf16x8 pb = __builtin_bit_cast(bf16x8, pw);
#pragma unroll
                for (int dt = 0; dt < 4; ++dt) { const LAS bf16* vp = vt + (16 * dt + n) * TLD + 32 * kb2 + 4 * g;
                    const u32x2 lo = *(const LAS u32x2*)vp, hi = *(const LAS u32x2*)(vp + 16);
                    u32x4 vv; vv.x = lo.x; vv.y = lo.y; vv.z = hi.x; vv.w = hi.y;
                    o[dt] = o[dt] * alpha; o[dt] = MFMA16(__builtin_bit_cast(bf16x8, vv), pb, o[dt]); }
            }
            if (T + 1 < nT) { *(LAS u32x4*)(KT + (buf ^ 1) * 64 * TLD + srow * TLD + sch * 8) = rk; *(LAS u32x4*)(VTT + (buf ^ 1) * 64 * TLD + srow * TLD + sch * 8) = rv; }
            __syncthreads();
        }
        lsum += __shfl_xor(lsum, 16); lsum += __shfl_xor(lsum, 32);
        const float inv = 1.0f / lsum;
        bf16* orow = QA + (size_t)(rowbase + n) * 512 + w * 64 + 4 * g;
#pragma unroll
        for (int dt = 0; dt < 4; ++dt) { u32x2 ww; ww.x = pk2(o[dt][0] * inv, o[dt][1] * inv); ww.y = pk2(o[dt][2] * inv, o[dt][3] * inv); *(u32x2*)(orow + dt * 16) = ww; }
    }
    __syncthreads();
}

constexpr int KW_LD = 72;
__device__ __forceinline__ void m1_unit(const bf16* MLQK, const bf16* MLV, const float* IG, const float* LF, const float* conv_w, const float* conv_b,
                                        bf16* QC, bf16* DC, float* DN, float* BCUM, float* CS, LAS unsigned char* lds, int unit) {
    const int c = unit & 31, bh = unit >> 5, h = bh & 3, b = bh >> 2;
    const int tid = threadIdx.x, w = __builtin_amdgcn_readfirstlane(tid >> 6), lane = tid & 63, n = lane & 15, g = lane >> 4;
    const int rowbase = b * SEQ + c * 64;
    LAS float* WK = (LAS float*)lds;
    LAS bf16* KWT = (LAS bf16*)(lds + 1024);
    LAS bf16* VT = (LAS bf16*)(lds + 1024 + 128 * KW_LD * 2);
    if (w == 0) {
        const float lf = LF[(size_t)(rowbase + lane) * 4 + h], ig = IG[(size_t)(rowbase + lane) * 4 + h];
        float bc = lf;
#pragma unroll
        for (int o = 1; o < 64; o <<= 1) { const float tt = __shfl_up(bc, o); if (lane >= o) bc += tt; }
        const float bl = __shfl(bc, 63), gj = bl - bc + ig, mg = wave_max(gj);
        WK[lane] = __expf(gj - mg);
        BCUM[(size_t)(rowbase + lane) * 4 + h] = bc;
        if (lane == 0) { CS[unit * 2] = bl; CS[unit * 2 + 1] = mg; }
    }
    __syncthreads();
    {
        const int isk = (tid >> 4) & 1, cgi = tid & 15, rl = tid >> 5;
        const int ch = isk * 512 + h * 128 + cgi * 8;
        float cw[4][8], cb[8];
#pragma unroll
        for (int j = 0; j < 4; ++j) { const f32x4 a = *(const f32x4*)(conv_w + j * 1024 + ch), bb = *(const f32x4*)(conv_w + j * 1024 + ch + 4);
            cw[j][0] = a[0]; cw[j][1] = a[1]; cw[j][2] = a[2]; cw[j][3] = a[3]; cw[j][4] = bb[0]; cw[j][5] = bb[1]; cw[j][6] = bb[2]; cw[j][7] = bb[3]; }
        { const f32x4 a = *(const f32x4*)(conv_b + ch), bb = *(const f32x4*)(conv_b + ch + 4);
            cb[0] = a[0]; cb[1] = a[1]; cb[2] = a[2]; cb[3] = a[3]; cb[4] = bb[0]; cb[5] = bb[1]; cb[6] = bb[2]; cb[7] = bb[3]; }
        float x[7][8];
#pragma unroll
        for (int rr = 0; rr < 7; ++rr) { const int tl = c * 64 + 4 * rl + rr - 3;
            u32x4 t = {0u, 0u, 0u, 0u};
            if (tl >= 0) t = *(const u32x4*)(MLQK + (size_t)(b * SEQ + tl) * 1024 + ch);
            x[rr][0] = bflo(t.x); x[rr][1] = bfhi(t.x); x[rr][2] = bflo(t.y); x[rr][3] = bfhi(t.y); x[rr][4] = bflo(t.z); x[rr][5] = bfhi(t.z); x[rr][6] = bflo(t.w); x[rr][7] = bfhi(t.w); }
#pragma unroll
        for (int oo = 0; oo < 4; ++oo) { const int jr = 4 * rl + oo; float y[8];
#pragma unroll
            for (int e = 0; e < 8; ++e) { float a = cb[e];
#pragma unroll
                for (int j = 0; j < 4; ++j) a += cw[j][e] * x[oo + j][e];
                a = a * sigmoidf_(a); y[e] = isk ? a * MLK_SCALE : a; }
            u32x4 wv; wv.x = pk2(y[0], y[1]); wv.y = pk2(y[2], y[3]); wv.z = pk2(y[4], y[5]); wv.w = pk2(y[6], y[7]);
            *(u32x4*)(QC + (size_t)(rowbase + jr) * 1024 + ch) = wv;
            if (isk) { const float wk = WK[jr];
#pragma unroll
                for (int e = 0; e < 8; ++e) KWT[(cgi * 8 + e) * KW_LD + jr] = (bf16)f2bf(y[e] * wk); }
        }
#pragma unroll
        for (int q = 0; q < 2; ++q) { const int idx = tid + 512 * q, row = idx >> 4, cgv = idx & 15;
            const u32x4 t = *(const u32x4*)(MLV + (size_t)(rowbase + row) * 512 + h * 128 + cgv * 8);
            LAS bf16* vp = VT + (cgv * 8) * KW_LD + row;
            vp[0 * KW_LD] = (bf16)(t.x & 0xffffu); vp[1 * KW_LD] = (bf16)(t.x >> 16); vp[2 * KW_LD] = (bf16)(t.y & 0xffffu); vp[3 * KW_LD] = (bf16)(t.y >> 16);
            vp[4 * KW_LD] = (bf16)(t.z & 0xffffu); vp[5 * KW_LD] = (bf16)(t.z >> 16); vp[6 * KW_LD] = (bf16)(t.w & 0xffffu); vp[7 * KW_LD] = (bf16)(t.w >> 16); }
    }
    __syncthreads();
    {
        f32x4 acc[8];
#pragma unroll
        for (int et = 0; et < 8; ++et) acc[et] = (f32x4){0.f, 0.f, 0.f, 0.f};
#pragma unroll
        for (int ks = 0; ks < 2; ++ks) { const bf16x8 a = *(const LAS bf16x8*)(KWT + (16 * w + n) * KW_LD + 32 * ks + 8 * g);
#pragma unroll
            for (int et = 0; et < 8; ++et) { const bf16x8 bfr = *(const LAS bf16x8*)(VT + (16 * et + n) * KW_LD + 32 * ks + 8 * g); acc[et] = MFMA16(a, bfr, acc[et]); } }
        bf16* dcu = DC + (size_t)unit * 16384;
#pragma unroll
        for (int et = 0; et < 8; ++et) { u32x2 ww; ww.x = pk2(acc[et][0], acc[et][1]); ww.y = pk2(acc[et][2], acc[et][3]); *(u32x2*)(dcu + (16 * et + n) * 128 + 16 * w + 4 * g) = ww; }
        if (tid < 128) { float s = 0.f;
#pragma unroll 8
            for (int j = 0; j < 64; ++j) s += __builtin_bit_cast(float, (unsigned)KWT[tid * KW_LD + j] << 16);
            DN[(size_t)unit * 128 + tid] = s; }
    }
    __syncthreads();
}

constexpr int CT_LD = 136;
__device__ __forceinline__ void m3_unit(const bf16* QC, bf16* MLV  , const bf16* MLO, const float* IG, const float* BCUM, const float* MST,
                                        const bf16* DC, const float* DN, const float* gnorm, LAS unsigned char* lds, int unit) {
    const int c = unit & 31, bh = unit >> 5, h = bh & 3, b = bh >> 2;
    const int tid = threadIdx.x, w = __builtin_amdgcn_readfirstlane(tid >> 6), lane = tid & 63, n = lane & 15, g = lane >> 4;
    const int rowbase = b * SEQ + c * 64;
    LAS float* U = (LAS float*)lds; LAS float* R = U + 64; LAS float* WINT = U + 128; LAS float* EMR = U + 192; LAS float* NS = U + 256; LAS float* XCH = U + 384;
    LAS bf16* CT = (LAS bf16*)(lds + 4096);
    LAS bf16* KS = (LAS bf16*)(lds + 4096 + 128 * CT_LD * 2);
    LAS bf16* VT = (LAS bf16*)(lds + 4096 + 128 * CT_LD * 2 + 64 * CT_LD * 2);
    if (w == 0) {
        const float bc = BCUM[(size_t)(rowbase + lane) * 4 + h], ig = IG[(size_t)(rowbase + lane) * 4 + h], mc = MST[unit];
        const float uu = ig - bc; float a = uu;
#pragma unroll
        for (int o = 1; o < 64; o <<= 1) { const float tt = __shfl_up(a, o); if (lane >= o) a = fmaxf(a, tt); }
        const float mrow = bc + fmaxf(a, mc);
        U[lane] = uu; R[lane] = bc - mrow; WINT[lane] = __expf(bc + mc - mrow); EMR[lane] = __expf(-mrow);
    }
    {
        const bf16* dcu = DC + (size_t)unit * 16384;
#pragma unroll
        for (int q = 0; q < 4; ++q) { const int idx = tid + 512 * q, e = idx >> 4, dg = idx & 15; *(LAS u32x4*)(CT + e * CT_LD + dg * 8) = *(const u32x4*)(dcu + idx * 8); }
#pragma unroll
        for (int q = 0; q < 2; ++q) { const int idx = tid + 512 * q, s = idx >> 4, dg = idx & 15;
            *(LAS u32x4*)(KS + s * CT_LD + dg * 8) = *(const u32x4*)(QC + (size_t)(rowbase + s) * 1024 + 512 + h * 128 + dg * 8); }
#pragma unroll
        for (int q = 0; q < 2; ++q) { const int idx = tid + 512 * q, row = idx >> 4, cgv = idx & 15;
            const u32x4 t = *(const u32x4*)(MLV + (size_t)(rowbase + row) * 512 + h * 128 + cgv * 8);
            LAS bf16* vp = VT + (cgv * 8) * KW_LD + row;
            vp[0 * KW_LD] = (bf16)(t.x & 0xffffu); vp[1 * KW_LD] = (bf16)(t.x >> 16); vp[2 * KW_LD] = (bf16)(t.y & 0xffffu); vp[3 * KW_LD] = (bf16)(t.y >> 16);
            vp[4 * KW_LD] = (bf16)(t.z & 0xffffu); vp[5 * KW_LD] = (bf16)(t.z >> 16); vp[6 * KW_LD] = (bf16)(t.w & 0xffffu); vp[7 * KW_LD] = (bf16)(t.w >> 16); }
        if (tid < 128) NS[tid] = DN[(size_t)unit * 128 + tid];
    }
    __syncthreads();
#ifdef M3_LITE
    {
        const int lt = w & 3, eh = w >> 2, l = 16 * lt + n;
#pragma unroll
        for (int j = 0; j < 4; ++j) { const int e0 = 16 * (4 * eh + j) + 4 * g; float y[4];
#pragma unroll
            for (int i = 0; i < 4; ++i) { const int e = e0 + i;
                y[i] = 0.f;
                if (M3_LITE & 1) y[i] += __builtin_bit_cast(float, (unsigned)CT[e * CT_LD + ((l * 2 + 1) & 127)] << 16);
                if (M3_LITE & 2) y[i] += __builtin_bit_cast(float, (unsigned)KS[l * CT_LD + e] << 16);
                if (M3_LITE & 4) y[i] += __builtin_bit_cast(float, (unsigned)VT[e * KW_LD + l] << 16);
                if (M3_LITE & 8) y[i] += NS[e];
                if (M3_LITE & 16) y[i] += U[l] + R[l];
                if (M3_LITE & 32) y[i] += WINT[l] + EMR[l]; }
            const size_t off = (size_t)(rowbase + l) * 512 + h * 128 + e0;
            u32x2 ww; ww.x = pk2(y[0], y[1]); ww.y = pk2(y[2], y[3]); *(u32x2*)(MLV + off) = ww; }
        __syncthreads();
        return;
    }
#endif
    const int lt = w & 3, eh = w >> 2, l = 16 * lt + n;
    bf16x8 qf[4];
    { const bf16* qrow = QC + (size_t)(rowbase + l) * 1024 + h * 128 + 8 * g;
#pragma unroll
        for (int ks = 0; ks < 4; ++ks) qf[ks] = *(const bf16x8*)(qrow + 32 * ks); }
    const f32x4 zero4 = {0.f, 0.f, 0.f, 0.f};
    f32x4 sw[4]; const float Rl = R[l], wint = WINT[l], emr = EMR[l];
    float dsum = 0.f;
#pragma unroll
    for (int st = 0; st < 4; ++st) {
        sw[st] = zero4;
        if (st <= lt) { f32x4 acc = zero4;
#pragma unroll
            for (int ks = 0; ks < 4; ++ks) { const bf16x8 a = *(const LAS bf16x8*)(KS + (16 * st + n) * CT_LD + 32 * ks + 8 * g); acc = MFMA16(a, qf[ks], acc); }
#pragma unroll
            for (int i = 0; i < 4; ++i) { const int s = 16 * st + 4 * g + i; const float wgt = (s <= l) ? __expf(U[s] + Rl) : 0.f; sw[st][i] = acc[i] * wgt; dsum += sw[st][i]; } }
    }
    dsum += __shfl_xor(dsum, 16); dsum += __shfl_xor(dsum, 32);
    float qn = 0.f;
#pragma unroll
    for (int ks = 0; ks < 4; ++ks) { const u32x4 qq = __builtin_bit_cast(u32x4, qf[ks]); const LAS float* np = NS + 32 * ks + 8 * g;
        qn += bflo(qq.x) * np[0] + bfhi(qq.x) * np[1] + bflo(qq.y) * np[2] + bfhi(qq.y) * np[3] + bflo(qq.z) * np[4] + bfhi(qq.z) * np[5] + bflo(qq.w) * np[6] + bfhi(qq.w) * np[7]; }
    qn += __shfl_xor(qn, 16); qn += __shfl_xor(qn, 32);
    const float den = wint * qn + dsum;
    const float rden = 1.0f / fmaxf(fabsf(den), emr);
    f32x4 hv[4]; float s1 = 0.f;
#pragma unroll
    for (int j = 0; j < 4; ++j) { const int et = 4 * eh + j;
        f32x4 accS = zero4, accC = zero4;
#pragma unroll
        for (int kb = 0; kb < 2; ++kb) if (2 * kb <= lt) {
            u32x4 pw; pw.x = pk2(sw[2 * kb][0], sw[2 * kb][1]); pw.y = pk2(sw[2 * kb][2], sw[2 * kb][3]); pw.z = pk2(sw[2 * kb + 1][0], sw[2 * kb + 1][1]); pw.w = pk2(sw[2 * kb + 1][2], sw[2 * kb + 1][3]);
            const LAS bf16* vp = VT + (16 * et + n) * KW_LD + 32 * kb + 4 * g;
            const u32x2 lo = *(const LAS u32x2*)vp, hi = *(const LAS u32x2*)(vp + 16);
            u32x4 vv; vv.x = lo.x; vv.y = lo.y; vv.z = hi.x; vv.w = hi.y;
            accS = MFMA16(__builtin_bit_cast(bf16x8, vv), __builtin_bit_cast(bf16x8, pw), accS); }
#pragma unroll
        for (int ks = 0; ks < 4; ++ks) { const bf16x8 a = *(const LAS bf16x8*)(CT + (16 * et + n) * CT_LD + 32 * ks + 8 * g); accC = MFMA16(a, qf[ks], accC); }
#pragma unroll
        for (int i = 0; i < 4; ++i) { hv[j][i] = (wint * accC[i] + accS[i]) * rden; s1 += hv[j][i]; }
    }
    s1 += __shfl_xor(s1, 16); s1 += __shfl_xor(s1, 32);
    const float mloc = s1 * (1.f / 64.f); float q2 = 0.f;
#pragma unroll
    for (int j = 0; j < 4; ++j)
#pragma unroll
        for (int i = 0; i < 4; ++i) { const float dd = hv[j][i] - mloc; q2 += dd * dd; }
    q2 += __shfl_xor(q2, 16); q2 += __shfl_xor(q2, 32);
    if (g == 0) { XCH[(l * 2 + eh) * 2] = mloc; XCH[(l * 2 + eh) * 2 + 1] = q2; }
    __syncthreads();
    {
        const float mo = XCH[(l * 2 + (eh ^ 1)) * 2], qo = XCH[(l * 2 + (eh ^ 1)) * 2 + 1];
        const float mean = 0.5f * (mloc + mo), dm = mloc - mo, m2 = q2 + qo + 32.f * dm * dm;
        const float rstd = 1.0f / sqrtf(m2 * (1.f / 128.f) + LN_EPS);
#pragma unroll
        for (int j = 0; j < 4; ++j) { const int e0 = 16 * (4 * eh + j) + 4 * g;
            const f32x4 gn = *(const f32x4*)(gnorm + h * 128 + e0);
            const size_t off = (size_t)(rowbase + l) * 512 + h * 128 + e0;
            const u32x2 so = *(const u32x2*)(MLO + off);
            const float y0 = (hv[j][0] - mean) * rstd * gn[0] * bflo(so.x), y1 = (hv[j][1] - mean) * rstd * gn[1] * bfhi(so.x);
            const float y2 = (hv[j][2] - mean) * rstd * gn[2] * bflo(so.y), y3 = (hv[j][3] - mean) * rstd * gn[3] * bfhi(so.y);
            u32x2 ww; ww.x = pk2(y0, y1); ww.y = pk2(y2, y3); *(u32x2*)(MLV + off) = ww; }
    }
    __syncthreads();
}

__global__ void __launch_bounds__(NTHR, 2) fwd_kernel(Args args) {
    extern __shared__ __attribute__((aligned(16))) unsigned char lds_raw[];
    LAS unsigned char* lds = (LAS unsigned char*)lds_raw;
    cg::grid_group grid = cg::this_grid();
    const int tid = threadIdx.x, lane = tid & 63, wave = __builtin_amdgcn_readfirstlane(tid >> 6);
    const int G = gridDim.x, bx = blockIdx.x;
    const int gw = bx * NWAVES + wave, NGW = G * NWAVES;
    const int gt = bx * NTHR + tid, NGT = G * NTHR;
    unsigned char* ws = args.ws;
    const int lo = args.ph_lo, hi = args.ph_hi;
#ifndef PH_MASK
#define PH_MASK 0xfff
#endif
#define IN(k) (((PH_MASK >> (k)) & 1) && lo <= (k) && (k) < hi)
#define SEAM(k) do { if (IN(k) && IN((k) + 1)) { __builtin_amdgcn_fence(__ATOMIC_RELEASE, "agent"); asm volatile("s_waitcnt vmcnt(0) lgkmcnt(0)" ::: "memory"); grid.sync(); \
    __builtin_amdgcn_fence(__ATOMIC_ACQUIRE, "agent"); asm volatile("s_waitcnt vmcnt(0)" ::: "memory"); __syncthreads(); } } while (0)
    float* OUT = args.out;
#define PHASE_PTRS() unsigned char* wsb = ws; asm volatile("" : "+s"(wsb)); \
    bf16* WinT = (bf16*)(wsb + WS_WIN); bf16* WgaT = (bf16*)(wsb + WS_WGA); bf16* WgbT = (bf16*)(wsb + WS_WGB); bf16* WuaT = (bf16*)(wsb + WS_WUA); bf16* WubT = (bf16*)(wsb + WS_WUB); \
    bf16* WoutT = (bf16*)(wsb + WS_WOUT); bf16* Wff1T = (bf16*)(wsb + WS_WFF1); bf16* Wff2T = (bf16*)(wsb + WS_WFF2); bf16* WpgT = (bf16*)(wsb + WS_WPG); bf16* WppT = (bf16*)(wsb + WS_WPP); \
    float* COS = (float*)(wsb + WS_COS); float* SIN = (float*)(wsb + WS_SIN); float* WI = (float*)(wsb + WS_WI); float* IG = (float*)(wsb + WS_IG); float* LF = (float*)(wsb + WS_LF); \
    bf16* KA = (bf16*)(wsb + WS_KA); bf16* KI = (bf16*)(wsb + WS_KI); bf16* VAT = (bf16*)(wsb + WS_VAT); \
    float* BCUM = (float*)(wsb + WS_BCUM); float* CS = (float*)(wsb + WS_CS); float* MST = (float*)(wsb + WS_MST); float* DN = (float*)(wsb + WS_DN); \
    bf16* XB = (bf16*)(wsb + WS_XB); bf16* PB = (bf16*)(wsb + WS_PB); bf16* QA = (bf16*)(wsb + WS_QA); bf16* QI = (bf16*)(wsb + WS_QI); bf16* MLQK = (bf16*)(wsb + WS_MLQK); \
    bf16* MLV = (bf16*)(wsb + WS_MLV); bf16* MLO = (bf16*)(wsb + WS_MLO); bf16* QC = (bf16*)(wsb + WS_QC); bf16* DC = (bf16*)(wsb + WS_DC); \
    bf16* TMP = (bf16*)(wsb + WS_TMP); bf16* MRG = (bf16*)(wsb + WS_MRG); bf16* H1 = (bf16*)(wsb + WS_H1); bf16* HF = (bf16*)(wsb + WS_HF); bf16* RB = (bf16*)(wsb + WS_RB); \
    float* PROJ = (float*)(wsb + WS_PROJ); bf16* CST = (bf16*)(wsb + WS_CST); float* NST = (float*)(wsb + WS_NST); (void)CST; (void)NST; \
    (void)WinT; (void)WgaT; (void)WgbT; (void)WuaT; (void)WubT; (void)WoutT; (void)Wff1T; (void)Wff2T; (void)WpgT; (void)WppT; (void)COS; (void)SIN; (void)WI; (void)IG; (void)LF; (void)KA; (void)KI; (void)VAT; \
    (void)BCUM; (void)CS; (void)MST; (void)DN; (void)XB; (void)PB; (void)QA; (void)QI; (void)MLQK; (void)MLV; (void)MLO; (void)QC; (void)DC; (void)TMP; (void)MRG; (void)H1; (void)HF; (void)RB; (void)PROJ
#define LAUNDER_I(v) asm volatile("" : "+s"(v))

    if (IN(0)) { PHASE_PTRS();
        LAS float* scr = (LAS float*)(lds + wave * 16384);
        const float* w_in = args.in[I_WIN]; const float* x = args.in[I_X];
        constexpr int I_A = 16 * (NWIN / 32), I_G = 16 * 32, I_U = 8 * 32, I_O = 16 * 32, I_1 = 16 * 128, I_2 = 64 * 32, I_PG = 16 * 32, I_PP = 4 * 32;
        constexpr int NITEMS = I_A + 2 * I_G + 2 * I_U + I_O + I_1 + I_2 + I_PG + I_PP;
        for (int it = gw; it < NITEMS; it += NGW) {
            int r = it;
            if (r < I_A) { transpose_item(w_in, 1024, WIN_LD, WinT, NWIN, scr, r, lane, [](int n) { return win_src(n); }); continue; } r -= I_A;
            if (r < I_G) { transpose_item(w_in, 1024, WIN_LD, WgaT, 1024, scr, r, lane, [](int n) { return 3280 + n; }); continue; } r -= I_G;
            if (r < I_G) { transpose_item(w_in, 1024, WIN_LD, WgbT, 1024, scr, r, lane, [](int n) { return 4304 + n; }); continue; } r -= I_G;
            if (r < I_U) { transpose_item(args.in[I_WUA], 512, 1024, WuaT, 1024, scr, r, lane, [](int n) { return n; }); continue; } r -= I_U;
            if (r < I_U) { transpose_item(args.in[I_WUB], 512, 1024, WubT, 1024, scr, r, lane, [](int n) { return n; }); continue; } r -= I_U;
            if (r < I_O) { transpose_item(args.in[I_WOUT], 1024, 1024, WoutT, 1024, scr, r, lane, [](int n) { return n; }); continue; } r -= I_O;
            if (r < I_1) { transpose_item(args.in[I_WFF1], 1024, 4096, Wff1T, 4096, scr, r, lane, [](int n) { return n; }); continue; } r -= I_1;
            if (r < I_2) { transpose_item(args.in[I_WFF2], 4096, 1024, Wff2T, 1024, scr, r, lane, [](int n) { return n; }); continue; } r -= I_2;
            if (r < I_PG) { transpose_item(args.in[I_WPG], 1024, 1024, WpgT, 1024, scr, r, lane, [](int n) { return n; }); continue; } r -= I_PG;
            transpose_item(args.in[I_WPP], 256, 1024, WppT, 1024, scr, r, lane, [](int n) { return n; });
        }
        for (int i = gt; i < M * D / 8; i += NGT) { const f32x4 a = ((const f32x4*)x)[2 * i], b = ((const f32x4*)x)[2 * i + 1];
            u32x4 o; o.x = pk2(a[0], a[1]); o.y = pk2(a[2], a[3]); o.z = pk2(b[0], b[1]); o.w = pk2(b[2], b[3]); ((u32x4*)XB)[i] = o; }
        { const float* p = args.in[I_P];
            for (int i = gt; i < M * PLE / 8; i += NGT) { const f32x4 a = ((const f32x4*)p)[2 * i], b = ((const f32x4*)p)[2 * i + 1];
                u32x4 o; o.x = pk2(a[0], a[1]); o.y = pk2(a[2], a[3]); o.z = pk2(b[0], b[1]); o.w = pk2(b[2], b[3]); ((u32x4*)PB)[i] = o; } }
        { const int* pos = (const int*)args.in[I_POS];
            for (int i = gt; i < M * 32; i += NGT) { const int m = i >> 5, f = i & 31; const double a = (double)pos[m] * INVF[f] * 0.15915494309189535;
                const float rev = (float)(a - floor(a)); COS[i] = __builtin_amdgcn_cosf(rev); SIN[i] = __builtin_amdgcn_sinf(rev); } }
    }
    SEAM(0);
    if (IN(1)) { PHASE_PTRS();
        int Kv = D; LAUNDER_I(Kv); pg8::Gemm gm{XB, WinT, M, NWIN, Kv}; pg8::StaticOrder S; S.init(M, NWIN, G, bx);
        EpiWin E{QA, QI, KA, KI, VAT, MLQK, MLV, MLO, WI, IG, LF, COS, SIN, args.in[I_BIG], args.in[I_BFG]};
        pg8::gemm_phase<EpiWin, pg8::StaticOrder, true, true>(lds, gm, S, E);
    }
    SEAM(1);
    if (IN(2)) { PHASE_PTRS();
#ifdef NO_MIXA
        for (int i = gt; i < M * 512 / 8; i += NGT) ((u32x4*)QA)[i] = (u32x4){0u, 0u, 0u, 0u};
#else
        for (int pr = bx; pr < NB * 64; pr += G) { const int b = pr >> 6, j = pr & 63;
            mixa_unit(QI, KI, WI, QA, KA, VAT, lds, b, 127 - j);
            mixa_unit(QI, KI, WI, QA, KA, VAT, lds, b, j); }
#endif
        for (int u = bx; u < 2048; u += G) m1_unit(MLQK, MLV, IG, LF, args.in[I_CONVW], args.in[I_CONVB], QC, DC, DN, BCUM, CS, lds, u);
    }
    SEAM(2);
    if (IN(3)) { PHASE_PTRS();
        for (int item = gt; item < 64 * 2048; item += NGT) { const int bh = item >> 11, rem = item & 2047;
            float st[8] = {0.f, 0.f, 0.f, 0.f, 0.f, 0.f, 0.f, 0.f}; float m = 0.f;
#pragma unroll 4
            for (int c = 0; c < 32; ++c) { const float bl = CS[(bh * 32 + c) * 2], mg = CS[(bh * 32 + c) * 2 + 1];
                const float mn = fmaxf(bl + m, mg), a = __expf(bl + m - mn), s = __expf(mg - mn); m = mn;
                const u32x4 d = *(const u32x4*)(DC + (size_t)(bh * 32 + c) * 16384 + rem * 8);
                u32x4 o; o.x = pk2(st[0], st[1]); o.y = pk2(st[2], st[3]); o.z = pk2(st[4], st[5]); o.w = pk2(st[6], st[7]); *(u32x4*)(CST + (size_t)(bh * 32 + c) * 16384 + rem * 8) = o;
                st[0] = a * st[0] + s * bflo(d.x); st[1] = a * st[1] + s * bfhi(d.x); st[2] = a * st[2] + s * bflo(d.y); st[3] = a * st[3] + s * bfhi(d.y);
                st[4] = a * st[4] + s * bflo(d.z); st[5] = a * st[5] + s * bfhi(d.z); st[6] = a * st[6] + s * bflo(d.w); st[7] = a * st[7] + s * bfhi(d.w); } }
        for (int item = gt; item < 64 * 128; item += NGT) { const int bh = item >> 7, dd = item & 127; float st = 0.f, m = 0.f;
            for (int c = 0; c < 32; ++c) { const float bl = CS[(bh * 32 + c) * 2], mg = CS[(bh * 32 + c) * 2 + 1];
                if (dd == 0) MST[bh * 32 + c] = m;
                const float mn = fmaxf(bl + m, mg), a = __expf(bl + m - mn), s = __expf(mg - mn); m = mn;
                const float d = DN[(size_t)(bh * 32 + c) * 128 + dd]; NST[(size_t)(bh * 32 + c) * 128 + dd] = st; st = a * st + s * d; } }
    }
    SEAM(3);
    if (IN(4)) { PHASE_PTRS();
        for (int u = bx; u < 2048; u += G) m3_unit(QC, MLV, MLO, IG, BCUM, MST, CST, NST, args.in[I_MLNG], lds, u);
    }
    SEAM(4);
    if (IN(5)) { PHASE_PTRS();
        pg8::StaticOrder S; S.init(M, D, G, bx);
        { int Kv = D; LAUNDER_I(Kv); pg8::Gemm gm{XB, WgaT, M, D, Kv}; EpiB<0> E{TMP, nullptr, nullptr, nullptr, D}; pg8::gemm_phase<EpiB<0>, pg8::StaticOrder, true, true>(lds, gm, S, E); }
        { int Kv = 512; LAUNDER_I(Kv); pg8::Gemm gm{QA, WuaT, M, D, Kv}; EpiB<1> E{nullptr, OUT, TMP, nullptr, D}; pg8::gemm_phase<EpiB<1>, pg8::StaticOrder, true, true>(lds, gm, S, E); }
        { int Kv = D; LAUNDER_I(Kv); pg8::Gemm gm{XB, WgbT, M, D, Kv}; EpiB<0> E{TMP, nullptr, nullptr, nullptr, D}; pg8::gemm_phase<EpiB<0>, pg8::StaticOrder, true, true>(lds, gm, S, E); }
        { int Kv = 512; LAUNDER_I(Kv); pg8::Gemm gm{MLV, WubT, M, D, Kv}; EpiB<2> E{MRG, nullptr, TMP, OUT, D}; pg8::gemm_phase<EpiB<2>, pg8::StaticOrder, true, true>(lds, gm, S, E); }
    }
    SEAM(5);
    if (IN(6)) { PHASE_PTRS();
        pg8::StaticOrder S; S.init(M, D, G, bx);
        int Kv = D; LAUNDER_I(Kv); pg8::Gemm gm{MRG, WoutT, M, D, Kv}; EpiF<0> E{OUT, nullptr, args.in[I_X], nullptr, D}; pg8::gemm_phase<EpiF<0>, pg8::StaticOrder, true, true>(lds, gm, S, E);
    }
    SEAM(6);
    if (IN(7)) { PHASE_PTRS(); for (int m = gw; m < M; m += NGW) ln_row<true>(OUT + (size_t)m * D, args.in[I_LN1G], args.in[I_LN1B], nullptr, H1 + (size_t)m * D, lane); }
    SEAM(7);
    if (IN(8)) { PHASE_PTRS();
        pg8::StaticOrder S; S.init(M, FF, G, bx);
        int Kv = D; LAUNDER_I(Kv); pg8::Gemm gm{H1, Wff1T, M, FF, Kv}; EpiB<3> E{HF, nullptr, nullptr, nullptr, FF}; pg8::gemm_phase<EpiB<3>, pg8::StaticOrder, true, true>(lds, gm, S, E);
    }
    SEAM(8);
    if (IN(9)) { PHASE_PTRS();
        pg8::StaticOrder S; S.init(M, D, G, bx);
        int Kv = FF; LAUNDER_I(Kv); pg8::Gemm gm{HF, Wff2T, M, D, Kv}; EpiF<1> E{OUT, RB, nullptr, H1, D}; pg8::gemm_phase<EpiF<1>, pg8::StaticOrder, true, true>(lds, gm, S, E);
    }
    SEAM(9);
    if (IN(10)) { PHASE_PTRS();
        pg8::StaticOrder S; S.init(M, D, G, bx);
#if !defined(P10_ONLY) || P10_ONLY == 1
        { int Kv = PLE; LAUNDER_I(Kv); pg8::Gemm gm{PB, WppT, M, D, Kv}; EpiF<2> E{PROJ, nullptr, nullptr, nullptr, D}; pg8::gemm_phase<EpiF<2>, pg8::StaticOrder, true, true>(lds, gm, S, E); }
#endif
#if !defined(P10_ONLY) || P10_ONLY == 2
        { int Kv = D; LAUNDER_I(Kv); pg8::Gemm gm{RB, WpgT, M, D, Kv}; EpiF<3> E{OUT, nullptr, PROJ, nullptr, D}; pg8::gemm_phase<EpiF<3>, pg8::StaticOrder, true, true>(lds, gm, S, E); }
#endif
    }
    SEAM(10);
    if (IN(11)) { PHASE_PTRS(); for (int m = gw; m < M; m += NGW) ln_row<false>(OUT + (size_t)m * D, args.in[I_LN2G], args.in[I_LN2B], OUT + (size_t)m * D, nullptr, lane); }
#undef IN
#undef SEAM
}

extern "C" void kernel_launch(void* const* d_in, const int* in_sizes, int n_in, void* d_out, int out_size, void* d_ws, size_t ws_size, hipStream_t stream) {
    static int grid = 0;
    if (grid == 0) {
        if (n_in != 20 || out_size != M * D || ws_size < WS_END) { fprintf(stderr, "kernel_launch: unexpected problem shape (n_in %d, out %d, ws %zu)\n", n_in, out_size, ws_size); grid = -1; return; }
        int dev = 0, cus = 0, per_cu = 0;
        hipGetDevice(&dev); hipDeviceGetAttribute(&cus, hipDeviceAttributeMultiprocessorCount, dev);
        if (hipFuncSetAttribute((const void*)fwd_kernel, hipFuncAttributeMaxDynamicSharedMemorySize, LDS_BYTES) != hipSuccess) { fprintf(stderr, "kernel_launch: hipFuncSetAttribute failed\n"); grid = -1; return; }
        if (hipOccupancyMaxActiveBlocksPerMultiprocessor(&per_cu, (const void*)fwd_kernel, NTHR, LDS_BYTES) != hipSuccess || per_cu < 1) { fprintf(stderr, "kernel_launch: occupancy query says %d\n", per_cu); per_cu = 1; }
        (void)hipGetLastError();
        grid = cus * (per_cu > 1 ? 1 : per_cu);
        if (grid <= 0) { grid = -1; return; }
    }
    if (grid < 0) return;
    Args a{};
    for (int i = 0; i < 20; ++i) a.in[i] = (const float*)d_in[i];
    a.out = (float*)d_out; a.ws = (unsigned char*)d_ws;
#if MK_ONE
    a.ph_lo = 0; a.ph_hi = NPHASE;
    void* params[] = {&a};
    hipError_t e = hipLaunchCooperativeKernel((const void*)fwd_kernel, dim3(grid), dim3(NTHR), params, LDS_BYTES, stream);
    if (e != hipSuccess) fprintf(stderr, "cooperative launch failed: %s (grid %d)\n", hipGetErrorString(e), grid);
#else
    for (int ph = 0; ph < NPHASE; ++ph) { a.ph_lo = ph; a.ph_hi = ph + 1; hipLaunchKernelGGL(fwd_kernel, dim3(grid), dim3(NTHR), LDS_BYTES, stream, a); }
#endif
}
```

```cpp
#include <hip/hip_runtime.h>
#include <hip/hip_cooperative_groups.h>
#include <cstdio>
#include <cstdint>
namespace cg = cooperative_groups;
#define MK_ONE 1
namespace pg8 {
#define PG8_LAS __attribute__((address_space(3)))
typedef unsigned short bf16_t;
typedef short bf16x8 __attribute__((ext_vector_type(8)));
typedef float f32x4 __attribute__((ext_vector_type(4)));
typedef unsigned u32x4 __attribute__((ext_vector_type(4)));
constexpr int BM = 256, BK = 64, HALF = 128, HTB = HALF * BK * 2  , STAGE_BYTES = 8 * HTB, NXCD = 8, WGM = 8;

__host__ __device__ __forceinline__ int lds_byte(int r, int c) { const int st = (r >> 4) * 2 + (c >> 5), rr = r & 15, cc = c & 31, ob = rr * 64 + cc * 2; return st * 1024 + (ob ^ (((ob >> 9) & 1) << 5)); }
__host__ __device__ __forceinline__ void stage_rc(int b, int& R, int& C) { const int st = b / 1024, sb = b % 1024, swz = sb ^ (((sb >> 9) & 1) << 5); R = (st >> 1) * 16 + swz / 64; C = (st & 1) * 32 + (swz % 64) / 2; }
__host__ __device__ __forceinline__ int perm32(int rho) { const int n = rho >> 4, i = rho & 15; return 8 * (i >> 2) + 4 * n + (i & 3); }

struct Unit { int pm, pn; };
struct Gemm { const bf16_t* A; const bf16_t* Bt; int M, N, K; };

struct StaticOrder {
    int nM, nN, nwg, G, c;
    __host__ __device__ void init(int M, int N, int G_, int c_) { nM = M / BM; nN = N / BM; nwg = nM * nN; G = G_; c = c_; }
    __host__ __device__ bool next(int i, Unit& u) const {
        const long L = (long)i * G + c; if (L >= nwg) return false;
        int wgid = (int)L; { const int q = nwg / NXCD, r = nwg % NXCD, xcd = wgid % NXCD, off = wgid / NXCD; wgid = (xcd < r ? xcd * (q + 1) : r * (q + 1) + (xcd - r) * q) + off; }
        const int nig = WGM * nN, gid = wgid / nig, fm = gid * WGM, gsz = (nM - fm) < WGM ? (nM - fm) : WGM;
        u.pm = fm + ((wgid % nig) % gsz); u.pn = (wgid % nig) / gsz; return true;
    }
    __device__ __forceinline__ void a_ready(const Unit&) const {}
    __device__ __forceinline__ void done(const Unit&) const {}
};

__device__ __forceinline__ unsigned cvt_pk_bf16(float lo, float hi) { unsigned r; asm volatile("v_cvt_pk_bf16_f32 %0, %1, %2" : "=v"(r) : "v"(lo), "v"(hi)); return r; }
template <class Epi, class Sched, bool ALIGN_EPI = false, bool SP2 = false>
__device__ __forceinline__ void gemm_phase(PG8_LAS unsigned char* lds, const Gemm g, const Sched& S, const Epi& E) {
    const int tid = threadIdx.x, wid = __builtin_amdgcn_readfirstlane(tid >> 6), lane = tid & 63, wr = wid >> 2, wc = wid & 3, fr = lane & 15, fq = lane >> 4;
    const int K = g.K, nt = K / BK;
    unsigned voffA[2], voffB[2];
#pragma unroll
    for (int i = 0; i < 2; ++i) { int R, C; stage_rc(tid * 16 + i * 8192, R, C); const int Rb = Epi::PERM ? ((R & ~31) + perm32(R & 31)) : R;
        voffA[i] = (unsigned)(R * K + C) * 2u; voffB[i] = (unsigned)(Rb * K + C) * 2u; }
    const size_t kstep = (size_t)(BK * 2);
    const size_t hstep = (size_t)HALF * K * 2;
    const size_t tstep = 2 * hstep;
    const unsigned ldsw = (unsigned)wid * 1024u;
    const int aoff = lds_byte(wr * 64 + fr, fq * 8), boff = lds_byte(wc * 32 + fr, fq * 8);
#define PG8_SA(b, h) (((b) * 2 + (h)) * HTB)
#define PG8_SB(b, h) ((4 + (b) * 2 + (h)) * HTB)
#define PG8_STAGE(bufoff, gbase, voff) do { _Pragma("unroll") for (int _i = 0; _i < 2; ++_i) \
        __builtin_amdgcn_global_load_lds((const unsigned*)((const char*)(gbase) + (voff)[_i]), (PG8_LAS unsigned*)(lds + (bufoff) + ldsw + _i * 8192), 16, 0, 0); } while (0)
#define PG8_LDA(dst, b, h) do { _Pragma("unroll") for (int m = 0; m < 4; ++m) _Pragma("unroll") for (int k = 0; k < 2; ++k) dst[m][k] = *(const PG8_LAS bf16x8*)(lds + PG8_SA(b, h) + aoff + m * 2048 + k * 1024); } while (0)
#define PG8_LDB(dst, b, h) do { _Pragma("unroll") for (int n = 0; n < 2; ++n) _Pragma("unroll") for (int k = 0; k < 2; ++k) dst[n][k] = *(const PG8_LAS bf16x8*)(lds + PG8_SB(b, h) + boff + n * 2048 + k * 1024); } while (0)
#define PG8_MMA(ai, bj, At, Bt) do { __builtin_amdgcn_s_setprio(1); _Pragma("unroll") for (int m = 0; m < 4; ++m) _Pragma("unroll") for (int n = 0; n < 2; ++n) _Pragma("unroll") for (int k = 0; k < 2; ++k) \
        acc[ai][bj][m][n] = __builtin_amdgcn_mfma_f32_16x16x32_bf16(Bt[n][k], At[m][k], acc[ai][bj][m][n], 0, 0, 0); __builtin_amdgcn_s_setprio(0); } while (0)
#define PG8_WAIT_V(n) asm volatile("s_waitcnt vmcnt(" #n ")" ::: "memory")
#define PG8_WAIT_L(n) asm volatile("s_waitcnt lgkmcnt(" #n ")" ::: "memory")
#define PG8_BAR __builtin_amdgcn_s_barrier()
#define PG8_SCHED __builtin_amdgcn_sched_barrier(0)
    Unit cur, nxt; int ui = 0;
    if (!S.next(0, cur)) return;
    f32x4 acc[2][2][4][2];
#pragma unroll
    for (int a = 0; a < 2; ++a)
#pragma unroll
        for (int b = 0; b < 2; ++b)
#pragma unroll
            for (int m = 0; m < 4; ++m)
#pragma unroll
                for (int n = 0; n < 2; ++n) acc[a][b][m][n] = (f32x4){0.f, 0.f, 0.f, 0.f};
    bf16x8 At[4][2], B0[2][2], B1[2][2];
    const char* cA = (const char*)g.A + (size_t)cur.pm * tstep; const char* cB = (const char*)g.Bt + (size_t)cur.pn * tstep;
    S.a_ready(cur);
    if constexpr (SP2) {
        PG8_STAGE(PG8_SB(0, 0), cB, voffB); PG8_STAGE(PG8_SB(0, 1), cB + hstep, voffB); PG8_STAGE(PG8_SA(0, 0), cA, voffA); PG8_STAGE(PG8_SA(0, 1), cA + hstep, voffA);
        if (wr == 1) PG8_BAR;
        PG8_WAIT_V(2); PG8_BAR;
        PG8_STAGE(PG8_SB(1, 0), cB + kstep, voffB); PG8_STAGE(PG8_SA(1, 0), cA + kstep, voffA); PG8_STAGE(PG8_SB(1, 1), cB + hstep + kstep, voffB);
        PG8_WAIT_V(6); PG8_BAR;
    } else {
        PG8_STAGE(PG8_SB(0, 0), cB, voffB); PG8_STAGE(PG8_SA(0, 0), cA, voffA); PG8_STAGE(PG8_SB(0, 1), cB + hstep, voffB); PG8_STAGE(PG8_SA(0, 1), cA + hstep, voffA);
        if (wr == 1) PG8_BAR;
        PG8_WAIT_V(4); PG8_BAR;
        PG8_STAGE(PG8_SB(1, 0), cB + kstep, voffB); PG8_STAGE(PG8_SA(1, 0), cA + kstep, voffA); PG8_STAGE(PG8_SB(1, 1), cB + hstep + kstep, voffB);
        PG8_WAIT_V(6); PG8_BAR;
    }
    for (;;) {
        const bool has_next = S.next(ui + 1, nxt);
        const char* nA = has_next ? (const char*)g.A + (size_t)nxt.pm * tstep : cA; const char* nB = has_next ? (const char*)g.Bt + (size_t)nxt.pn * tstep : cB;
        for (int t = 0; t < nt; t += 2) {
            const bool last = (t == nt - 2);
            const char* a1 = cA + (size_t)(t + 1) * kstep;
            const char* a2 = last ? nA : cA + (size_t)(t + 2) * kstep; const char* b2 = last ? nB : cB + (size_t)(t + 2) * kstep;
            const char* a3 = a2 + kstep; const char* b3 = b2 + kstep;
            if (last && has_next) S.a_ready(nxt);
            if constexpr (SP2) {
            PG8_LDB(B0, 0, 0); PG8_LDB(B1, 0, 1); PG8_SCHED; PG8_LDA(At, 0, 0); PG8_STAGE(PG8_SA(1, 1), a1 + hstep, voffA);
            PG8_WAIT_V(8); PG8_WAIT_L(0); PG8_BAR; PG8_MMA(0, 0, At, B0); PG8_MMA(0, 1, At, B1); PG8_BAR; PG8_SCHED;
            PG8_LDA(At, 0, 1); PG8_STAGE(PG8_SB(0, 0), b2, voffB); PG8_STAGE(PG8_SB(0, 1), b2 + hstep, voffB); PG8_STAGE(PG8_SA(0, 0), a2, voffA);
            PG8_WAIT_V(8); PG8_WAIT_L(0); PG8_BAR; PG8_MMA(1, 0, At, B0); PG8_MMA(1, 1, At, B1); PG8_BAR; PG8_SCHED;
            PG8_LDB(B0, 1, 0); PG8_LDB(B1, 1, 1); PG8_SCHED; PG8_LDA(At, 1, 0); PG8_STAGE(PG8_SA(0, 1), a2 + hstep, voffA);
            PG8_WAIT_V(8); PG8_WAIT_L(0); PG8_BAR; PG8_MMA(0, 0, At, B0); PG8_MMA(0, 1, At, B1); PG8_BAR; PG8_SCHED;
            PG8_LDA(At, 1, 1); PG8_STAGE(PG8_SB(1, 0), b3, voffB); PG8_STAGE(PG8_SB(1, 1), b3 + hstep, voffB); PG8_STAGE(PG8_SA(1, 0), a3, voffA);
            PG8_WAIT_V(8); PG8_WAIT_L(0); PG8_BAR; PG8_MMA(1, 0, At, B0); PG8_MMA(1, 1, At, B1); PG8_BAR; PG8_SCHED;
            } else {
            PG8_LDB(B0, 0, 0); PG8_SCHED; PG8_LDA(At, 0, 0); PG8_STAGE(PG8_SA(1, 1), a1 + hstep, voffA);
            PG8_WAIT_L(8); PG8_BAR; PG8_WAIT_L(0); PG8_MMA(0, 0, At, B0); PG8_BAR; PG8_SCHED;
            PG8_LDB(B1, 0, 1); PG8_STAGE(PG8_SB(0, 0), b2, voffB);
            PG8_BAR; PG8_WAIT_L(0); PG8_MMA(0, 1, At, B1); PG8_BAR;
            PG8_LDA(At, 0, 1); PG8_STAGE(PG8_SA(0, 0), a2, voffA);
            PG8_BAR; PG8_WAIT_L(0); PG8_MMA(1, 0, At, B0); PG8_BAR; PG8_SCHED;
            PG8_STAGE(PG8_SB(0, 1), b2 + hstep, voffB);
            PG8_WAIT_V(6); PG8_BAR; PG8_MMA(1, 1, At, B1); PG8_BAR;
            PG8_LDB(B0, 1, 0); PG8_SCHED; PG8_LDA(At, 1, 0); PG8_STAGE(PG8_SA(0, 1), a2 + hstep, voffA);
            PG8_WAIT_L(8); PG8_BAR; PG8_WAIT_L(0); PG8_MMA(0, 0, At, B0); PG8_BAR; PG8_SCHED;
            PG8_LDB(B1, 1, 1); PG8_STAGE(PG8_SB(1, 0), b3, voffB);
            PG8_BAR; PG8_WAIT_L(0); PG8_MMA(0, 1, At, B1); PG8_BAR;
            PG8_LDA(At, 1, 1); PG8_STAGE(PG8_SA(1, 0), a3, voffA);
            PG8_BAR; PG8_WAIT_L(0); PG8_MMA(1, 0, At, B0); PG8_BAR; PG8_SCHED;
            PG8_STAGE(PG8_SB(1, 1), b3 + hstep, voffB);
            PG8_WAIT_V(6); PG8_BAR; PG8_MMA(1, 1, At, B1); PG8_BAR;
            }
        }
        if constexpr (ALIGN_EPI) { if (wr == 0) PG8_BAR; }
        if constexpr (!Epi::AFTER_DRAIN) { E(acc, cur, wr, wc, fr, fq); S.done(cur); }
        if (!has_next) break;
#pragma unroll
        for (int a = 0; a < 2; ++a)
#pragma unroll
            for (int b = 0; b < 2; ++b)
#pragma unroll
                for (int m = 0; m < 4; ++m)
#pragma unroll
                    for (int n = 0; n < 2; ++n) acc[a][b][m][n] = (f32x4){0.f, 0.f, 0.f, 0.f};
        cur = nxt; cA = nA; cB = nB; ++ui;
        if constexpr (ALIGN_EPI) { if (wr == 1) PG8_BAR; }
    }
    PG8_WAIT_V(0);
    if constexpr (!ALIGN_EPI) { if (wr == 0) PG8_BAR; }
    PG8_BAR;
    if constexpr (Epi::AFTER_DRAIN) { E.fused(acc, cur, wr, wc, fr, fq, lds, wid, lane); S.done(cur); }
#undef PG8_SA
#undef PG8_SB
#undef PG8_STAGE
#undef PG8_LDA
#undef PG8_LDB
#undef PG8_MMA
#undef PG8_WAIT_V
#undef PG8_WAIT_L
#undef PG8_BAR
#undef PG8_SCHED
}
}

#ifndef MK_ONE
#define MK_ONE 1
#endif
#define GAS __attribute__((address_space(1)))
#define LAS __attribute__((address_space(3)))
typedef unsigned short bf16;
typedef short bf16x8 __attribute__((ext_vector_type(8)));
typedef float f32x4 __attribute__((ext_vector_type(4)));
typedef unsigned u32x4 __attribute__((ext_vector_type(4)));
typedef unsigned u32x2 __attribute__((ext_vector_type(2)));

constexpr int NWAVES = 8, NTHR = 512;
constexpr int M = 32768, SEQ = 2048, NB = 16, D = 1024, FF = 4096, PLE = 256;
constexpr int NWIN = 3328, WIN_LD = 5328;
constexpr float LN_EPS = 1e-5f;
constexpr float ALPHA = 1.189207115002721f;
constexpr float IDX_W_SCALE = 0.04419417382415922f;
constexpr float QA_SCALE = 0.125f * 1.4426950408889634f;
constexpr float MLK_SCALE = 0.08838834764831845f;
constexpr int LDS_BYTES = 147456;
constexpr int NPHASE = 12;

constexpr size_t MiB = 1u << 20;
constexpr size_t WS_WIN = 1 * MiB, WS_WGA = 8 * MiB, WS_WGB = 10 * MiB, WS_WUA = 12 * MiB, WS_WUB = 13 * MiB, WS_WOUT = 14 * MiB,
                 WS_WFF1 = 16 * MiB, WS_WFF2 = 24 * MiB, WS_WPG = 32 * MiB, WS_WPP = 34 * MiB;
constexpr size_t WS_COS = 35 * MiB, WS_SIN = 39 * MiB, WS_WI = 43 * MiB, WS_IG = 44 * MiB, WS_LF = 44 * MiB + 512 * 1024;
constexpr size_t WS_KA = 45 * MiB, WS_KI = 49 * MiB, WS_VAT = 53 * MiB;
constexpr size_t WS_BCUM = 57 * MiB, WS_CS = 58 * MiB, WS_MST = 59 * MiB, WS_DN = 60 * MiB, WS_NST = 61 * MiB, WS_CST = 208 * MiB;
constexpr size_t WS_XB = 64 * MiB, WS_PB = 128 * MiB, WS_QA = 144 * MiB, WS_QI = 176 * MiB, WS_MLQK = 208 * MiB, WS_MLV = 272 * MiB,
                 WS_MLO = 304 * MiB, WS_QC = 336 * MiB, WS_DC = 400 * MiB, WS_END = 464 * MiB;
constexpr size_t WS_TMP = 336 * MiB, WS_MRG = 400 * MiB, WS_H1 = 64 * MiB, WS_HF = 144 * MiB, WS_RB = 400 * MiB, WS_PROJ = 144 * MiB;

__device__ __forceinline__ unsigned f2bf(float f) { unsigned u = __builtin_bit_cast(unsigned, f); return (u + 0x7fffu + ((u >> 16) & 1u)) >> 16; }
typedef float f32x2_t __attribute__((ext_vector_type(2)));
typedef __bf16 bf16x2_t __attribute__((ext_vector_type(2)));
__device__ __forceinline__ unsigned pk2(float lo, float hi) { f32x2_t v = {lo, hi}; bf16x2_t b = __builtin_convertvector(v, bf16x2_t); return __builtin_bit_cast(unsigned, b); }
__device__ __forceinline__ float bflo(unsigned w) { return __builtin_bit_cast(float, w << 16); }
__device__ __forceinline__ float bfhi(unsigned w) { return __builtin_bit_cast(float, w & 0xffff0000u); }
__device__ __forceinline__ float sigmoidf_(float x) { return __builtin_amdgcn_rcpf(1.0f + __expf(-x)); }
#define LDS_WAIT() asm volatile("s_waitcnt lgkmcnt(0)" ::: "memory")

__constant__ double INVF[32] = {1.0, 0.7498942093324559, 0.5623413251903491, 0.4216965034285822, 0.31622776601683794, 0.23713737056616552, 0.1778279410038923, 0.1333521432163324,
    0.1, 0.07498942093324558, 0.05623413251903491, 0.042169650342858224, 0.03162277660168379, 0.023713737056616554, 0.01778279410038923, 0.01333521432163324,
    0.01, 0.007498942093324558, 0.005623413251903491, 0.004216965034285823, 0.0031622776601683794, 0.0023713737056616554, 0.0017782794100389228, 0.001333521432163324,
    0.001, 0.0007498942093324559, 0.0005623413251903491, 0.00042169650342858224, 0.00031622776601683794, 0.00023713737056616554, 0.00017782794100389227, 0.0001333521432163324};

struct Args {
    const float* in[20]; float* out; unsigned char* ws; int ph_lo, ph_hi;
};
enum { I_X = 0, I_P, I_POS, I_WIN, I_CONVW, I_CONVB, I_BIG, I_BFG, I_MLNG, I_WUA, I_WUB, I_WOUT, I_LN1G, I_LN1B, I_WFF1, I_WFF2, I_WPG, I_WPP, I_LN2G, I_LN2B };

__device__ __forceinline__ int win_src(int n) {
    if (n < 512) { const int hh = n >> 6, j = n & 63; return hh * 64 + (j >> 1) + 32 * (j & 1); }
    if (n < 1024) { const int mm = n - 512, hh = mm >> 6, j = mm & 63; return 640 + hh * 64 + (j >> 1) + 32 * (j & 1); }
    if (n < 1280) { const int mm = n - 1024;
        if (mm < 64) return 512 + (mm >> 1) + 32 * (mm & 1);
        if (mm < 128) { const int j = mm - 64; return 1152 + (j >> 1) + 32 * (j & 1); }
        if (mm < 192) return 576 + (mm - 128);
        if (mm < 200) return 1216 + (mm - 192);
        if (mm < 204) return 2760 + (mm - 200);
        if (mm < 208) return 2764 + (mm - 204);
        return -1; }
    if (n < 2304) return 1224 + (n - 1280);
    if (n < 2816) return 2248 + (n - 2304);
    return 2768 + (n - 2816);
}

template <class SrcF>
__device__ __forceinline__ void transpose_item(const float* W, int K, int ldw, bf16* WT, int Nrows, LAS float* scr, int item, int lane, SrcF src) {
    const int nblk = Nrows / 32, kb = item / nblk, nb = item % nblk, k0 = 64 * kb, n0 = 32 * nb;
    const int sc = src(n0 + (lane & 31));
#pragma unroll 8
    for (int i = 0; i < 32; ++i) { const int kk = 2 * i + (lane >> 5); scr[kk * 33 + (lane & 31)] = sc >= 0 ? W[(size_t)(k0 + kk) * ldw + sc] : 0.f; }
    LDS_WAIT(); asm volatile("" ::: "memory");
    const int c = lane & 7;
#pragma unroll
    for (int j = 0; j < 4; ++j) { const int n = (lane >> 3) + 8 * j; const LAS float* s = scr + (8 * c) * 33 + n;
        u32x4 o; o.x = pk2(s[0 * 33], s[1 * 33]); o.y = pk2(s[2 * 33], s[3 * 33]); o.z = pk2(s[4 * 33], s[5 * 33]); o.w = pk2(s[6 * 33], s[7 * 33]);
        *(u32x4*)(WT + (size_t)(n0 + n) * K + k0 + 8 * c) = o; }
    LDS_WAIT(); asm volatile("" ::: "memory");
}

struct EpiWin {
    static constexpr bool PERM = true, AFTER_DRAIN = false;
    bf16 *QA, *QI, *KA, *KI, *VAT, *MLQK, *MLV, *MLO; float *WI, *IG, *LF; const float *COS, *SIN, *b_ig, *b_fg;
    __device__ __forceinline__ void operator()(const f32x4 (&acc)[2][2][4][2], const pg8::Unit& u, int wr, int wc, int fr, int fq) const {
        const int pn = u.pn, row0 = u.pm * 256 + wr * 64 + fr;
#pragma unroll
        for (int ai = 0; ai < 2; ++ai)
#pragma unroll
            for (int m = 0; m < 4; ++m) { const int r = row0 + ai * 128 + m * 16;
#pragma unroll
                for (int bj = 0; bj < 2; ++bj) { const int cl = bj * 128 + wc * 32 + 8 * fq; f32x4 v0 = acc[ai][bj][m][0], v1 = acc[ai][bj][m][1];
                    const bool rope = (pn < 4) || (pn == 4 && cl < 128);
                    if (rope) {
                        const int i0 = (cl & 63) >> 1;
                        const f32x4 c = *(const f32x4*)(COS + (unsigned)r * 32 + i0), s = *(const f32x4*)(SIN + (unsigned)r * 32 + i0);
                        const float sc = (pn < 2) ? QA_SCALE : 1.0f;
                        f32x4 o0, o1;
                        o0[0] = (v0[0] * c[0] - v0[1] * s[0]) * sc; o0[1] = (v0[1] * c[0] + v0[0] * s[0]) * sc;
                        o0[2] = (v0[2] * c[1] - v0[3] * s[1]) * sc; o0[3] = (v0[3] * c[1] + v0[2] * s[1]) * sc;
                        o1[0] = (v1[0] * c[2] - v1[1] * s[2]) * sc; o1[1] = (v1[1] * c[2] + v1[0] * s[2]) * sc;
                        o1[2] = (v1[2] * c[3] - v1[3] * s[3]) * sc; o1[3] = (v1[3] * c[3] + v1[2] * s[3]) * sc;
                        bf16* dst;
                        if (pn < 2) dst = QA + (unsigned)r * 512 + pn * 256 + cl;
                        else if (pn < 4) dst = QI + (unsigned)r * 512 + (pn - 2) * 256 + cl;
                        else dst = (cl < 64) ? (KA + (unsigned)r * 64 + cl) : (KI + (unsigned)r * 64 + (cl - 64));
                        u32x4 w; w.x = pk2(o0[0], o0[1]); w.y = pk2(o0[2], o0[3]); w.z = pk2(o1[0], o1[1]); w.w = pk2(o1[2], o1[3]);
                        *(u32x4*)dst = w;
                    } else if (pn == 4) {
                        if (cl < 192) { const int d0 = cl - 128, b = r >> 11, t = r & 2047; bf16* base = VAT + ((unsigned)(b * 64 + d0)) * 2048 + t;
#pragma unroll
                            for (int j = 0; j < 4; ++j) { base[(unsigned)j * 2048] = (bf16)f2bf(v0[j]); base[(unsigned)(j + 4) * 2048] = (bf16)f2bf(v1[j]); } }
                        else if (cl == 192) { *(f32x4*)(WI + (unsigned)r * 8) = v0 * IDX_W_SCALE; *(f32x4*)(WI + (unsigned)r * 8 + 4) = v1 * IDX_W_SCALE; }
                        else if (cl == 200) { f32x4 ig, lf;
#pragma unroll
                            for (int j = 0; j < 4; ++j) { ig[j] = v0[j] + b_ig[j]; const float f = v1[j] + b_fg[j]; lf[j] = fminf(f, 0.f) - log1pf(__expf(-fabsf(f))); }
                            *(f32x4*)(IG + (unsigned)r * 4) = ig; *(f32x4*)(LF + (unsigned)r * 4) = lf; }
                    } else {
                        bf16* dst;
                        if (pn < 9) dst = MLQK + (unsigned)r * 1024 + (pn - 5) * 256 + cl;
                        else if (pn < 11) dst = MLV + (unsigned)r * 512 + (pn - 9) * 256 + cl;
                        else { dst = MLO + (unsigned)r * 512 + (pn - 11) * 256 + cl;
#pragma unroll
                            for (int j = 0; j < 4; ++j) { v0[j] = sigmoidf_(v0[j]); v1[j] = sigmoidf_(v1[j]); } }
                        u32x4 w; w.x = pk2(v0[0], v0[1]); w.y = pk2(v0[2], v0[3]); w.z = pk2(v1[0], v1[1]); w.w = pk2(v1[2], v1[3]);
                        *(u32x4*)dst = w;
                    }
                }
                asm volatile("" ::: "memory"); }
    }
};

template <int MODE> struct EpiB {
    static constexpr bool PERM = true, AFTER_DRAIN = false;
    bf16* O; float* OF; const bf16* IB; const float* IF; int ldc;
    __device__ __forceinline__ void operator()(const f32x4 (&acc)[2][2][4][2], const pg8::Unit& u, int wr, int wc, int fr, int fq) const {
        const int row0 = u.pm * 256 + wr * 64 + fr, col0 = u.pn * 256 + wc * 32 + 8 * fq;
#pragma unroll
        for (int ai = 0; ai < 2; ++ai)
#pragma unroll
            for (int m = 0; m < 4; ++m) { const unsigned ro = (unsigned)(row0 + ai * 128 + m * 16) * ldc + col0;
#pragma unroll
                for (int bj = 0; bj < 2; ++bj) { const unsigned off = ro + bj * 128; f32x4 v0 = acc[ai][bj][m][0], v1 = acc[ai][bj][m][1];
                    if (MODE == 0) {
#pragma unroll
                        for (int j = 0; j < 4; ++j) { v0[j] = sigmoidf_(v0[j]); v1[j] = sigmoidf_(v1[j]); }
                    } else if (MODE == 3) {
#pragma unroll
                        for (int j = 0; j < 4; ++j) { const float a = fmaxf(v0[j], 0.f), b = fmaxf(v1[j], 0.f); v0[j] = a * a; v1[j] = b * b; }
                    } else {
                        const u32x4 t = *(const u32x4*)(IB + off);
                        v0[0] *= bflo(t.x); v0[1] *= bfhi(t.x); v0[2] *= bflo(t.y); v0[3] *= bfhi(t.y);
                        v1[0] *= bflo(t.z); v1[1] *= bfhi(t.z); v1[2] *= bflo(t.w); v1[3] *= bfhi(t.w);
                        if (MODE == 2) { v0 += *(const f32x4*)(IF + off); v1 += *(const f32x4*)(IF + off + 4); }
                    }
                    if (MODE == 1) { *(f32x4*)(OF + off) = v0; *(f32x4*)(OF + off + 4) = v1; }
                    else { u32x4 w; w.x = pk2(v0[0], v0[1]); w.y = pk2(v0[2], v0[3]); w.z = pk2(v1[0], v1[1]); w.w = pk2(v1[2], v1[3]); *(u32x4*)(O + off) = w; }
                }
                if (MODE == 1 || MODE == 2) asm volatile("" ::: "memory"); }
    }
};
template <int MODE> struct EpiF {
    static constexpr bool PERM = false, AFTER_DRAIN = false;
    float* OF; bf16* O; const float* IF; const bf16* IB; int ldc;
    __device__ __forceinline__ void operator()(const f32x4 (&acc)[2][2][4][2], const pg8::Unit& u, int wr, int wc, int fr, int fq) const {
        const int row0 = u.pm * 256 + wr * 64 + fr, col0 = u.pn * 256 + wc * 32 + 4 * fq;
#pragma unroll
        for (int ai = 0; ai < 2; ++ai)
#pragma unroll
            for (int m = 0; m < 4; ++m) { const unsigned ro = (unsigned)(row0 + ai * 128 + m * 16) * ldc + col0;
#pragma unroll
                for (int bj = 0; bj < 2; ++bj)
#pragma unroll
                    for (int n = 0; n < 2; ++n) { const unsigned off = ro + bj * 128 + n * 16; f32x4 v = acc[ai][bj][m][n];
                        if (MODE == 0) { v += ALPHA * *(const f32x4*)(IF + off); *(f32x4*)(OF + off) = v; }
                        else if (MODE == 1) { const u32x2 t = *(const u32x2*)(IB + off);
                            v[0] += ALPHA * bflo(t.x); v[1] += ALPHA * bfhi(t.x); v[2] += ALPHA * bflo(t.y); v[3] += ALPHA * bfhi(t.y);
                            *(f32x4*)(OF + off) = v; u32x2 w; w.x = pk2(v[0], v[1]); w.y = pk2(v[2], v[3]); *(u32x2*)(O + off) = w; }
                        else if (MODE == 2) { *(f32x4*)(OF + off) = v; }
                        else { const f32x4 pr = *(const f32x4*)(IF + off); f32x4 r = *(const f32x4*)(OF + off);
#pragma unroll
                            for (int j = 0; j < 4; ++j) r[j] += sigmoidf_(v[j]) * pr[j];
                            *(f32x4*)(OF + off) = r; }
                    }
                if (MODE != 2) asm volatile("" ::: "memory"); }
    }
};

__device__ __forceinline__ float wave_sum(float v) {
#pragma unroll
    for (int o = 1; o < 64; o <<= 1) v += __shfl_xor(v, o);
    return v;
}
__device__ __forceinline__ float wave_max(float v) {
#pragma unroll
    for (int o = 1; o < 64; o <<= 1) v = fmaxf(v, __shfl_xor(v, o));
    return v;
}
#define MFMA16(a, b, c) __builtin_amdgcn_mfma_f32_16x16x32_bf16((a), (b), (c), 0, 0, 0)

template <bool TO_BF16>
__device__ __forceinline__ void ln_row(const float* xrow, const float* gam, const float* bet, float* of, bf16* ob, int lane) {
    const f32x4* xr = (const f32x4*)xrow + lane;
    f32x4 v[4]; float s = 0.f;
#pragma unroll
    for (int j = 0; j < 4; ++j) { v[j] = xr[64 * j]; s += (v[j][0] + v[j][1]) + (v[j][2] + v[j][3]); }
    const float mean = wave_sum(s) * (1.f / 1024.f); float s2 = 0.f;
#pragma unroll
    for (int j = 0; j < 4; ++j) { v[j] = v[j] - mean; s2 += (v[j][0] * v[j][0] + v[j][1] * v[j][1]) + (v[j][2] * v[j][2] + v[j][3] * v[j][3]); }
    const float rstd = 1.f / sqrtf(wave_sum(s2) * (1.f / 1024.f) + LN_EPS);
#pragma unroll
    for (int j = 0; j < 4; ++j) { const f32x4 g = ((const f32x4*)gam)[lane + 64 * j], b = ((const f32x4*)bet)[lane + 64 * j]; const f32x4 o = v[j] * rstd * g + b;
        if (TO_BF16) { u32x2 w; w.x = pk2(o[0], o[1]); w.y = pk2(o[2], o[3]); ((u32x2*)ob)[lane + 64 * j] = w; }
        else ((f32x4*)of)[lane + 64 * j] = o; }
}

constexpr int SC_LD = 2052;
constexpr int MK_OFF = 16 * SC_LD * 4;
__device__ __forceinline__ void mixa_unit(const bf16* QI, const bf16* KI, const float* WI, bf16* QA  , const bf16* KA, const bf16* VAT,
                                          LAS unsigned char* lds, int b, int qt) {
    const int tid = threadIdx.x, w = __builtin_amdgcn_readfirstlane(tid >> 6), lane = tid & 63, n = lane & 15, g = lane >> 4;
    const int rowbase = b * SEQ + qt * 16, nk16 = qt + 1;
    LAS float* SC = (LAS float*)lds;
    LAS unsigned long long* MK = (LAS unsigned long long*)(lds + MK_OFF);
    const f32x4 zero4 = {0.f, 0.f, 0.f, 0.f};
    {
        bf16x8 qf[8][2];
        const bf16* qrow = QI + (size_t)(rowbase + n) * 512 + 8 * g;
#pragma unroll
        for (int h = 0; h < 8; ++h) { qf[h][0] = *(const bf16x8*)(qrow + h * 64); qf[h][1] = *(const bf16x8*)(qrow + h * 64 + 32); }
        const f32x4 w0 = *(const f32x4*)(WI + (size_t)(rowbase + n) * 8), w1 = *(const f32x4*)(WI + (size_t)(rowbase + n) * 8 + 4);
        const float wv[8] = {w0[0], w0[1], w0[2], w0[3], w1[0], w1[1], w1[2], w1[3]};
        const bf16* kbase = KI + (size_t)(b * SEQ + n) * 64 + 8 * g;
        bf16x8 nk0 = *(const bf16x8*)(kbase + (size_t)w * 1024), nk1 = *(const bf16x8*)(kbase + (size_t)w * 1024 + 32);
        for (int kt = w; kt < nk16; kt += 8) {
            const bf16x8 k0 = nk0, k1 = nk1;
            { const int ktn = (kt + 8 < nk16) ? kt + 8 : kt; nk0 = *(const bf16x8*)(kbase + (size_t)ktn * 1024); nk1 = *(const bf16x8*)(kbase + (size_t)ktn * 1024 + 32); }
            f32x4 sc = zero4;
#pragma unroll
            for (int h = 0; h < 8; ++h) { f32x4 a = MFMA16(k0, qf[h][0], zero4); a = MFMA16(k1, qf[h][1], a);
#pragma unroll
                for (int i = 0; i < 4; ++i) sc[i] += fmaxf(a[i], 0.f) * wv[h]; }
            if (kt == qt) {
#pragma unroll
                for (int i = 0; i < 4; ++i) if (4 * g + i > n) sc[i] = -INFINITY; }
            *(LAS f32x4*)(SC + n * SC_LD + kt * 16 + 4 * g) = sc;
        }
    }
    __syncthreads();
#pragma unroll 1
    for (int qq = 0; qq < 2; ++qq) {
        const int nq = 2 * w + qq, t = qt * 16 + nq, Lr = 16 * nk16, nj = (Lr + 63) >> 6;
        unsigned key[32];
#pragma unroll
        for (int j = 0; j < 32; ++j) { const int idx = lane + 64 * j; float v = -INFINITY; if (j < nj && idx < Lr) v = SC[nq * SC_LD + idx];
            const unsigned uu = __builtin_bit_cast(unsigned, v); key[j] = (uu & 0x80000000u) ? ~uu : (uu | 0x80000000u); }
        if (t + 1 <= 256) {
#pragma unroll
            for (int j = 0; j < 32; ++j) { const unsigned long long mm = __ballot(lane + 64 * j <= t); if (lane == 0) MK[nq * 32 + j] = mm; }
        } else {
            unsigned T = 0u; bool exact = false;
#pragma unroll 1
            for (int bit = 31; bit >= 0; --bit) {
                const unsigned cand = T | (1u << bit); int cnt = 0;
#pragma unroll
                for (int j = 0; j < 32; ++j) if (j < nj) cnt += __popcll(__ballot(key[j] >= cand));
                if (cnt >= 256) { T = cand; if (cnt == 256) { exact = true; break; } }
            }
            int need = 0x7fffffff;
            if (!exact) { int cgt = 0;
#pragma unroll
                for (int j = 0; j < 32; ++j) if (j < nj) cgt += __popcll(__ballot(key[j] > T));
                need = 256 - cgt; }
            int tb = 0; const unsigned long long ltm = (1ull << lane) - 1ull;
#pragma unroll
            for (int j = 0; j < 32; ++j) {
                unsigned long long selm = 0ull;
                if (j < nj) { const bool eq = key[j] == T; const unsigned long long eqm = __ballot(eq);
                    const int myrank = tb + __popcll(eqm & ltm);
                    selm = __ballot(key[j] > T || (eq && myrank < need)); tb += __popcll(eqm); }
                if (lane == 0) MK[nq * 32 + j] = selm;
            }
        }
    }
    __syncthreads();
    {
        constexpr int TLD = 72;
        LAS bf16* KT = (LAS bf16*)lds;
        LAS bf16* VTT = (LAS bf16*)(lds + 2 * 64 * TLD * 2);
        const bf16* qrow = QA + (size_t)(rowbase + n) * 512 + w * 64 + 8 * g;
        const bf16x8 qa0 = *(const bf16x8*)qrow, qa1 = *(const bf16x8*)(qrow + 32);
        f32x4 o[4] = {zero4, zero4, zero4, zero4}; float mrun = -1e30f, lsum = 0.f;
        const int nT = (nk16 + 3) >> 2;
        const int srow = tid >> 3, sch = tid & 7;
        const bf16* kg = KA + (size_t)(b * SEQ + srow) * 64 + sch * 8;
        const bf16* vg = VAT + (size_t)(b * 64 + srow) * 2048 + sch * 8;
        u32x4 rk = *(const u32x4*)kg, rv = *(const u32x4*)vg;
        *(LAS u32x4*)(KT + srow * TLD + sch * 8) = rk; *(LAS u32x4*)(VTT + srow * TLD + sch * 8) = rv;
        __syncthreads();
        for (int T = 0; T < nT; ++T) {
            const int buf = T & 1;
            if (T + 1 < nT) { rk = *(const u32x4*)(kg + (size_t)(T + 1) * 4096); rv = *(const u32x4*)(vg + (T + 1) * 64); }
            const LAS bf16* kt = KT + buf * 64 * TLD; const LAS bf16* vt = VTT + buf * 64 * TLD;
            const unsigned long long mw = MK[n * 32 + T];
#pragma unroll
            for (int kb2 = 0; kb2 < 2; ++kb2) {
                f32x4 st[2];
#pragma unroll
                for (int tt = 0; tt < 2; ++tt) { const LAS bf16* kp = kt + (32 * kb2 + 16 * tt + n) * TLD + 8 * g;
                    const bf16x8 k0 = *(const LAS bf16x8*)kp, k1 = *(const LAS bf16x8*)(kp + 32);
                    st[tt] = MFMA16(k0, qa0, zero4); st[tt] = MFMA16(k1, qa1, st[tt]); }
                const unsigned hs = (kb2 ? (unsigned)(mw >> 32) : (unsigned)mw) >> (4 * g);
                float bm = -INFINITY;
#pragma unroll
                for (int tt = 0; tt < 2; ++tt)
#pragma unroll
                    for (int i = 0; i < 4; ++i) { const bool sel = (hs >> (16 * tt + i)) & 1u; st[tt][i] = sel ? st[tt][i] : -INFINITY; bm = fmaxf(bm, st[tt][i]); }
                bm = fmaxf(bm, __shfl_xor(bm, 16)); bm = fmaxf(bm, __shfl_xor(bm, 32));
                const float mn = fmaxf(mrun, bm), alpha = __builtin_amdgcn_exp2f(mrun - mn); mrun = mn;
                float ps = 0.f;
#pragma unroll
                for (int tt = 0; tt < 2; ++tt)
#pragma unroll
                    for (int i = 0; i < 4; ++i) { st[tt][i] = __builtin_amdgcn_exp2f(st[tt][i] - mn); ps += st[tt][i]; }
                lsum = lsum * alpha + ps;
                u32x4 pw; pw.x = pk2(st[0][0], st[0][1]); pw.y = pk2(st[0][2], st[0][3]); pw.z = pk2(st[1][0], st[1][1]); pw.w = pk2(st[1][2], st[1][3]);
                const bf16x8 pb = __builtin_bit_cast(bf16x8, pw);
#pragma unroll
                for (int dt = 0; dt < 4; ++dt) { const LAS bf16* vp = vt + (16 * dt + n) * TLD + 32 * kb2 + 4 * g;
                    const u32x2 lo = *(const LAS u32x2*)vp, hi = *(const LAS u32x2*)(vp + 16);
                    u32x4 vv; vv.x = lo.x; vv.y = lo.y; vv.z = hi.x; vv.w = hi.y;
                    o[dt] = o[dt] * alpha; o[dt] = MFMA16(__builtin_bit_cast(bf16x8, vv), pb, o[dt]); }
            }
            if (T + 1 < nT) { *(LAS u32x4*)(KT + (buf ^ 1) * 64 * TLD + srow * TLD + sch * 8) = rk; *(LAS u32x4*)(VTT + (buf ^ 1) * 64 * TLD + srow * TLD + sch * 8) = rv; }
            __syncthreads();
        }
        lsum += __shfl_xor(lsum, 16); lsum += __shfl_xor(lsum, 32);
        const float inv = 1.0f / lsum;
        bf16* orow = QA + (size_t)(rowbase + n) * 512 + w * 64 + 4 * g;
#pragma unroll
        for (int dt = 0; dt < 4; ++dt) { u32x2 ww; ww.x = pk2(o[dt][0] * inv, o[dt][1] * inv); ww.y = pk2(o[dt][2] * inv, o[dt][3] * inv); *(u32x2*)(orow + dt * 16) = ww; }
    }
    __syncthreads();
}

constexpr int KW_LD = 72;
__device__ __forceinline__ void m1_unit(const bf16* MLQK, const bf16* MLV, const float* IG, const float* LF, const float* conv_w, const float* conv_b,
                                        bf16* QC, bf16* DC, float* DN, float* BCUM, float* CS, LAS unsigned char* lds, int unit) {
    const int c = unit & 31, bh = unit >> 5, h = bh & 3, b = bh >> 2;
    const int tid = threadIdx.x, w = __builtin_amdgcn_readfirstlane(tid >> 6), lane = tid & 63, n = lane & 15, g = lane >> 4;
    const int rowbase = b * SEQ + c * 64;
    LAS float* WK = (LAS float*)lds;
    LAS bf16* KWT = (LAS bf16*)(lds + 1024);
    LAS bf16* VT = (LAS bf16*)(lds + 1024 + 128 * KW_LD * 2);
    if (w == 0) {
        const float lf = LF[(size_t)(rowbase + lane) * 4 + h], ig = IG[(size_t)(rowbase + lane) * 4 + h];
        float bc = lf;
#pragma unroll
        for (int o = 1; o < 64; o <<= 1) { const float tt = __shfl_up(bc, o); if (lane >= o) bc += tt; }
        const float bl = __shfl(bc, 63), gj = bl - bc + ig, mg = wave_max(gj);
        WK[lane] = __expf(gj - mg);
        BCUM[(size_t)(rowbase + lane) * 4 + h] = bc;
        if (lane == 0) { CS[unit * 2] = bl; CS[unit * 2 + 1] = mg; }
    }
    __syncthreads();
    {
        const int isk = (tid >> 4) & 1, cgi = tid & 15, rl = tid >> 5;
        const int ch = isk * 512 + h * 128 + cgi * 8;
        float cw[4][8], cb[8];
#pragma unroll
        for (int j = 0; j < 4; ++j) { const f32x4 a = *(const f32x4*)(conv_w + j * 1024 + ch), bb = *(const f32x4*)(conv_w + j * 1024 + ch + 4);
            cw[j][0] = a[0]; cw[j][1] = a[1]; cw[j][2] = a[2]; cw[j][3] = a[3]; cw[j][4] = bb[0]; cw[j][5] = bb[1]; cw[j][6] = bb[2]; cw[j][7] = bb[3]; }
        { const f32x4 a = *(const f32x4*)(conv_b + ch), bb = *(const f32x4*)(conv_b + ch + 4);
            cb[0] = a[0]; cb[1] = a[1]; cb[2] = a[2]; cb[3] = a[3]; cb[4] = bb[0]; cb[5] = bb[1]; cb[6] = bb[2]; cb[7] = bb[3]; }
        float x[7][8];
#pragma unroll
        for (int rr = 0; rr < 7; ++rr) { const int tl = c * 64 + 4 * rl + rr - 3;
            u32x4 t = {0u, 0u, 0u, 0u};
            if (tl >= 0) t = *(const u32x4*)(MLQK + (size_t)(b * SEQ + tl) * 1024 + ch);
            x[rr][0] = bflo(t.x); x[rr][1] = bfhi(t.x); x[rr][2] = bflo(t.y); x[rr][3] = bfhi(t.y); x[rr][4] = bflo(t.z); x[rr][5] = bfhi(t.z); x[rr][6] = bflo(t.w); x[rr][7] = bfhi(t.w); }
#pragma unroll
        for (int oo = 0; oo < 4; ++oo) { const int jr = 4 * rl + oo; float y[8];
#pragma unroll
            for (int e = 0; e < 8; ++e) { float a = cb[e];
#pragma unroll
                for (int j = 0; j < 4; ++j) a += cw[j][e] * x[oo + j][e];
                a = a * sigmoidf_(a); y[e] = isk ? a * MLK_SCALE : a; }
            u32x4 wv; wv.x = pk2(y[0], y[1]); wv.y = pk2(y[2], y[3]); wv.z = pk2(y[4], y[5]); wv.w = pk2(y[6], y[7]);
            *(u32x4*)(QC + (size_t)(rowbase + jr) * 1024 + ch) = wv;
            if (isk) { const float wk = WK[jr];
#pragma unroll
                for (int e = 0; e < 8; ++e) KWT[(cgi * 8 + e) * KW_LD + jr] = (bf16)f2bf(y[e] * wk); }
        }
#pragma unroll
        for (int q = 0; q < 2; ++q) { const int idx = tid + 512 * q, row = idx >> 4, cgv = idx & 15;
            const u32x4 t = *(const u32x4*)(MLV + (size_t)(rowbase + row) * 512 + h * 128 + cgv * 8);
            LAS bf16* vp = VT + (cgv * 8) * KW_LD + row;
            vp[0 * KW_LD] = (bf16)(t.x & 0xffffu); vp[1 * KW_LD] = (bf16)(t.x >> 16); vp[2 * KW_LD] = (bf16)(t.y & 0xffffu); vp[3 * KW_LD] = (bf16)(t.y >> 16);
            vp[4 * KW_LD] = (bf16)(t.z & 0xffffu); vp[5 * KW_LD] = (bf16)(t.z >> 16); vp[6 * KW_LD] = (bf16)(t.w & 0xffffu); vp[7 * KW_LD] = (bf16)(t.w >> 16); }
    }
    __syncthreads();
    {
        f32x4 acc[8];
#pragma unroll
        for (int et = 0; et < 8; ++et) acc[et] = (f32x4){0.f, 0.f, 0.f, 0.f};
#pragma unroll
        for (int ks = 0; ks < 2; ++ks) { const bf16x8 a = *(const LAS bf16x8*)(KWT + (16 * w + n) * KW_LD + 32 * ks + 8 * g);
#pragma unroll
            for (int et = 0; et < 8; ++et) { const bf16x8 bfr = *(const LAS bf16x8*)(VT + (16 * et + n) * KW_LD + 32 * ks + 8 * g); acc[et] = MFMA16(a, bfr, acc[et]); } }
        bf16* dcu = DC + (size_t)unit * 16384;
#pragma unroll
        for (int et = 0; et < 8; ++et) { u32x2 ww; ww.x = pk2(acc[et][0], acc[et][1]); ww.y = pk2(acc[et][2], acc[et][3]); *(u32x2*)(dcu + (16 * et + n) * 128 + 16 * w + 4 * g) = ww; }
        if (tid < 128) { float s = 0.f;
#pragma unroll 8
            for (int j = 0; j < 64; ++j) s += __builtin_bit_cast(float, (unsigned)KWT[tid * KW_LD + j] << 16);
            DN[(size_t)unit * 128 + tid] = s; }
    }
    __syncthreads();
}

constexpr int CT_LD = 136;
__device__ __forceinline__ void m3_unit(const bf16* QC, bf16* MLV  , const bf16* MLO, const float* IG, const float* BCUM, const float* MST,
                                        const bf16* DC, const float* DN, const float* gnorm, LAS unsigned char* lds, int unit) {
    const int c = unit & 31, bh = unit >> 5, h = bh & 3, b = bh >> 2;
    const int tid = threadIdx.x, w = __builtin_amdgcn_readfirstlane(tid >> 6), lane = tid & 63, n = lane & 15, g = lane >> 4;
    const int rowbase = b * SEQ + c * 64;
    LAS float* U = (LAS float*)lds; LAS float* R = U + 64; LAS float* WINT = U + 128; LAS float* EMR = U + 192; LAS float* NS = U + 256; LAS float* XCH = U + 384;
    LAS bf16* CT = (LAS bf16*)(lds + 4096);
    LAS bf16* KS = (LAS bf16*)(lds + 4096 + 128 * CT_LD * 2);
    LAS bf16* VT = (LAS bf16*)(lds + 4096 + 128 * CT_LD * 2 + 64 * CT_LD * 2);
    if (w == 0) {
        const float bc = BCUM[(size_t)(rowbase + lane) * 4 + h], ig = IG[(size_t)(rowbase + lane) * 4 + h], mc = MST[unit];
        const float uu = ig - bc; float a = uu;
#pragma unroll
        for (int o = 1; o < 64; o <<= 1) { const float tt = __shfl_up(a, o); if (lane >= o) a = fmaxf(a, tt); }
        const float mrow = bc + fmaxf(a, mc);
        U[lane] = uu; R[lane] = bc - mrow; WINT[lane] = __expf(bc + mc - mrow); EMR[lane] = __expf(-mrow);
    }
    {
        const bf16* dcu = DC + (size_t)unit * 16384;
#pragma unroll
        for (int q = 0; q < 4; ++q) { const int idx = tid + 512 * q, e = idx >> 4, dg = idx & 15; *(LAS u32x4*)(CT + e * CT_LD + dg * 8) = *(const u32x4*)(dcu + idx * 8); }
#pragma unroll
        for (int q = 0; q < 2; ++q) { const int idx = tid + 512 * q, s = idx >> 4, dg = idx & 15;
            *(LAS u32x4*)(KS + s * CT_LD + dg * 8) = *(const u32x4*)(QC + (size_t)(rowbase + s) * 1024 + 512 + h * 128 + dg * 8); }
#pragma unroll
        for (int q = 0; q < 2; ++q) { const int idx = tid + 512 * q, row = idx >> 4, cgv = idx & 15;
            const u32x4 t = *(const u32x4*)(MLV + (size_t)(rowbase + row) * 512 + h * 128 + cgv * 8);
            LAS bf16* vp = VT + (cgv * 8) * KW_LD + row;
            vp[0 * KW_LD] = (bf16)(t.x & 0xffffu); vp[1 * KW_LD] = (bf16)(t.x >> 16); vp[2 * KW_LD] = (bf16)(t.y & 0xffffu); vp[3 * KW_LD] = (bf16)(t.y >> 16);
            vp[4 * KW_LD] = (bf16)(t.z & 0xffffu); vp[5 * KW_LD] = (bf16)(t.z >> 16); vp[6 * KW_LD] = (bf16)(t.w & 0xffffu); vp[7 * KW_LD] = (bf16)(t.w >> 16); }
        if (tid < 128) NS[tid] = DN[(size_t)unit * 128 + tid];
    }
    __syncthreads();
#ifdef M3_LITE
    {
        const int lt = w & 3, eh = w >> 2, l = 16 * lt + n;
#pragma unroll
        for (int j = 0; j < 4; ++j) { const int e0 = 16 * (4 * eh + j) + 4 * g; float y[4];
#pragma unroll
            for (int i = 0; i < 4; ++i) { const int e = e0 + i;
                y[i] = 0.f;
                if (M3_LITE & 1) y[i] += __builtin_bit_cast(float, (unsigned)CT[e * CT_LD + ((l * 2 + 1) & 127)] << 16);
                if (M3_LITE & 2) y[i] += __builtin_bit_cast(float, (unsigned)KS[l * CT_LD + e] << 16);
                if (M3_LITE & 4) y[i] += __builtin_bit_cast(float, (unsigned)VT[e * KW_LD + l] << 16);
                if (M3_LITE & 8) y[i] += NS[e];
                if (M3_LITE & 16) y[i] += U[l] + R[l];
                if (M3_LITE & 32) y[i] += WINT[l] + EMR[l]; }
            const size_t off = (size_t)(rowbase + l) * 512 + h * 128 + e0;
            u32x2 ww; ww.x = pk2(y[0], y[1]); ww.y = pk2(y[2], y[3]); *(u32x2*)(MLV + off) = ww; }
        __syncthreads();
        return;
    }
#endif
    const int lt = w & 3, eh = w >> 2, l = 16 * lt + n;
    bf16x8 qf[4];
    { const bf16* qrow = QC + (size_t)(rowbase + l) * 1024 + h * 128 + 8 * g;
#pragma unroll
        for (int ks = 0; ks < 4; ++ks) qf[ks] = *(const bf16x8*)(qrow + 32 * ks); }
    const f32x4 zero4 = {0.f, 0.f, 0.f, 0.f};
    f32x4 sw[4]; const float Rl = R[l], wint = WINT[l], emr = EMR[l];
    float dsum = 0.f;
#pragma unroll
    for (int st = 0; st < 4; ++st) {
        sw[st] = zero4;
        if (st <= lt) { f32x4 acc = zero4;
#pragma unroll
            for (int ks = 0; ks < 4; ++ks) { const bf16x8 a = *(const LAS bf16x8*)(KS + (16 * st + n) * CT_LD + 32 * ks + 8 * g); acc = MFMA16(a, qf[ks], acc); }
#pragma unroll
            for (int i = 0; i < 4; ++i) { const int s = 16 * st + 4 * g + i; const float wgt = (s <= l) ? __expf(U[s] + Rl) : 0.f; sw[st][i] = acc[i] * wgt; dsum += sw[st][i]; } }
    }
    dsum += __shfl_xor(dsum, 16); dsum += __shfl_xor(dsum, 32);
    float qn = 0.f;
#pragma unroll
    for (int ks = 0; ks < 4; ++ks) { const u32x4 qq = __builtin_bit_cast(u32x4, qf[ks]); const LAS float* np = NS + 32 * ks + 8 * g;
        qn += bflo(qq.x) * np[0] + bfhi(qq.x) * np[1] + bflo(qq.y) * np[2] + bfhi(qq.y) * np[3] + bflo(qq.z) * np[4] + bfhi(qq.z) * np[5] + bflo(qq.w) * np[6] + bfhi(qq.w) * np[7]; }
    qn += __shfl_xor(qn, 16); qn += __shfl_xor(qn, 32);
    const float den = wint * qn + dsum;
    const float rden = 1.0f / fmaxf(fabsf(den), emr);
    f32x4 hv[4]; float s1 = 0.f;
#pragma unroll
    for (int j = 0; j < 4; ++j) { const int et = 4 * eh + j;
        f32x4 accS = zero4, accC = zero4;
#pragma unroll
        for (int kb = 0; kb < 2; ++kb) if (2 * kb <= lt) {
            u32x4 pw; pw.x = pk2(sw[2 * kb][0], sw[2 * kb][1]); pw.y = pk2(sw[2 * kb][2], sw[2 * kb][3]); pw.z = pk2(sw[2 * kb + 1][0], sw[2 * kb + 1][1]); pw.w = pk2(sw[2 * kb + 1][2], sw[2 * kb + 1][3]);
            const LAS bf16* vp = VT + (16 * et + n) * KW_LD + 32 * kb + 4 * g;
            const u32x2 lo = *(const LAS u32x2*)vp, hi = *(const LAS u32x2*)(vp + 16);
            u32x4 vv; vv.x = lo.x; vv.y = lo.y; vv.z = hi.x; vv.w = hi.y;
            accS = MFMA16(__builtin_bit_cast(bf16x8, vv), __builtin_bit_cast(bf16x8, pw), accS); }
#pragma unroll
        for (int ks = 0; ks < 4; ++ks) { const bf16x8 a = *(const LAS bf16x8*)(CT + (16 * et + n) * CT_LD + 32 * ks + 8 * g); accC = MFMA16(a, qf[ks], accC); }
#pragma unroll
        for (int i = 0; i < 4; ++i) { hv[j][i] = (wint * accC[i] + accS[i]) * rden; s1 += hv[j][i]; }
    }
    s1 += __shfl_xor(s1, 16); s1 += __shfl_xor(s1, 32);
    const float mloc = s1 * (1.f / 64.f); float q2 = 0.f;
#pragma unroll
    for (int j = 0; j < 4; ++j)
#pragma unroll
        for (int i = 0; i < 4; ++i) { const float dd = hv[j][i] - mloc; q2 += dd * dd; }
    q2 += __shfl_xor(q2, 16); q2 += __shfl_xor(q2, 32);
    if (g == 0) { XCH[(l * 2 + eh) * 2] = mloc; XCH[(l * 2 + eh) * 2 + 1] = q2; }
    __syncthreads();
    {
        const float mo = XCH[(l * 2 + (eh ^ 1)) * 2], qo = XCH[(l * 2 + (eh ^ 1)) * 2 + 1];
        const float mean = 0.5f * (mloc + mo), dm = mloc - mo, m2 = q2 + qo + 32.f * dm * dm;
        const float rstd = 1.0f / sqrtf(m2 * (1.f / 128.f) + LN_EPS);
#pragma unroll
        for (int j = 0; j < 4; ++j) { const int e0 = 16 * (4 * eh + j) + 4 * g;
            const f32x4 gn = *(const f32x4*)(gnorm + h * 128 + e0);
            const size_t off = (size_t)(rowbase + l) * 512 + h * 128 + e0;
            const u32x2 so = *(const u32x2*)(MLO + off);
            const float y0 = (hv[j][0] - mean) * rstd * gn[0] * bflo(so.x), y1 = (hv[j][1] - mean) * rstd * gn[1] * bfhi(so.x);
            const float y2 = (hv[j][2] - mean) * rstd * gn[2] * bflo(so.y), y3 = (hv[j][3] - mean) * rstd * gn[3] * bfhi(so.y);
            u32x2 ww; ww.x = pk2(y0, y1); ww.y = pk2(y2, y3); *(u32x2*)(MLV + off) = ww; }
    }
    __syncthreads();
}

__global__ void __launch_bounds__(NTHR, 2) fwd_kernel(Args args) {
    extern __shared__ __attribute__((aligned(16))) unsigned char lds_raw[];
    LAS unsigned char* lds = (LAS unsigned char*)lds_raw;
    cg::grid_group grid = cg::this_grid();
    const int tid = threadIdx.x, lane = tid & 63, wave = __builtin_amdgcn_readfirstlane(tid >> 6);
    const int G = gridDim.x, bx = blockIdx.x;
    const int gw = bx * NWAVES + wave, NGW = G * NWAVES;
    const int gt = bx * NTHR + tid, NGT = G * NTHR;
    unsigned char* ws = args.ws;
    const int lo = args.ph_lo, hi = args.ph_hi;
#ifndef PH_MASK
#define PH_MASK 0xfff
#endif
#define IN(k) (((PH_MASK >> (k)) & 1) && lo <= (k) && (k) < hi)
#define SEAM(k) do { if (IN(k) && IN((k) + 1)) { asm volatile("s_waitcnt vmcnt(0) lgkmcnt(0)" ::: "memory"); grid.sync(); \
    if (tid == 0) { __builtin_amdgcn_fence(__ATOMIC_ACQUIRE, "agent"); asm volatile("s_waitcnt vmcnt(0)" ::: "memory"); } __syncthreads(); } } while (0)
    float* OUT = args.out;
#define PHASE_PTRS() unsigned char* wsb = ws; asm volatile("" : "+s"(wsb)); \
    bf16* WinT = (bf16*)(wsb + WS_WIN); bf16* WgaT = (bf16*)(wsb + WS_WGA); bf16* WgbT = (bf16*)(wsb + WS_WGB); bf16* WuaT = (bf16*)(wsb + WS_WUA); bf16* WubT = (bf16*)(wsb + WS_WUB); \
    bf16* WoutT = (bf16*)(wsb + WS_WOUT); bf16* Wff1T = (bf16*)(wsb + WS_WFF1); bf16* Wff2T = (bf16*)(wsb + WS_WFF2); bf16* WpgT = (bf16*)(wsb + WS_WPG); bf16* WppT = (bf16*)(wsb + WS_WPP); \
    float* COS = (float*)(wsb + WS_COS); float* SIN = (float*)(wsb + WS_SIN); float* WI = (float*)(wsb + WS_WI); float* IG = (float*)(wsb + WS_IG); float* LF = (float*)(wsb + WS_LF); \
    bf16* KA = (bf16*)(wsb + WS_KA); bf16* KI = (bf16*)(wsb + WS_KI); bf16* VAT = (bf16*)(wsb + WS_VAT); \
    float* BCUM = (float*)(wsb + WS_BCUM); float* CS = (float*)(wsb + WS_CS); float* MST = (float*)(wsb + WS_MST); float* DN = (float*)(wsb + WS_DN); \
    bf16* XB = (bf16*)(wsb + WS_XB); bf16* PB = (bf16*)(wsb + WS_PB); bf16* QA = (bf16*)(wsb + WS_QA); bf16* QI = (bf16*)(wsb + WS_QI); bf16* MLQK = (bf16*)(wsb + WS_MLQK); \
    bf16* MLV = (bf16*)(wsb + WS_MLV); bf16* MLO = (bf16*)(wsb + WS_MLO); bf16* QC = (bf16*)(wsb + WS_QC); bf16* DC = (bf16*)(wsb + WS_DC); \
    bf16* TMP = (bf16*)(wsb + WS_TMP); bf16* MRG = (bf16*)(wsb + WS_MRG); bf16* H1 = (bf16*)(wsb + WS_H1); bf16* HF = (bf16*)(wsb + WS_HF); bf16* RB = (bf16*)(wsb + WS_RB); \
    float* PROJ = (float*)(wsb + WS_PROJ); bf16* CST = (bf16*)(wsb + WS_CST); float* NST = (float*)(wsb + WS_NST); (void)CST; (void)NST; \
    (void)WinT; (void)WgaT; (void)WgbT; (void)WuaT; (void)WubT; (void)WoutT; (void)Wff1T; (void)Wff2T; (void)WpgT; (void)WppT; (void)COS; (void)SIN; (void)WI; (void)IG; (void)LF; (void)KA; (void)KI; (void)VAT; \
    (void)BCUM; (void)CS; (void)MST; (void)DN; (void)XB; (void)PB; (void)QA; (void)QI; (void)MLQK; (void)MLV; (void)MLO; (void)QC; (void)DC; (void)TMP; (void)MRG; (void)H1; (void)HF; (void)RB; (void)PROJ
#define LAUNDER_I(v) asm volatile("" : "+s"(v))

    if (IN(0)) { PHASE_PTRS();
        LAS float* scr = (LAS float*)(lds + wave * 16384);
        const float* w_in = args.in[I_WIN]; const float* x = args.in[I_X];
        constexpr int I_A = 16 * (NWIN / 32), I_G = 16 * 32, I_U = 8 * 32, I_O = 16 * 32, I_1 = 16 * 128, I_2 = 64 * 32, I_PG = 16 * 32, I_PP = 4 * 32;
        constexpr int NITEMS = I_A + 2 * I_G + 2 * I_U + I_O + I_1 + I_2 + I_PG + I_PP;
        for (int it = gw; it < NITEMS; it += NGW) {
            int r = it;
            if (r < I_A) { transpose_item(w_in, 1024, WIN_LD, WinT, NWIN, scr, r, lane, [](int n) { return win_src(n); }); continue; } r -= I_A;
            if (r < I_G) { transpose_item(w_in, 1024, WIN_LD, WgaT, 1024, scr, r, lane, [](int n) { return 3280 + n; }); continue; } r -= I_G;
            if (r < I_G) { transpose_item(w_in, 1024, WIN_LD, WgbT, 1024, scr, r, lane, [](int n) { return 4304 + n; }); continue; } r -= I_G;
            if (r < I_U) { transpose_item(args.in[I_WUA], 512, 1024, WuaT, 1024, scr, r, lane, [](int n) { return n; }); continue; } r -= I_U;
            if (r < I_U) { transpose_item(args.in[I_WUB], 512, 1024, WubT, 1024, scr, r, lane, [](int n) { return n; }); continue; } r -= I_U;
            if (r < I_O) { transpose_item(args.in[I_WOUT], 1024, 1024, WoutT, 1024, scr, r, lane, [](int n) { return n; }); continue; } r -= I_O;
            if (r < I_1) { transpose_item(args.in[I_WFF1], 1024, 4096, Wff1T, 4096, scr, r, lane, [](int n) { return n; }); continue; } r -= I_1;
            if (r < I_2) { transpose_item(args.in[I_WFF2], 4096, 1024, Wff2T, 1024, scr, r, lane, [](int n) { return n; }); continue; } r -= I_2;
            if (r < I_PG) { transpose_item(args.in[I_WPG], 1024, 1024, WpgT, 1024, scr, r, lane, [](int n) { return n; }); continue; } r -= I_PG;
            transpose_item(args.in[I_WPP], 256, 1024, WppT, 1024, scr, r, lane, [](int n) { return n; });
        }
        for (int i = gt; i < M * D / 8; i += NGT) { const f32x4 a = ((const f32x4*)x)[2 * i], b = ((const f32x4*)x)[2 * i + 1];
            u32x4 o; o.x = pk2(a[0], a[1]); o.y = pk2(a[2], a[3]); o.z = pk2(b[0], b[1]); o.w = pk2(b[2], b[3]); ((u32x4*)XB)[i] = o; }
        { const float* p = args.in[I_P];
            for (int i = gt; i < M * PLE / 8; i += NGT) { const f32x4 a = ((const f32x4*)p)[2 * i], b = ((const f32x4*)p)[2 * i + 1];
                u32x4 o; o.x = pk2(a[0], a[1]); o.y = pk2(a[2], a[3]); o.z = pk2(b[0], b[1]); o.w = pk2(b[2], b[3]); ((u32x4*)PB)[i] = o; } }
        { const int* pos = (const int*)args.in[I_POS];
            for (int i = gt; i < M * 32; i += NGT) { const int m = i >> 5, f = i & 31; const double a = (double)pos[m] * INVF[f] * 0.15915494309189535;
                const float rev = (float)(a - floor(a)); COS[i] = __builtin_amdgcn_cosf(rev); SIN[i] = __builtin_amdgcn_sinf(rev); } }
    }
    SEAM(0);
    if (IN(1)) { PHASE_PTRS();
        int Kv = D; LAUNDER_I(Kv); pg8::Gemm gm{XB, WinT, M, NWIN, Kv}; pg8::StaticOrder S; S.init(M, NWIN, G, bx);
        EpiWin E{QA, QI, KA, KI, VAT, MLQK, MLV, MLO, WI, IG, LF, COS, SIN, args.in[I_BIG], args.in[I_BFG]};
        pg8::gemm_phase<EpiWin, pg8::StaticOrder, true, true>(lds, gm, S, E);
    }
    SEAM(1);
    if (IN(2)) { PHASE_PTRS();
#ifdef NO_MIXA
        for (int i = gt; i < M * 512 / 8; i += NGT) ((u32x4*)QA)[i] = (u32x4){0u, 0u, 0u, 0u};
#else
        for (int pr = bx; pr < NB * 64; pr += G) { const int b = pr >> 6, j = pr & 63;
            mixa_unit(QI, KI, WI, QA, KA, VAT, lds, b, 127 - j);
            mixa_unit(QI, KI, WI, QA, KA, VAT, lds, b, j); }
#endif
        for (int u = bx; u < 2048; u += G) m1_unit(MLQK, MLV, IG, LF, args.in[I_CONVW], args.in[I_CONVB], QC, DC, DN, BCUM, CS, lds, u);
    }
    SEAM(2);
    if (IN(3)) { PHASE_PTRS();
        for (int item = gt; item < 64 * 2048; item += NGT) { const int bh = item >> 11, rem = item & 2047;
            float st[8] = {0.f, 0.f, 0.f, 0.f, 0.f, 0.f, 0.f, 0.f}; float m = 0.f;
#pragma unroll 4
            for (int c = 0; c < 32; ++c) { const float bl = CS[(bh * 32 + c) * 2], mg = CS[(bh * 32 + c) * 2 + 1];
                const float mn = fmaxf(bl + m, mg), a = __expf(bl + m - mn), s = __expf(mg - mn); m = mn;
                const u32x4 d = *(const u32x4*)(DC + (size_t)(bh * 32 + c) * 16384 + rem * 8);
                u32x4 o; o.x = pk2(st[0], st[1]); o.y = pk2(st[2], st[3]); o.z = pk2(st[4], st[5]); o.w = pk2(st[6], st[7]); *(u32x4*)(CST + (size_t)(bh * 32 + c) * 16384 + rem * 8) = o;
                st[0] = a * st[0] + s * bflo(d.x); st[1] = a * st[1] + s * bfhi(d.x); st[2] = a * st[2] + s * bflo(d.y); st[3] = a * st[3] + s * bfhi(d.y);
                st[4] = a * st[4] + s * bflo(d.z); st[5] = a * st[5] + s * bfhi(d.z); st[6] = a * st[6] + s * bflo(d.w); st[7] = a * st[7] + s * bfhi(d.w); } }
        for (int item = gt; item < 64 * 128; item += NGT) { const int bh = item >> 7, dd = item & 127; float st = 0.f, m = 0.f;
            for (int c = 0; c < 32; ++c) { const float bl = CS[(bh * 32 + c) * 2], mg = CS[(bh * 32 + c) * 2 + 1];
                if (dd == 0) MST[bh * 32 + c] = m;
                const float mn = fmaxf(bl + m, mg), a = __expf(bl + m - mn), s = __expf(mg - mn); m = mn;
                const float d = DN[(size_t)(bh * 32 + c) * 128 + dd]; NST[(size_t)(bh * 32 + c) * 128 + dd] = st; st = a * st + s * d; } }
    }
    SEAM(3);
    if (IN(4)) { PHASE_PTRS();
        for (int u = bx; u < 2048; u += G) m3_unit(QC, MLV, MLO, IG, BCUM, MST, CST, NST, args.in[I_MLNG], lds, u);
    }
    SEAM(4);
    if (IN(5)) { PHASE_PTRS();
        pg8::StaticOrder S; S.init(M, D, G, bx);
        { int Kv = D; LAUNDER_I(Kv); pg8::Gemm gm{XB, WgaT, M, D, Kv}; EpiB<0> E{TMP, nullptr, nullptr, nullptr, D}; pg8::gemm_phase<EpiB<0>, pg8::StaticOrder, true, true>(lds, gm, S, E); }
        { int Kv = 512; LAUNDER_I(Kv); pg8::Gemm gm{QA, WuaT, M, D, Kv}; EpiB<1> E{nullptr, OUT, TMP, nullptr, D}; pg8::gemm_phase<EpiB<1>, pg8::StaticOrder, true, true>(lds, gm, S, E); }
        { int Kv = D; LAUNDER_I(Kv); pg8::Gemm gm{XB, WgbT, M, D, Kv}; EpiB<0> E{TMP, nullptr, nullptr, nullptr, D}; pg8::gemm_phase<EpiB<0>, pg8::StaticOrder, true, true>(lds, gm, S, E); }
        { int Kv = 512; LAUNDER_I(Kv); pg8::Gemm gm{MLV, WubT, M, D, Kv}; EpiB<2> E{MRG, nullptr, TMP, OUT, D}; pg8::gemm_phase<EpiB<2>, pg8::StaticOrder, true, true>(lds, gm, S, E); }
    }
    SEAM(5);
    if (IN(6)) { PHASE_PTRS();
        pg8::StaticOrder S; S.init(M, D, G, bx);
        int Kv = D; LAUNDER_I(Kv); pg8::Gemm gm{MRG, WoutT, M, D, Kv}; EpiF<0> E{OUT, nullptr, args.in[I_X], nullptr, D}; pg8::gemm_phase<EpiF<0>, pg8::StaticOrder, true, true>(lds, gm, S, E);
    }
    SEAM(6);
    if (IN(7)) { PHASE_PTRS(); for (int m = gw; m < M; m += NGW) ln_row<true>(OUT + (size_t)m * D, args.in[I_LN1G], args.in[I_LN1B], nullptr, H1 + (size_t)m * D, lane); }
    SEAM(7);
    if (IN(8)) { PHASE_PTRS();
        pg8::StaticOrder S; S.init(M, FF, G, bx);
        int Kv = D; LAUNDER_I(Kv); pg8::Gemm gm{H1, Wff1T, M, FF, Kv}; EpiB<3> E{HF, nullptr, nullptr, nullptr, FF}; pg8::gemm_phase<EpiB<3>, pg8::StaticOrder, true, true>(lds, gm, S, E);
    }
    SEAM(8);
    if (IN(9)) { PHASE_PTRS();
        pg8::StaticOrder S; S.init(M, D, G, bx);
        int Kv = FF; LAUNDER_I(Kv); pg8::Gemm gm{HF, Wff2T, M, D, Kv}; EpiF<1> E{OUT, RB, nullptr, H1, D}; pg8::gemm_phase<EpiF<1>, pg8::StaticOrder, true, true>(lds, gm, S, E);
    }
    SEAM(9);
    if (IN(10)) { PHASE_PTRS();
        pg8::StaticOrder S; S.init(M, D, G, bx);
#if !defined(P10_ONLY) || P10_ONLY == 1
        { int Kv = PLE; LAUNDER_I(Kv); pg8::Gemm gm{PB, WppT, M, D, Kv}; EpiF<2> E{PROJ, nullptr, nullptr, nullptr, D}; pg8::gemm_phase<EpiF<2>, pg8::StaticOrder, true, true>(lds, gm, S, E); }
#endif
#if !defined(P10_ONLY) || P10_ONLY == 2
        { int Kv = D; LAUNDER_I(Kv); pg8::Gemm gm{RB, WpgT, M, D, Kv}; EpiF<3> E{OUT, nullptr, PROJ, nullptr, D}; pg8::gemm_phase<EpiF<3>, pg8::StaticOrder, true, true>(lds, gm, S, E); }
#endif
    }
    SEAM(10);
    if (IN(11)) { PHASE_PTRS(); for (int m = gw; m < M; m += NGW) ln_row<false>(OUT + (size_t)m * D, args.in[I_LN2G], args.in[I_LN2B], OUT + (size_t)m * D, nullptr, lane); }
#undef IN
#undef SEAM
}

extern "C" void kernel_launch(void* const* d_in, const int* in_sizes, int n_in, void* d_out, int out_size, void* d_ws, size_t ws_size, hipStream_t stream) {
    static int grid = 0;
    if (grid == 0) {
        if (n_in != 20 || out_size != M * D || ws_size < WS_END) { fprintf(stderr, "kernel_launch: unexpected problem shape (n_in %d, out %d, ws %zu)\n", n_in, out_size, ws_size); grid = -1; return; }
        int dev = 0, cus = 0, per_cu = 0;
        hipGetDevice(&dev); hipDeviceGetAttribute(&cus, hipDeviceAttributeMultiprocessorCount, dev);
        if (hipFuncSetAttribute((const void*)fwd_kernel, hipFuncAttributeMaxDynamicSharedMemorySize, LDS_BYTES) != hipSuccess) { fprintf(stderr, "kernel_launch: hipFuncSetAttribute failed\n"); grid = -1; return; }
        if (hipOccupancyMaxActiveBlocksPerMultiprocessor(&per_cu, (const void*)fwd_kernel, NTHR, LDS_BYTES) != hipSuccess || per_cu < 1) { fprintf(stderr, "kernel_launch: occupancy query says %d\n", per_cu); per_cu = 1; }
        (void)hipGetLastError();
        grid = cus * (per_cu > 1 ? 1 : per_cu);
        if (grid <= 0) { grid = -1; return; }
    }
    if (grid < 0) return;
    Args a{};
    for (int i = 0; i < 20; ++i) a.in[i] = (const float*)d_in[i];
    a.out = (float*)d_out; a.ws = (unsigned char*)d_ws;
#if MK_ONE
    a.ph_lo = 0; a.ph_hi = NPHASE;
    void* params[] = {&a};
    hipError_t e = hipLaunchCooperativeKernel((const void*)fwd_kernel, dim3(grid), dim3(NTHR), params, LDS_BYTES, stream);
    if (e != hipSuccess) fprintf(stderr, "cooperative launch failed: %s (grid %d)\n", hipGetErrorString(e), grid);
#else
    for (int ph = 0; ph < NPHASE; ++ph) { a.ph_lo = ph; a.ph_hi = ph + 1; hipLaunchKernelGGL(fwd_kernel, dim3(grid), dim3(NTHR), LDS_BYTES, stream, a); }
#endif
}
```

```cpp
#include <hip/hip_runtime.h>
#include <hip/hip_cooperative_groups.h>
#include <cstdio>
#include <cstdint>
namespace cg = cooperative_groups;
#define MK_ONE 1
namespace pg8 {
#define PG8_LAS __attribute__((address_space(3)))
typedef unsigned short bf16_t;
typedef short bf16x8 __attribute__((ext_vector_type(8)));
typedef float f32x4 __attribute__((ext_vector_type(4)));
typedef unsigned u32x4 __attribute__((ext_vector_type(4)));
constexpr int BM = 256, BK = 64, HALF = 128, HTB = HALF * BK * 2  , STAGE_BYTES = 8 * HTB, NXCD = 8, WGM = 8;

__host__ __device__ __forceinline__ int lds_byte(int r, int c) { const int st = (r >> 4) * 2 + (c >> 5), rr = r & 15, cc = c & 31, ob = rr * 64 + cc * 2; return st * 1024 + (ob ^ (((ob >> 9) & 1) << 5)); }
__host__ __device__ __forceinline__ void stage_rc(int b, int& R, int& C) { const int st = b / 1024, sb = b % 1024, swz = sb ^ (((sb >> 9) & 1) << 5); R = (st >> 1) * 16 + swz / 64; C = (st & 1) * 32 + (swz % 64) / 2; }
__host__ __device__ __forceinline__ int perm32(int rho) { const int n = rho >> 4, i = rho & 15; return 8 * (i >> 2) + 4 * n + (i & 3); }

struct Unit { int pm, pn; };
struct Gemm { const bf16_t* A; const bf16_t* Bt; int M, N, K; };

struct StaticOrder {
    int nM, nN, nwg, G, c;
    __host__ __device__ void init(int M, int N, int G_, int c_) { nM = M / BM; nN = N / BM; nwg = nM * nN; G = G_; c = c_; }
    __host__ __device__ bool next(int i, Unit& u) const {
        const long L = (long)i * G + c; if (L >= nwg) return false;
        int wgid = (int)L; { const int q = nwg / NXCD, r = nwg % NXCD, xcd = wgid % NXCD, off = wgid / NXCD; wgid = (xcd < r ? xcd * (q + 1) : r * (q + 1) + (xcd - r) * q) + off; }
        const int nig = WGM * nN, gid = wgid / nig, fm = gid * WGM, gsz = (nM - fm) < WGM ? (nM - fm) : WGM;
        u.pm = fm + ((wgid % nig) % gsz); u.pn = (wgid % nig) / gsz; return true;
    }
    __device__ __forceinline__ void a_ready(const Unit&) const {}
    __device__ __forceinline__ void done(const Unit&) const {}
};

__device__ __forceinline__ unsigned cvt_pk_bf16(float lo, float hi) { unsigned r; asm volatile("v_cvt_pk_bf16_f32 %0, %1, %2" : "=v"(r) : "v"(lo), "v"(hi)); return r; }
template <class Epi, class Sched, bool ALIGN_EPI = false, bool SP2 = false>
__device__ __forceinline__ void gemm_phase(PG8_LAS unsigned char* lds, const Gemm g, const Sched& S, const Epi& E) {
    const int tid = threadIdx.x, wid = __builtin_amdgcn_readfirstlane(tid >> 6), lane = tid & 63, wr = wid >> 2, wc = wid & 3, fr = lane & 15, fq = lane >> 4;
    const int K = g.K, nt = K / BK;
    unsigned voffA[2], voffB[2];
#pragma unroll
    for (int i = 0; i < 2; ++i) { int R, C; stage_rc(tid * 16 + i * 8192, R, C); const int Rb = Epi::PERM ? ((R & ~31) + perm32(R & 31)) : R;
        voffA[i] = (unsigned)(R * K + C) * 2u; voffB[i] = (unsigned)(Rb * K + C) * 2u; }
    const size_t kstep = (size_t)(BK * 2);
    const size_t hstep = (size_t)HALF * K * 2;
    const size_t tstep = 2 * hstep;
    const unsigned ldsw = (unsigned)wid * 1024u;
    const int aoff = lds_byte(wr * 64 + fr, fq * 8), boff = lds_byte(wc * 32 + fr, fq * 8);
#define PG8_SA(b, h) (((b) * 2 + (h)) * HTB)
#define PG8_SB(b, h) ((4 + (b) * 2 + (h)) * HTB)
#define PG8_STAGE(bufoff, gbase, voff) do { _Pragma("unroll") for (int _i = 0; _i < 2; ++_i) \
        __builtin_amdgcn_global_load_lds((const unsigned*)((const char*)(gbase) + (voff)[_i]), (PG8_LAS unsigned*)(lds + (bufoff) + ldsw + _i * 8192), 16, 0, 0); } while (0)
#define PG8_LDA(dst, b, h) do { _Pragma("unroll") for (int m = 0; m < 4; ++m) _Pragma("unroll") for (int k = 0; k < 2; ++k) dst[m][k] = *(const PG8_LAS bf16x8*)(lds + PG8_SA(b, h) + aoff + m * 2048 + k * 1024); } while (0)
#define PG8_LDB(dst, b, h) do { _Pragma("unroll") for (int n = 0; n < 2; ++n) _Pragma("unroll") for (int k = 0; k < 2; ++k) dst[n][k] = *(const PG8_LAS bf16x8*)(lds + PG8_SB(b, h) + boff + n * 2048 + k * 1024); } while (0)
#define PG8_MMA(ai, bj, At, Bt) do { __builtin_amdgcn_s_setprio(1); _Pragma("unroll") for (int m = 0; m < 4; ++m) _Pragma("unroll") for (int n = 0; n < 2; ++n) _Pragma("unroll") for (int k = 0; k < 2; ++k) \
        acc[ai][bj][m][n] = __builtin_amdgcn_mfma_f32_16x16x32_bf16(Bt[n][k], At[m][k], acc[ai][bj][m][n], 0, 0, 0); __builtin_amdgcn_s_setprio(0); } while (0)
#define PG8_WAIT_V(n) asm volatile("s_waitcnt vmcnt(" #n ")" ::: "memory")
#define PG8_WAIT_L(n) asm volatile("s_waitcnt lgkmcnt(" #n ")" ::: "memory")
#define PG8_BAR __builtin_amdgcn_s_barrier()
#define PG8_SCHED __builtin_amdgcn_sched_barrier(0)
    Unit cur, nxt; int ui = 0;
    if (!S.next(0, cur)) return;
    f32x4 acc[2][2][4][2];
#pragma unroll
    for (int a = 0; a < 2; ++a)
#pragma unroll
        for (int b = 0; b < 2; ++b)
#pragma unroll
            for (int m = 0; m < 4; ++m)
#pragma unroll
                for (int n = 0; n < 2; ++n) acc[a][b][m][n] = (f32x4){0.f, 0.f, 0.f, 0.f};
    bf16x8 At[4][2], B0[2][2], B1[2][2];
    const char* cA = (const char*)g.A + (size_t)cur.pm * tstep; const char* cB = (const char*)g.Bt + (size_t)cur.pn * tstep;
    S.a_ready(cur);
    if constexpr (SP2) {
        PG8_STAGE(PG8_SB(0, 0), cB, voffB); PG8_STAGE(PG8_SB(0, 1), cB + hstep, voffB); PG8_STAGE(PG8_SA(0, 0), cA, voffA); PG8_STAGE(PG8_SA(0, 1), cA + hstep, voffA);
        if (wr == 1) PG8_BAR;
        PG8_WAIT_V(2); PG8_BAR;
        PG8_STAGE(PG8_SB(1, 0), cB + kstep, voffB); PG8_STAGE(PG8_SA(1, 0), cA + kstep, voffA); PG8_STAGE(PG8_SB(1, 1), cB + hstep + kstep, voffB);
        PG8_WAIT_V(6); PG8_BAR;
    } else {
        PG8_STAGE(PG8_SB(0, 0), cB, voffB); PG8_STAGE(PG8_SA(0, 0), cA, voffA); PG8_STAGE(PG8_SB(0, 1), cB + hstep, voffB); PG8_STAGE(PG8_SA(0, 1), cA + hstep, voffA);
        if (wr == 1) PG8_BAR;
        PG8_WAIT_V(4); PG8_BAR;
        PG8_STAGE(PG8_SB(1, 0), cB + kstep, voffB); PG8_STAGE(PG8_SA(1, 0), cA + kstep, voffA); PG8_STAGE(PG8_SB(1, 1), cB + hstep + kstep, voffB);
        PG8_WAIT_V(6); PG8_BAR;
    }
    for (;;) {
        const bool has_next = S.next(ui + 1, nxt);
        const char* nA = has_next ? (const char*)g.A + (size_t)nxt.pm * tstep : cA; const char* nB = has_next ? (const char*)g.Bt + (size_t)nxt.pn * tstep : cB;
        for (int t = 0; t < nt; t += 2) {
            const bool last = (t == nt - 2);
            const char* a1 = cA + (size_t)(t + 1) * kstep;
            const char* a2 = last ? nA : cA + (size_t)(t + 2) * kstep; const char* b2 = last ? nB : cB + (size_t)(t + 2) * kstep;
            const char* a3 = a2 + kstep; const char* b3 = b2 + kstep;
            if (last && has_next) S.a_ready(nxt);
            if constexpr (SP2) {
            PG8_LDB(B0, 0, 0); PG8_LDB(B1, 0, 1); PG8_SCHED; PG8_LDA(At, 0, 0); PG8_STAGE(PG8_SA(1, 1), a1 + hstep, voffA);
            PG8_WAIT_V(8); PG8_WAIT_L(0); PG8_BAR; PG8_MMA(0, 0, At, B0); PG8_MMA(0, 1, At, B1); PG8_BAR; PG8_SCHED;
            PG8_LDA(At, 0, 1); PG8_STAGE(PG8_SB(0, 0), b2, voffB); PG8_STAGE(PG8_SB(0, 1), b2 + hstep, voffB); PG8_STAGE(PG8_SA(0, 0), a2, voffA);
            PG8_WAIT_V(8); PG8_WAIT_L(0); PG8_BAR; PG8_MMA(1, 0, At, B0); PG8_MMA(1, 1, At, B1); PG8_BAR; PG8_SCHED;
            PG8_LDB(B0, 1, 0); PG8_LDB(B1, 1, 1); PG8_SCHED; PG8_LDA(At, 1, 0); PG8_STAGE(PG8_SA(0, 1), a2 + hstep, voffA);
            PG8_WAIT_V(8); PG8_WAIT_L(0); PG8_BAR; PG8_MMA(0, 0, At, B0); PG8_MMA(0, 1, At, B1); PG8_BAR; PG8_SCHED;
            PG8_LDA(At, 1, 1); PG8_STAGE(PG8_SB(1, 0), b3, voffB); PG8_STAGE(PG8_SB(1, 1), b3 + hstep, voffB); PG8_STAGE(PG8_SA(1, 0), a3, voffA);
            PG8_WAIT_V(8); PG8_WAIT_L(0); PG8_BAR; PG8_MMA(1, 0, At, B0); PG8_MMA(1, 1, At, B1); PG8_BAR; PG8_SCHED;
            } else {
            PG8_LDB(B0, 0, 0); PG8_SCHED; PG8_LDA(At, 0, 0); PG8_STAGE(PG8_SA(1, 1), a1 + hstep, voffA);
            PG8_WAIT_L(8); PG8_BAR; PG8_WAIT_L(0); PG8_MMA(0, 0, At, B0); PG8_BAR; PG8_SCHED;
            PG8_LDB(B1, 0, 1); PG8_STAGE(PG8_SB(0, 0), b2, voffB);
            PG8_BAR; PG8_WAIT_L(0); PG8_MMA(0, 1, At, B1); PG8_BAR;
            PG8_LDA(At, 0, 1); PG8_STAGE(PG8_SA(0, 0), a2, voffA);
            PG8_BAR; PG8_WAIT_L(0); PG8_MMA(1, 0, At, B0); PG8_BAR; PG8_SCHED;
            PG8_STAGE(PG8_SB(0, 1), b2 + hstep, voffB);
            PG8_WAIT_V(6); PG8_BAR; PG8_MMA(1, 1, At, B1); PG8_BAR;
            PG8_LDB(B0, 1, 0); PG8_SCHED; PG8_LDA(At, 1, 0); PG8_STAGE(PG8_SA(0, 1), a2 + hstep, voffA);
            PG8_WAIT_L(8); PG8_BAR; PG8_WAIT_L(0); PG8_MMA(0, 0, At, B0); PG8_BAR; PG8_SCHED;
            PG8_LDB(B1, 1, 1); PG8_STAGE(PG8_SB(1, 0), b3, voffB);
            PG8_BAR; PG8_WAIT_L(0); PG8_MMA(0, 1, At, B1); PG8_BAR;
            PG8_LDA(At, 1, 1); PG8_STAGE(PG8_SA(1, 0), a3, voffA);
            PG8_BAR; PG8_WAIT_L(0); PG8_MMA(1, 0, At, B0); PG8_BAR; PG8_SCHED;
            PG8_STAGE(PG8_SB(1, 1), b3 + hstep, voffB);
            PG8_WAIT_V(6); PG8_BAR; PG8_MMA(1, 1, At, B1); PG8_BAR;
            }
        }
        if constexpr (ALIGN_EPI) { if (wr == 0) PG8_BAR; }
        if constexpr (!Epi::AFTER_DRAIN) { E(acc, cur, wr, wc, fr, fq); S.done(cur); }
        if (!has_next) break;
#pragma unroll
        for (int a = 0; a < 2; ++a)
#pragma unroll
            for (int b = 0; b < 2; ++b)
#pragma unroll
                for (int m = 0; m < 4; ++m)
#pragma unroll
                    for (int n = 0; n < 2; ++n) acc[a][b][m][n] = (f32x4){0.f, 0.f, 0.f, 0.f};
        cur = nxt; cA = nA; cB = nB; ++ui;
        if constexpr (ALIGN_EPI) { if (wr == 1) PG8_BAR; }
    }
    PG8_WAIT_V(0);
    if constexpr (!ALIGN_EPI) { if (wr == 0) PG8_BAR; }
    PG8_BAR;
    if constexpr (Epi::AFTER_DRAIN) { E.fused(acc, cur, wr, wc, fr, fq, lds, wid, lane); S.done(cur); }
#undef PG8_SA
#undef PG8_SB
#undef PG8_STAGE
#undef PG8_LDA
#undef PG8_LDB
#undef PG8_MMA
#undef PG8_WAIT_V
#undef PG8_WAIT_L
#undef PG8_BAR
#undef PG8_SCHED
}
}

#ifndef MK_ONE
#define MK_ONE 1
#endif
#define GAS __attribute__((address_space(1)))
#define LAS __attribute__((address_space(3)))
typedef unsigned short bf16;
typedef short bf16x8 __attribute__((ext_vector_type(8)));
typedef float f32x4 __attribute__((ext_vector_type(4)));
typedef unsigned u32x4 __attribute__((ext_vector_type(4)));
typedef unsigned u32x2 __attribute__((ext_vector_type(2)));

constexpr int NWAVES = 8, NTHR = 512;
constexpr int M = 32768, SEQ = 2048, NB = 16, D = 1024, FF = 4096, PLE = 256;
constexpr int NWIN = 3328, WIN_LD = 5328;
constexpr float LN_EPS = 1e-5f;
constexpr float ALPHA = 1.189207115002721f;
constexpr float IDX_W_SCALE = 0.04419417382415922f;
constexpr float QA_SCALE = 0.125f * 1.4426950408889634f;
constexpr float MLK_SCALE = 0.08838834764831845f;
constexpr int LDS_BYTES = 147456;
constexpr int NPHASE = 12;

constexpr size_t MiB = 1u << 20;
constexpr size_t WS_WIN = 1 * MiB, WS_WGA = 8 * MiB, WS_WGB = 10 * MiB, WS_WUA = 12 * MiB, WS_WUB = 13 * MiB, WS_WOUT = 14 * MiB,
                 WS_WFF1 = 16 * MiB, WS_WFF2 = 24 * MiB, WS_WPG = 32 * MiB, WS_WPP = 34 * MiB;
constexpr size_t WS_COS = 35 * MiB, WS_SIN = 39 * MiB, WS_WI = 43 * MiB, WS_IG = 44 * MiB, WS_LF = 44 * MiB + 512 * 1024;
constexpr size_t WS_KA = 45 * MiB, WS_KI = 49 * MiB, WS_VAT = 53 * MiB;
constexpr size_t WS_BCUM = 57 * MiB, WS_CS = 58 * MiB, WS_MST = 59 * MiB, WS_DN = 60 * MiB, WS_NST = 61 * MiB, WS_CST = 208 * MiB;
constexpr size_t WS_XB = 64 * MiB, WS_PB = 128 * MiB, WS_QA = 144 * MiB, WS_QI = 176 * MiB, WS_MLQK = 208 * MiB, WS_MLV = 272 * MiB,
                 WS_MLO = 304 * MiB, WS_QC = 336 * MiB, WS_DC = 400 * MiB, WS_YA = 464 * MiB, WS_END = 496 * MiB;
constexpr size_t WS_TMP = 336 * MiB, WS_MRG = 400 * MiB, WS_H1 = 64 * MiB, WS_HF = 144 * MiB, WS_RB = 400 * MiB, WS_PROJ = 144 * MiB;

__device__ __forceinline__ unsigned f2bf(float f) { unsigned u = __builtin_bit_cast(unsigned, f); return (u + 0x7fffu + ((u >> 16) & 1u)) >> 16; }
typedef float f32x2_t __attribute__((ext_vector_type(2)));
typedef __bf16 bf16x2_t __attribute__((ext_vector_type(2)));
__device__ __forceinline__ unsigned pk2(float lo, float hi) { f32x2_t v = {lo, hi}; bf16x2_t b = __builtin_convertvector(v, bf16x2_t); return __builtin_bit_cast(unsigned, b); }
__device__ __forceinline__ float bflo(unsigned w) { return __builtin_bit_cast(float, w << 16); }
__device__ __forceinline__ float bfhi(unsigned w) { return __builtin_bit_cast(float, w & 0xffff0000u); }
__device__ __forceinline__ float sigmoidf_(float x) { return __builtin_amdgcn_rcpf(1.0f + __expf(-x)); }
#define LDS_WAIT() asm volatile("s_waitcnt lgkmcnt(0)" ::: "memory")

__constant__ double INVF[32] = {1.0, 0.7498942093324559, 0.5623413251903491, 0.4216965034285822, 0.31622776601683794, 0.23713737056616552, 0.1778279410038923, 0.1333521432163324,
    0.1, 0.07498942093324558, 0.05623413251903491, 0.042169650342858224, 0.03162277660168379, 0.023713737056616554, 0.01778279410038923, 0.01333521432163324,
    0.01, 0.007498942093324558, 0.005623413251903491, 0.004216965034285823, 0.0031622776601683794, 0.0023713737056616554, 0.0017782794100389228, 0.001333521432163324,
    0.001, 0.0007498942093324559, 0.0005623413251903491, 0.00042169650342858224, 0.00031622776601683794, 0.00023713737056616554, 0.00017782794100389227, 0.0001333521432163324};

struct Args {
    const float* in[20]; float* out; unsigned char* ws; int ph_lo, ph_hi;
};
enum { I_X = 0, I_P, I_POS, I_WIN, I_CONVW, I_CONVB, I_BIG, I_BFG, I_MLNG, I_WUA, I_WUB, I_WOUT, I_LN1G, I_LN1B, I_WFF1, I_WFF2, I_WPG, I_WPP, I_LN2G, I_LN2B };

__device__ __forceinline__ int win_src(int n) {
    if (n < 512) { const int hh = n >> 6, j = n & 63; return hh * 64 + (j >> 1) + 32 * (j & 1); }
    if (n < 1024) { const int mm = n - 512, hh = mm >> 6, j = mm & 63; return 640 + hh * 64 + (j >> 1) + 32 * (j & 1); }
    if (n < 1280) { const int mm = n - 1024;
        if (mm < 64) return 512 + (mm >> 1) + 32 * (mm & 1);
        if (mm < 128) { const int j = mm - 64; return 1152 + (j >> 1) + 32 * (j & 1); }
        if (mm < 192) return 576 + (mm - 128);
        if (mm < 200) return 1216 + (mm - 192);
        if (mm < 204) return 2760 + (mm - 200);
        if (mm < 208) return 2764 + (mm - 204);
        return -1; }
    if (n < 2304) return 1224 + (n - 1280);
    if (n < 2816) return 2248 + (n - 2304);
    return 2768 + (n - 2816);
}

template <class SrcF>
__device__ __forceinline__ void transpose_item(const float* W, int K, int ldw, bf16* WT, int Nrows, LAS float* scr, int item, int lane, SrcF src) {
    const int nblk = Nrows / 32, kb = item / nblk, nb = item % nblk, k0 = 64 * kb, n0 = 32 * nb;
    const int sc = src(n0 + (lane & 31));
#pragma unroll 8
    for (int i = 0; i < 32; ++i) { const int kk = 2 * i + (lane >> 5); scr[kk * 33 + (lane & 31)] = sc >= 0 ? W[(size_t)(k0 + kk) * ldw + sc] : 0.f; }
    LDS_WAIT(); asm volatile("" ::: "memory");
    const int c = lane & 7;
#pragma unroll
    for (int j = 0; j < 4; ++j) { const int n = (lane >> 3) + 8 * j; const LAS float* s = scr + (8 * c) * 33 + n;
        u32x4 o; o.x = pk2(s[0 * 33], s[1 * 33]); o.y = pk2(s[2 * 33], s[3 * 33]); o.z = pk2(s[4 * 33], s[5 * 33]); o.w = pk2(s[6 * 33], s[7 * 33]);
        *(u32x4*)(WT + (size_t)(n0 + n) * K + k0 + 8 * c) = o; }
    LDS_WAIT(); asm volatile("" ::: "memory");
}

struct EpiWin {
    static constexpr bool PERM = true, AFTER_DRAIN = false;
    bf16 *QA, *QI, *KA, *KI, *VAT, *MLQK, *MLV, *MLO; float *WI, *IG, *LF; const float *COS, *SIN, *b_ig, *b_fg;
    __device__ __forceinline__ void operator()(const f32x4 (&acc)[2][2][4][2], const pg8::Unit& u, int wr, int wc, int fr, int fq) const {
        const int pn = u.pn, row0 = u.pm * 256 + wr * 64 + fr;
#pragma unroll
        for (int ai = 0; ai < 2; ++ai)
#pragma unroll
            for (int m = 0; m < 4; ++m) { const int r = row0 + ai * 128 + m * 16;
#pragma unroll
                for (int bj = 0; bj < 2; ++bj) { const int cl = bj * 128 + wc * 32 + 8 * fq; f32x4 v0 = acc[ai][bj][m][0], v1 = acc[ai][bj][m][1];
                    const bool rope = (pn < 4) || (pn == 4 && cl < 128);
                    if (rope) {
                        const int i0 = (cl & 63) >> 1;
                        const f32x4 c = *(const f32x4*)(COS + (unsigned)r * 32 + i0), s = *(const f32x4*)(SIN + (unsigned)r * 32 + i0);
                        const float sc = (pn < 2) ? QA_SCALE : 1.0f;
                        f32x4 o0, o1;
                        o0[0] = (v0[0] * c[0] - v0[1] * s[0]) * sc; o0[1] = (v0[1] * c[0] + v0[0] * s[0]) * sc;
                        o0[2] = (v0[2] * c[1] - v0[3] * s[1]) * sc; o0[3] = (v0[3] * c[1] + v0[2] * s[1]) * sc;
                        o1[0] = (v1[0] * c[2] - v1[1] * s[2]) * sc; o1[1] = (v1[1] * c[2] + v1[0] * s[2]) * sc;
                        o1[2] = (v1[2] * c[3] - v1[3] * s[3]) * sc; o1[3] = (v1[3] * c[3] + v1[2] * s[3]) * sc;
                        bf16* dst;
                        if (pn < 2) dst = QA + (unsigned)r * 512 + pn * 256 + cl;
                        else if (pn < 4) dst = QI + (unsigned)r * 512 + (pn - 2) * 256 + cl;
                        else dst = (cl < 64) ? (KA + (unsigned)r * 64 + cl) : (KI + (unsigned)r * 64 + (cl - 64));
                        u32x4 w; w.x = pk2(o0[0], o0[1]); w.y = pk2(o0[2], o0[3]); w.z = pk2(o1[0], o1[1]); w.w = pk2(o1[2], o1[3]);
                        *(u32x4*)dst = w;
                    } else if (pn == 4) {
                        if (cl < 192) { const int d0 = cl - 128, b = r >> 11, t = r & 2047; bf16* base = VAT + ((unsigned)(b * 64 + d0)) * 2048 + t;
#pragma unroll
                            for (int j = 0; j < 4; ++j) { base[(unsigned)j * 2048] = (bf16)f2bf(v0[j]); base[(unsigned)(j + 4) * 2048] = (bf16)f2bf(v1[j]); } }
                        else if (cl == 192) { *(f32x4*)(WI + (unsigned)r * 8) = v0 * IDX_W_SCALE; *(f32x4*)(WI + (unsigned)r * 8 + 4) = v1 * IDX_W_SCALE; }
                        else if (cl == 200) { f32x4 ig, lf;
#pragma unroll
                            for (int j = 0; j < 4; ++j) { ig[j] = v0[j] + b_ig[j]; const float f = v1[j] + b_fg[j]; lf[j] = fminf(f, 0.f) - log1pf(__expf(-fabsf(f))); }
                            *(f32x4*)(IG + (unsigned)r * 4) = ig; *(f32x4*)(LF + (unsigned)r * 4) = lf; }
                    } else {
                        bf16* dst;
                        if (pn < 9) dst = MLQK + (unsigned)r * 1024 + (pn - 5) * 256 + cl;
                        else if (pn < 11) dst = MLV + (unsigned)r * 512 + (pn - 9) * 256 + cl;
                        else { dst = MLO + (unsigned)r * 512 + (pn - 11) * 256 + cl;
#pragma unroll
                            for (int j = 0; j < 4; ++j) { v0[j] = sigmoidf_(v0[j]); v1[j] = sigmoidf_(v1[j]); } }
                        u32x4 w; w.x = pk2(v0[0], v0[1]); w.y = pk2(v0[2], v0[3]); w.z = pk2(v1[0], v1[1]); w.w = pk2(v1[2], v1[3]);
                        *(u32x4*)dst = w;
                    }
                }
                asm volatile("" ::: "memory"); }
    }
};

template <int MODE> struct EpiB {
    static constexpr bool PERM = true, AFTER_DRAIN = false;
    bf16* O; float* OF; const bf16* IB; const float* IF; int ldc;
    __device__ __forceinline__ void operator()(const f32x4 (&acc)[2][2][4][2], const pg8::Unit& u, int wr, int wc, int fr, int fq) const {
        const int row0 = u.pm * 256 + wr * 64 + fr, col0 = u.pn * 256 + wc * 32 + 8 * fq;
#pragma unroll
        for (int ai = 0; ai < 2; ++ai)
#pragma unroll
            for (int m = 0; m < 4; ++m) { const unsigned ro = (unsigned)(row0 + ai * 128 + m * 16) * ldc + col0;
#pragma unroll
                for (int bj = 0; bj < 2; ++bj) { const unsigned off = ro + bj * 128; f32x4 v0 = acc[ai][bj][m][0], v1 = acc[ai][bj][m][1];
                    if (MODE == 0) {
#pragma unroll
                        for (int j = 0; j < 4; ++j) { v0[j] = sigmoidf_(v0[j]); v1[j] = sigmoidf_(v1[j]); }
                    } else if (MODE == 3) {
#pragma unroll
                        for (int j = 0; j < 4; ++j) { const float a = fmaxf(v0[j], 0.f), b = fmaxf(v1[j], 0.f); v0[j] = a * a; v1[j] = b * b; }
                    } else {
                        const u32x4 t = *(const u32x4*)(IB + off);
                        v0[0] *= bflo(t.x); v0[1] *= bfhi(t.x); v0[2] *= bflo(t.y); v0[3] *= bfhi(t.y);
                        v1[0] *= bflo(t.z); v1[1] *= bfhi(t.z); v1[2] *= bflo(t.w); v1[3] *= bfhi(t.w);
                        if (MODE == 2) { v0 += *(const f32x4*)(IF + off); v1 += *(const f32x4*)(IF + off + 4); }
                    }
                    if (MODE == 1) { *(f32x4*)(OF + off) = v0; *(f32x4*)(OF + off + 4) = v1; }
                    else { u32x4 w; w.x = pk2(v0[0], v0[1]); w.y = pk2(v0[2], v0[3]); w.z = pk2(v1[0], v1[1]); w.w = pk2(v1[2], v1[3]); *(u32x4*)(O + off) = w; }
                }
                if (MODE == 1 || MODE == 2) asm volatile("" ::: "memory"); }
    }
};
template <int MODE> struct EpiF {
    static constexpr bool PERM = false, AFTER_DRAIN = false;
    float* OF; bf16* O; const float* IF; const bf16* IB; int ldc;
    __device__ __forceinline__ void operator()(const f32x4 (&acc)[2][2][4][2], const pg8::Unit& u, int wr, int wc, int fr, int fq) const {
        const int row0 = u.pm * 256 + wr * 64 + fr, col0 = u.pn * 256 + wc * 32 + 4 * fq;
#pragma unroll
        for (int ai = 0; ai < 2; ++ai)
#pragma unroll
            for (int m = 0; m < 4; ++m) { const unsigned ro = (unsigned)(row0 + ai * 128 + m * 16) * ldc + col0;
#pragma unroll
                for (int bj = 0; bj < 2; ++bj)
#pragma unroll
                    for (int n = 0; n < 2; ++n) { const unsigned off = ro + bj * 128 + n * 16; f32x4 v = acc[ai][bj][m][n];
                        if (MODE == 0) { v += ALPHA * *(const f32x4*)(IF + off); *(f32x4*)(OF + off) = v; }
                        else if (MODE == 1) { const u32x2 t = *(const u32x2*)(IB + off);
                            v[0] += ALPHA * bflo(t.x); v[1] += ALPHA * bfhi(t.x); v[2] += ALPHA * bflo(t.y); v[3] += ALPHA * bfhi(t.y);
                            *(f32x4*)(OF + off) = v; u32x2 w; w.x = pk2(v[0], v[1]); w.y = pk2(v[2], v[3]); *(u32x2*)(O + off) = w; }
                        else if (MODE == 2) { *(f32x4*)(OF + off) = v; }
                        else { const f32x4 pr = *(const f32x4*)(IF + off); f32x4 r = *(const f32x4*)(OF + off);
#pragma unroll
                            for (int j = 0; j < 4; ++j) r[j] += sigmoidf_(v[j]) * pr[j];
                            *(f32x4*)(OF + off) = r; }
                    }
                if (MODE != 2) asm volatile("" ::: "memory"); }
    }
};

__device__ __forceinline__ float wave_sum(float v) {
#pragma unroll
    for (int o = 1; o < 64; o <<= 1) v += __shfl_xor(v, o);
    return v;
}
__device__ __forceinline__ float wave_max(float v) {
#pragma unroll
    for (int o = 1; o < 64; o <<= 1) v = fmaxf(v, __shfl_xor(v, o));
    return v;
}
#define MFMA16(a, b, c) __builtin_amdgcn_mfma_f32_16x16x32_bf16((a), (b), (c), 0, 0, 0)

template <bool TO_BF16>
__device__ __forceinline__ void ln_row2(const float* x0, const float* x1, const float* gam, const float* bet, float* of0, float* of1, bf16* ob0, bf16* ob1, int lane) {
    const f32x4* xr0 = (const f32x4*)x0 + lane; const f32x4* xr1 = (const f32x4*)x1 + lane;
    f32x4 v[4], u[4]; float s = 0.f, t = 0.f;
#pragma unroll
    for (int j = 0; j < 4; ++j) { v[j] = xr0[64 * j]; u[j] = xr1[64 * j]; }
#pragma unroll
    for (int j = 0; j < 4; ++j) { s += (v[j][0] + v[j][1]) + (v[j][2] + v[j][3]); t += (u[j][0] + u[j][1]) + (u[j][2] + u[j][3]); }
#pragma unroll
    for (int o = 1; o < 64; o <<= 1) { s += __shfl_xor(s, o); t += __shfl_xor(t, o); }
    const float mean0 = s * (1.f / 1024.f), mean1 = t * (1.f / 1024.f); float s2 = 0.f, t2 = 0.f;
#pragma unroll
    for (int j = 0; j < 4; ++j) { v[j] = v[j] - mean0; u[j] = u[j] - mean1;
        s2 += (v[j][0] * v[j][0] + v[j][1] * v[j][1]) + (v[j][2] * v[j][2] + v[j][3] * v[j][3]); t2 += (u[j][0] * u[j][0] + u[j][1] * u[j][1]) + (u[j][2] * u[j][2] + u[j][3] * u[j][3]); }
#pragma unroll
    for (int o = 1; o < 64; o <<= 1) { s2 += __shfl_xor(s2, o); t2 += __shfl_xor(t2, o); }
    const float r0 = 1.f / sqrtf(s2 * (1.f / 1024.f) + LN_EPS), r1 = 1.f / sqrtf(t2 * (1.f / 1024.f) + LN_EPS);
#pragma unroll
    for (int j = 0; j < 4; ++j) { const f32x4 g = ((const f32x4*)gam)[lane + 64 * j], b = ((const f32x4*)bet)[lane + 64 * j]; const f32x4 o0 = v[j] * r0 * g + b, o1 = u[j] * r1 * g + b;
        if (TO_BF16) { u32x2 w; w.x = pk2(o0[0], o0[1]); w.y = pk2(o0[2], o0[3]); ((u32x2*)ob0)[lane + 64 * j] = w; w.x = pk2(o1[0], o1[1]); w.y = pk2(o1[2], o1[3]); ((u32x2*)ob1)[lane + 64 * j] = w; }
        else { ((f32x4*)of0)[lane + 64 * j] = o0; ((f32x4*)of1)[lane + 64 * j] = o1; } }
}

constexpr int SC_LD = 2052;
constexpr int MK_OFF = 16 * SC_LD * 4;
__device__ __forceinline__ void mixa_unit(const bf16* QI, const bf16* KI, const float* WI, const bf16* QA, bf16* YA, const bf16* KA, const bf16* VAT,
                                          LAS unsigned char* lds, int b, int qt) {
    const int tid = threadIdx.x, w = __builtin_amdgcn_readfirstlane(tid >> 6), lane = tid & 63, n = lane & 15, g = lane >> 4;
    const int rowbase = b * SEQ + qt * 16, nk16 = qt + 1;
    LAS float* SC = (LAS float*)lds;
    LAS unsigned long long* MK = (LAS unsigned long long*)(lds + MK_OFF);
    const f32x4 zero4 = {0.f, 0.f, 0.f, 0.f};
    {
        bf16x8 qf[8][2];
        const bf16* qrow = QI + (size_t)(rowbase + n) * 512 + 8 * g;
#pragma unroll
        for (int h = 0; h < 8; ++h) { qf[h][0] = *(const bf16x8*)(qrow + h * 64); qf[h][1] = *(const bf16x8*)(qrow + h * 64 + 32); }
        const f32x4 w0 = *(const f32x4*)(WI + (size_t)(rowbase + n) * 8), w1 = *(const f32x4*)(WI + (size_t)(rowbase + n) * 8 + 4);
        const float wv[8] = {w0[0], w0[1], w0[2], w0[3], w1[0], w1[1], w1[2], w1[3]};
        const bf16* kbase = KI + (size_t)(b * SEQ + n) * 64 + 8 * g;
        const int ntw = (nk16 > w) ? ((nk16 - w + 7) >> 3) : 0;
        bf16x8 ka[2][2], kbv[2][2];
#define P1_LOAD(dst, g0) do { _Pragma("unroll") for (int i_ = 0; i_ < 2; ++i_) { int ti_ = (g0) * 2 + i_; ti_ = ti_ < ntw ? ti_ : (ntw - 1); const bf16* p_ = kbase + (size_t)(w + 8 * ti_) * 1024; \
            dst[i_][0] = *(const bf16x8*)p_; dst[i_][1] = *(const bf16x8*)(p_ + 32); } } while (0)
#define P1_COMP(src, g0) do { _Pragma("unroll") for (int i_ = 0; i_ < 2; ++i_) { const int ti_ = (g0) * 2 + i_; if (ti_ < ntw) { const int kt = w + 8 * ti_; f32x4 sc = zero4; \
            _Pragma("unroll") for (int h = 0; h < 8; ++h) { f32x4 a = MFMA16(src[i_][0], qf[h][0], zero4); a = MFMA16(src[i_][1], qf[h][1], a); \
                _Pragma("unroll") for (int i = 0; i < 4; ++i) sc[i] += fmaxf(a[i], 0.f) * wv[h]; } \
            if (kt == qt) { _Pragma("unroll") for (int i = 0; i < 4; ++i) if (4 * g + i > n) sc[i] = -INFINITY; } \
            *(LAS f32x4*)(SC + n * SC_LD + kt * 16 + 4 * g) = sc; } } } while (0)
        if (ntw > 0) {
            const int ng = (ntw + 1) >> 1;
            P1_LOAD(ka, 0);
            for (int g0 = 0; g0 < ng; g0 += 2) {
                if (g0 + 1 < ng) P1_LOAD(kbv, g0 + 1);
                P1_COMP(ka, g0);
                if (g0 + 1 >= ng) break;
                if (g0 + 2 < ng) P1_LOAD(ka, g0 + 2);
                P1_COMP(kbv, g0 + 1);
            }
        }
#undef P1_LOAD
#undef P1_COMP
    }
    __syncthreads();
#pragma unroll 1
    for (int qq = 0; qq < 2; ++qq) {
        const int nq = 2 * w + qq, t = qt * 16 + nq, Lr = 16 * nk16, nj = (Lr + 63) >> 6;
        unsigned key[32];
#pragma unroll
        for (int j = 0; j < 32; ++j) { const int idx = lane + 64 * j; float v = -INFINITY; if (j < nj && idx < Lr) v = SC[nq * SC_LD + idx];
            const unsigned uu = __builtin_bit_cast(unsigned, v); key[j] = (uu & 0x80000000u) ? ~uu : (uu | 0x80000000u); }
        if (t + 1 <= 256) {
#pragma unroll
            for (int j = 0; j < 32; ++j) { const unsigned long long mm = __ballot(lane + 64 * j <= t); if (lane == 0) MK[nq * 32 + j] = mm; }
        } else {
            unsigned T = 0u; bool exact = false;
#pragma unroll 1
            for (int bit = 31; bit >= 0; --bit) {
                const unsigned cand = T | (1u << bit); int cnt = 0;
#pragma unroll
                for (int j = 0; j < 32; ++j) if (j < nj) cnt += __popcll(__ballot(key[j] >= cand));
                if (cnt >= 256) { T = cand; if (cnt == 256) { exact = true; break; } }
            }
            int need = 0x7fffffff;
            if (!exact) { int cgt = 0;
#pragma unroll
                for (int j = 0; j < 32; ++j) if (j < nj) cgt += __popcll(__ballot(key[j] > T));
                need = 256 - cgt; }
            int tb = 0; const unsigned long long ltm = (1ull << lane) - 1ull;
#pragma unroll
            for (int j = 0; j < 32; ++j) {
                unsigned long long selm = 0ull;
                if (j < nj) { const bool eq = key[j] == T; const unsigned long long eqm = __ballot(eq);
                    const int myrank = tb + __popcll(eqm & ltm);
                    selm = __ballot(key[j] > T || (eq && myrank < need)); tb += __popcll(eqm); }
                if (lane == 0) MK[nq * 32 + j] = selm;
            }
        }
    }
    __syncthreads();
    {
        constexpr int TLD = 72;
        LAS bf16* KT = (LAS bf16*)lds;
        LAS bf16* VTT = (LAS bf16*)(lds + 2 * 64 * TLD * 2);
        const bf16* qrow = QA + (size_t)(rowbase + n) * 512 + w * 64 + 8 * g;
        const bf16x8 qa0 = *(const bf16x8*)qrow, qa1 = *(const bf16x8*)(qrow + 32);
        f32x4 o[4] = {zero4, zero4, zero4, zero4}; float mrun = -1e30f, lsum = 0.f;
        const int nT = (nk16 + 3) >> 2;
        const int srow = tid >> 3, sch = tid & 7;
        const bf16* kg = KA + (size_t)(b * SEQ + srow) * 64 + sch * 8;
        const bf16* vg = VAT + (size_t)(b * 64 + srow) * 2048 + sch * 8;
        u32x4 rkA = *(const u32x4*)kg, rvA = *(const u32x4*)vg, rkB = rkA, rvB = rvA;
        if (nT > 1) { rkB = *(const u32x4*)(kg + 4096); rvB = *(const u32x4*)(vg + 64); }
        *(LAS u32x4*)(KT + srow * TLD + sch * 8) = rkA; *(LAS u32x4*)(VTT + srow * TLD + sch * 8) = rvA;
        __syncthreads();
#define MIXA_TILE(T, buf) do { \
            const LAS bf16* kt = KT + (buf) * 64 * TLD; const LAS bf16* vt = VTT + (buf) * 64 * TLD; \
            const unsigned long long mw = MK[n * 32 + (T)]; \
            _Pragma("unroll") for (int kb2 = 0; kb2 < 2; ++kb2) { \
            f32x4 st[2]; \
            _Pragma("unroll") for (int tt = 0; tt < 2; ++tt) { const LAS bf16* kp = kt + (32 * kb2 + 16 * tt + n) * TLD + 8 * g; \
            const bf16x8 k0 = *(const LAS bf16x8*)kp, k1 = *(const LAS bf16x8*)(kp + 32); \
            st[tt] = MFMA16(k0, qa0, zero4); st[tt] = MFMA16(k1, qa1, st[tt]); } \
            const unsigned hs = (kb2 ? (unsigned)(mw >> 32) : (unsigned)mw) >> (4 * g); \
            float bm = -INFINITY; \
            _Pragma("unroll") for (int tt = 0; tt < 2; ++tt) \
            _Pragma("unroll") for (int i = 0; i < 4; ++i) { const bool sel = (hs >> (16 * tt + i)) & 1u; st[tt][i] = sel ? st[tt][i] : -INFINITY; bm = fmaxf(bm, st[tt][i]); } \
            bm = fmaxf(bm, __shfl_xor(bm, 16)); bm = fmaxf(bm, __shfl_xor(bm, 32)); \
            const float mn = fmaxf(mrun, bm), alpha = __builtin_amdgcn_exp2f(mrun - mn); mrun = mn; \
            float ps = 0.f; \
            _Pragma("unroll") for (int tt = 0; tt < 2; ++tt) \
            _Pragma("unroll") for (int i = 0; i < 4; ++i) { st[tt][i] = __builtin_amdgcn_exp2f(st[tt][i] - mn); ps += st[tt][i]; } \
            lsum = lsum * alpha + ps; \
            u32x4 pw; pw.x = pk2(st[0][0], st[0][1]); pw.y = pk2(st[0][2], st[0][3]); pw.z = pk2(st[1][0], st[1][1]); pw.w = pk2(st[1][2], st[1][3]); \
            const bf16x8 pb = __builtin_bit_cast(bf16x8, pw); \
            _Pragma("unroll") for (int dt = 0; dt < 4; ++dt) { const LAS bf16* vp = vt + (16 * dt + n) * TLD + 32 * kb2 + 4 * g; \
            const u32x2 lo = *(const LAS u32x2*)vp, hi = *(const LAS u32x2*)(vp + 16); \
            u32x4 vv; vv.x = lo.x; vv.y = lo.y; vv.z = hi.x; vv.w = hi.y; \
            o[dt] = o[dt] * alpha; o[dt] = MFMA16(__builtin_bit_cast(bf16x8, vv), pb, o[dt]); } \
            } \
        } while (0)
        for (int T0 = 0; T0 < nT; T0 += 2) {
            if (T0 + 2 < nT) { rkA = *(const u32x4*)(kg + (size_t)(T0 + 2) * 4096); rvA = *(const u32x4*)(vg + (T0 + 2) * 64); }
            MIXA_TILE(T0, 0);
            if (T0 + 1 < nT) { *(LAS u32x4*)(KT + 64 * TLD + srow * TLD + sch * 8) = rkB; *(LAS u32x4*)(VTT + 64 * TLD + srow * TLD + sch * 8) = rvB; }
            __syncthreads();
            if (T0 + 1 >= nT) break;
            if (T0 + 3 < nT) { rkB = *(const u32x4*)(kg + (size_t)(T0 + 3) * 4096); rvB = *(const u32x4*)(vg + (T0 + 3) * 64); }
            MIXA_TILE(T0 + 1, 1);
            if (T0 + 2 < nT) { *(LAS u32x4*)(KT + srow * TLD + sch * 8) = rkA; *(LAS u32x4*)(VTT + srow * TLD + sch * 8) = rvA; }
            __syncthreads();
        }
#undef MIXA_TILE
        lsum += __shfl_xor(lsum, 16); lsum += __shfl_xor(lsum, 32);
        const float inv = 1.0f / lsum;
        bf16* orow = YA + (size_t)(rowbase + n) * 512 + w * 64 + 4 * g;
#pragma unroll
        for (int dt = 0; dt < 4; ++dt) { u32x2 ww; ww.x = pk2(o[dt][0] * inv, o[dt][1] * inv); ww.y = pk2(o[dt][2] * inv, o[dt][3] * inv); *(u32x2*)(orow + dt * 16) = ww; }
    }
    __syncthreads();
}

constexpr int KW_LD = 72;
__device__ __forceinline__ void m1_unit(const bf16* MLQK, const bf16* MLV, const float* IG, const float* LF, const float* conv_w, const float* conv_b,
                                        bf16* QC, bf16* DC, float* DN, float* BCUM, float* CS, LAS unsigned char* lds, int unit) {
    const int c = unit & 31, bh = unit >> 5, h = bh & 3, b = bh >> 2;
    const int tid = threadIdx.x, w = __builtin_amdgcn_readfirstlane(tid >> 6), lane = tid & 63, n = lane & 15, g = lane >> 4;
    const int rowbase = b * SEQ + c * 64;
    LAS float* WK = (LAS float*)lds;
    LAS bf16* KWT = (LAS bf16*)(lds + 1024);
    LAS bf16* VT = (LAS bf16*)(lds + 1024 + 128 * KW_LD * 2);
    if (w == 0) {
        const float lf = LF[(size_t)(rowbase + lane) * 4 + h], ig = IG[(size_t)(rowbase + lane) * 4 + h];
        float bc = lf;
#pragma unroll
        for (int o = 1; o < 64; o <<= 1) { const float tt = __shfl_up(bc, o); if (lane >= o) bc += tt; }
        const float bl = __shfl(bc, 63), gj = bl - bc + ig, mg = wave_max(gj);
        WK[lane] = __expf(gj - mg);
        BCUM[(size_t)(rowbase + lane) * 4 + h] = bc;
        if (lane == 0) { CS[unit * 2] = bl; CS[unit * 2 + 1] = mg; }
    }
    __syncthreads();
    {
        const int isk = (tid >> 4) & 1, cgi = tid & 15, rl = tid >> 5;
        const int ch = isk * 512 + h * 128 + cgi * 8;
        float cw[4][8], cb[8];
#pragma unroll
        for (int j = 0; j < 4; ++j) { const f32x4 a = *(const f32x4*)(conv_w + j * 1024 + ch), bb = *(const f32x4*)(conv_w + j * 1024 + ch + 4);
            cw[j][0] = a[0]; cw[j][1] = a[1]; cw[j][2] = a[2]; cw[j][3] = a[3]; cw[j][4] = bb[0]; cw[j][5] = bb[1]; cw[j][6] = bb[2]; cw[j][7] = bb[3]; }
        { const f32x4 a = *(const f32x4*)(conv_b + ch), bb = *(const f32x4*)(conv_b + ch + 4);
            cb[0] = a[0]; cb[1] = a[1]; cb[2] = a[2]; cb[3] = a[3]; cb[4] = bb[0]; cb[5] = bb[1]; cb[6] = bb[2]; cb[7] = bb[3]; }
        float x[7][8];
#pragma unroll
        for (int rr = 0; rr < 7; ++rr) { const int tl = c * 64 + 4 * rl + rr - 3;
            u32x4 t = {0u, 0u, 0u, 0u};
            if (tl >= 0) t = *(const u32x4*)(MLQK + (size_t)(b * SEQ + tl) * 1024 + ch);
            x[rr][0] = bflo(t.x); x[rr][1] = bfhi(t.x); x[rr][2] = bflo(t.y); x[rr][3] = bfhi(t.y); x[rr][4] = bflo(t.z); x[rr][5] = bfhi(t.z); x[rr][6] = bflo(t.w); x[rr][7] = bfhi(t.w); }
#pragma unroll
        for (int oo = 0; oo < 4; ++oo) { const int jr = 4 * rl + oo; float y[8];
#pragma unroll
            for (int e = 0; e < 8; ++e) { float a = cb[e];
#pragma unroll
                for (int j = 0; j < 4; ++j) a += cw[j][e] * x[oo + j][e];
                a = a * sigmoidf_(a); y[e] = isk ? a * MLK_SCALE : a; }
            u32x4 wv; wv.x = pk2(y[0], y[1]); wv.y = pk2(y[2], y[3]); wv.z = pk2(y[4], y[5]); wv.w = pk2(y[6], y[7]);
            *(u32x4*)(QC + (size_t)(rowbase + jr) * 1024 + ch) = wv;
            if (isk) { const float wk = WK[jr];
#pragma unroll
                for (int e = 0; e < 8; ++e) KWT[(cgi * 8 + e) * KW_LD + jr] = (bf16)f2bf(y[e] * wk); }
        }
#pragma unroll
        for (int q = 0; q < 2; ++q) { const int idx = tid + 512 * q, row = idx >> 4, cgv = idx & 15;
            const u32x4 t = *(const u32x4*)(MLV + (size_t)(rowbase + row) * 512 + h * 128 + cgv * 8);
            LAS bf16* vp = VT + (cgv * 8) * KW_LD + row;
            vp[0 * KW_LD] = (bf16)(t.x & 0xffffu); vp[1 * KW_LD] = (bf16)(t.x >> 16); vp[2 * KW_LD] = (bf16)(t.y & 0xffffu); vp[3 * KW_LD] = (bf16)(t.y >> 16);
            vp[4 * KW_LD] = (bf16)(t.z & 0xffffu); vp[5 * KW_LD] = (bf16)(t.z >> 16); vp[6 * KW_LD] = (bf16)(t.w & 0xffffu); vp[7 * KW_LD] = (bf16)(t.w >> 16); }
    }
    __syncthreads();
    {
        f32x4 acc[8];
#pragma unroll
        for (int et = 0; et < 8; ++et) acc[et] = (f32x4){0.f, 0.f, 0.f, 0.f};
#pragma unroll
        for (int ks = 0; ks < 2; ++ks) { const bf16x8 a = *(const LAS bf16x8*)(KWT + (16 * w + n) * KW_LD + 32 * ks + 8 * g);
#pragma unroll
            for (int et = 0; et < 8; ++et) { const bf16x8 bfr = *(const LAS bf16x8*)(VT + (16 * et + n) * KW_LD + 32 * ks + 8 * g); acc[et] = MFMA16(a, bfr, acc[et]); } }
        bf16* dcu = DC + (size_t)unit * 16384;
#pragma unroll
        for (int et = 0; et < 8; ++et) { u32x2 ww; ww.x = pk2(acc[et][0], acc[et][1]); ww.y = pk2(acc[et][2], acc[et][3]); *(u32x2*)(dcu + (16 * et + n) * 128 + 16 * w + 4 * g) = ww; }
        if (tid < 128) { float s = 0.f;
#pragma unroll 8
            for (int j = 0; j < 64; ++j) s += __builtin_bit_cast(float, (unsigned)KWT[tid * KW_LD + j] << 16);
            DN[(size_t)unit * 128 + tid] = s; }
    }
    __syncthreads();
}

constexpr int CT_LD = 136;
__device__ __forceinline__ void m3_unit(const bf16* QC, bf16* MLV  , const bf16* MLO, const float* IG, const float* BCUM, const float* MST,
                                        const bf16* DC, const float* DN, const float* gnorm, LAS unsigned char* lds, int unit) {
    const int c = unit & 31, bh = unit >> 5, h = bh & 3, b = bh >> 2;
    const int tid = threadIdx.x, w = __builtin_amdgcn_readfirstlane(tid >> 6), lane = tid & 63, n = lane & 15, g = lane >> 4;
    const int rowbase = b * SEQ + c * 64;
    LAS float* U = (LAS float*)lds; LAS float* R = U + 64; LAS float* WINT = U + 128; LAS float* EMR = U + 192; LAS float* NS = U + 256; LAS float* XCH = U + 384;
    LAS bf16* CT = (LAS bf16*)(lds + 4096);
    LAS bf16* KS = (LAS bf16*)(lds + 4096 + 128 * CT_LD * 2);
    LAS bf16* VT = (LAS bf16*)(lds + 4096 + 128 * CT_LD * 2 + 64 * CT_LD * 2);
    if (w == 0) {
        const float bc = BCUM[(size_t)(rowbase + lane) * 4 + h], ig = IG[(size_t)(rowbase + lane) * 4 + h], mc = MST[unit];
        const float uu = ig - bc; float a = uu;
#pragma unroll
        for (int o = 1; o < 64; o <<= 1) { const float tt = __shfl_up(a, o); if (lane >= o) a = fmaxf(a, tt); }
        const float mrow = bc + fmaxf(a, mc);
        U[lane] = uu; R[lane] = bc - mrow; WINT[lane] = __expf(bc + mc - mrow); EMR[lane] = __expf(-mrow);
    }
    {
        const bf16* dcu = DC + (size_t)unit * 16384;
#pragma unroll
        for (int q = 0; q < 4; ++q) { const int idx = tid + 512 * q, e = idx >> 4, dg = idx & 15; *(LAS u32x4*)(CT + e * CT_LD + dg * 8) = *(const u32x4*)(dcu + idx * 8); }
#pragma unroll
        for (int q = 0; q < 2; ++q) { const int idx = tid + 512 * q, s = idx >> 4, dg = idx & 15;
            *(LAS u32x4*)(KS + s * CT_LD + dg * 8) = *(const u32x4*)(QC + (size_t)(rowbase + s) * 1024 + 512 + h * 128 + dg * 8); }
#pragma unroll
        for (int q = 0; q < 2; ++q) { const int idx = tid + 512 * q, row = idx >> 4, cgv = idx & 15;
            const u32x4 t = *(const u32x4*)(MLV + (size_t)(rowbase + row) * 512 + h * 128 + cgv * 8);
            LAS bf16* vp = VT + (cgv * 8) * KW_LD + row;
            vp[0 * KW_LD] = (bf16)(t.x & 0xffffu); vp[1 * KW_LD] = (bf16)(t.x >> 16); vp[2 * KW_LD] = (bf16)(t.y & 0xffffu); vp[3 * KW_LD] = (bf16)(t.y >> 16);
            vp[4 * KW_LD] = (bf16)(t.z & 0xffffu); vp[5 * KW_LD] = (bf16)(t.z >> 16); vp[6 * KW_LD] = (bf16)(t.w & 0xffffu); vp[7 * KW_LD] = (bf16)(t.w >> 16); }
        if (tid < 128) NS[tid] = DN[(size_t)unit * 128 + tid];
    }
    __syncthreads();
#ifdef M3_LITE
    {
        const int lt = w & 3, eh = w >> 2, l = 16 * lt + n;
#pragma unroll
        for (int j = 0; j < 4; ++j) { const int e0 = 16 * (4 * eh + j) + 4 * g; float y[4];
#pragma unroll
            for (int i = 0; i < 4; ++i) { const int e = e0 + i;
                y[i] = 0.f;
                if (M3_LITE & 1) y[i] += __builtin_bit_cast(float, (unsigned)CT[e * CT_LD + ((l * 2 + 1) & 127)] << 16);
                if (M3_LITE & 2) y[i] += __builtin_bit_cast(float, (unsigned)KS[l * CT_LD + e] << 16);
                if (M3_LITE & 4) y[i] += __builtin_bit_cast(float, (unsigned)VT[e * KW_LD + l] << 16);
                if (M3_LITE & 8) y[i] += NS[e];
                if (M3_LITE & 16) y[i] += U[l] + R[l];
                if (M3_LITE & 32) y[i] += WINT[l] + EMR[l]; }
            const size_t off = (size_t)(rowbase + l) * 512 + h * 128 + e0;
            u32x2 ww; ww.x = pk2(y[0], y[1]); ww.y = pk2(y[2], y[3]); *(u32x2*)(MLV + off) = ww; }
        __syncthreads();
        return;
    }
#endif
    const int lt = w & 3, eh = w >> 2, l = 16 * lt + n;
    bf16x8 qf[4];
    { const bf16* qrow = QC + (size_t)(rowbase + l) * 1024 + h * 128 + 8 * g;
#pragma unroll
        for (int ks = 0; ks < 4; ++ks) qf[ks] = *(const bf16x8*)(qrow + 32 * ks); }
    const f32x4 zero4 = {0.f, 0.f, 0.f, 0.f};
    f32x4 sw[4]; const float Rl = R[l], wint = WINT[l], emr = EMR[l];
    float dsum = 0.f;
#pragma unroll
    for (int st = 0; st < 4; ++st) {
        sw[st] = zero4;
        if (st <= lt) { f32x4 acc = zero4;
#pragma unroll
            for (int ks = 0; ks < 4; ++ks) { const bf16x8 a = *(const LAS bf16x8*)(KS + (16 * st + n) * CT_LD + 32 * ks + 8 * g); acc = MFMA16(a, qf[ks], acc); }
#pragma unroll
            for (int i = 0; i < 4; ++i) { const int s = 16 * st + 4 * g + i; const float wgt = (s <= l) ? __expf(U[s] + Rl) : 0.f; sw[st][i] = acc[i] * wgt; dsum += sw[st][i]; } }
    }
    dsum += __shfl_xor(dsum, 16); dsum += __shfl_xor(dsum, 32);
    float qn = 0.f;
#pragma unroll
    for (int ks = 0; ks < 4; ++ks) { const u32x4 qq = __builtin_bit_cast(u32x4, qf[ks]); const LAS float* np = NS + 32 * ks + 8 * g;
        qn += bflo(qq.x) * np[0] + bfhi(qq.x) * np[1] + bflo(qq.y) * np[2] + bfhi(qq.y) * np[3] + bflo(qq.z) * np[4] + bfhi(qq.z) * np[5] + bflo(qq.w) * np[6] + bfhi(qq.w) * np[7]; }
    qn += __shfl_xor(qn, 16); qn += __shfl_xor(qn, 32);
    const float den = wint * qn + dsum;
    const float rden = 1.0f / fmaxf(fabsf(den), emr);
    f32x4 hv[4]; float s1 = 0.f;
#pragma unroll
    for (int j = 0; j < 4; ++j) { const int et = 4 * eh + j;
        f32x4 accS = zero4, accC = zero4;
#pragma unroll
        for (int kb = 0; kb < 2; ++kb) if (2 * kb <= lt) {
            u32x4 pw; pw.x = pk2(sw[2 * kb][0], sw[2 * kb][1]); pw.y = pk2(sw[2 * kb][2], sw[2 * kb][3]); pw.z = pk2(sw[2 * kb + 1][0], sw[2 * kb + 1][1]); pw.w = pk2(sw[2 * kb + 1][2], sw[2 * kb + 1][3]);
            const LAS bf16* vp = VT + (16 * et + n) * KW_LD + 32 * kb + 4 * g;
            const u32x2 lo = *(const LAS u32x2*)vp, hi = *(const LAS u32x2*)(vp + 16);
            u32x4 vv; vv.x = lo.x; vv.y = lo.y; vv.z = hi.x; vv.w = hi.y;
            accS = MFMA16(__builtin_bit_cast(bf16x8, vv), __builtin_bit_cast(bf16x8, pw), accS); }
#pragma unroll
        for (int ks = 0; ks < 4; ++ks) { const bf16x8 a = *(const LAS bf16x8*)(CT + (16 * et + n) * CT_LD + 32 * ks + 8 * g); accC = MFMA16(a, qf[ks], accC); }
#pragma unroll
        for (int i = 0; i < 4; ++i) { hv[j][i] = (wint * accC[i] + accS[i]) * rden; s1 += hv[j][i]; }
    }
    s1 += __shfl_xor(s1, 16); s1 += __shfl_xor(s1, 32);
    const float mloc = s1 * (1.f / 64.f); float q2 = 0.f;
#pragma unroll
    for (int j = 0; j < 4; ++j)
#pragma unroll
        for (int i = 0; i < 4; ++i) { const float dd = hv[j][i] - mloc; q2 += dd * dd; }
    q2 += __shfl_xor(q2, 16); q2 += __shfl_xor(q2, 32);
    if (g == 0) { XCH[(l * 2 + eh) * 2] = mloc; XCH[(l * 2 + eh) * 2 + 1] = q2; }
    __syncthreads();
    {
        const float mo = XCH[(l * 2 + (eh ^ 1)) * 2], qo = XCH[(l * 2 + (eh ^ 1)) * 2 + 1];
        const float mean = 0.5f * (mloc + mo), dm = mloc - mo, m2 = q2 + qo + 32.f * dm * dm;
        const float rstd = 1.0f / sqrtf(m2 * (1.f / 128.f) + LN_EPS);
#pragma unroll
        for (int j = 0; j < 4; ++j) { const int e0 = 16 * (4 * eh + j) + 4 * g;
            const f32x4 gn = *(const f32x4*)(gnorm + h * 128 + e0);
            const size_t off = (size_t)(rowbase + l) * 512 + h * 128 + e0;
            const u32x2 so = *(const u32x2*)(MLO + off);
            const float y0 = (hv[j][0] - mean) * rstd * gn[0] * bflo(so.x), y1 = (hv[j][1] - mean) * rstd * gn[1] * bfhi(so.x);
            const float y2 = (hv[j][2] - mean) * rstd * gn[2] * bflo(so.y), y3 = (hv[j][3] - mean) * rstd * gn[3] * bfhi(so.y);
            u32x2 ww; ww.x = pk2(y0, y1); ww.y = pk2(y2, y3); *(u32x2*)(MLV + off) = ww; }
    }
    __syncthreads();
}

#define XB_TMO      128
#define XB_XCNT(j)  (256  + 64 * (j))
#define XB_XSUB(j)  (1280 + 64 * (j))
#define XB_XGEN(j)  (2304 + 64 * (j))
#define XB_TOP      3328
#define XB_TOPGEN   3392
#define XCD_BAR_WORDS 3456
#define XB_SPIN_CAP (1u << 18)

__device__ __forceinline__ unsigned xb_ld(unsigned* p)              { return __hip_atomic_load(p, __ATOMIC_RELAXED, __HIP_MEMORY_SCOPE_AGENT); }
__device__ __forceinline__ unsigned xb_add(unsigned* p, unsigned v) { return __hip_atomic_fetch_add(p, v, __ATOMIC_RELAXED, __HIP_MEMORY_SCOPE_AGENT); }
__device__ __forceinline__ unsigned xb_xcc_id() { return (unsigned)__builtin_amdgcn_s_getreg((3 << 11) | 20) & 0xFu; }
#define XB_SPIN(cond, bar) do { unsigned _sp = 0; while (cond) { __builtin_amdgcn_s_sleep(1); \
    if ((++_sp & 255u) == 0u) { if (xb_ld(&(bar)[XB_TMO])) break; if (_sp > XB_SPIN_CAP) { atomicAdd(&(bar)[XB_TMO], 1u); break; } } } } while (0)

struct XcdBarrier {
    unsigned* bar; unsigned x;
    volatile LAS unsigned* st;
};

__device__ __forceinline__ XcdBarrier xcd_barrier_post(unsigned* bar, volatile LAS unsigned* st) {
    XcdBarrier b; b.bar = bar; b.x = xb_xcc_id(); b.st = st;
    if (threadIdx.x == 0) (void)xb_add(&bar[XB_XCNT(b.x)], 1u);
    return b;
}
__device__ __forceinline__ void xcd_barrier_complete(unsigned* bar, unsigned x, unsigned& nloc, unsigned& nx) {
    const unsigned G = gridDim.x * gridDim.y * gridDim.z;
    unsigned sum, cnt, mine, sp = 0u;
    for (;;) {
        sum = 0u; cnt = 0u; mine = 0u;
#pragma unroll
        for (unsigned j = 0; j < 16; ++j) { const unsigned c = xb_ld(&bar[XB_XCNT(j)]); sum += c; cnt += (c > 0u) ? 1u : 0u; mine = (j == x) ? c : mine; }
        if (sum == G) break;
        __builtin_amdgcn_s_sleep(1);
        if ((++sp & 255u) == 0u) { if (xb_ld(&bar[XB_TMO])) break; if (sp > XB_SPIN_CAP) { atomicAdd(&bar[XB_TMO], 1u); break; } }
    }
    nloc = mine > 0u ? mine : 1u; nx = cnt > 0u ? cnt : 1u;
}

__device__ __forceinline__ void xcd_barrier(const XcdBarrier& b) {
    asm volatile("s_waitcnt vmcnt(0)" ::: "memory");
    __syncthreads();
    if (threadIdx.x == 0) {
        unsigned* bar = b.bar;
        __builtin_amdgcn_s_waitcnt(0);
        unsigned nloc = b.st[0], nx = b.st[1];
        if (nloc == 0u) { xcd_barrier_complete(bar, b.x, nloc, nx); b.st[0] = nloc; b.st[1] = nx; }
        const unsigned old = xb_add(&bar[XB_XSUB(b.x)], 1u);
        const unsigned gen = old / nloc;
        if (old + 1u == (gen + 1u) * nloc) {
            __builtin_amdgcn_fence(__ATOMIC_RELEASE, "agent");
            asm volatile("s_waitcnt vmcnt(0)" ::: "memory");
            const unsigned og = xb_add(&bar[XB_TOP], 1u);
            const unsigned tg = og / nx;
            if (og + 1u == (tg + 1u) * nx) xb_add(&bar[XB_TOPGEN], 1u);
            else XB_SPIN(xb_ld(&bar[XB_TOPGEN]) == tg, bar);
            __builtin_amdgcn_fence(__ATOMIC_ACQUIRE, "agent");
            xb_add(&bar[XB_XGEN(b.x)], 1u);
            asm volatile("s_waitcnt vmcnt(0)" ::: "memory");
        } else {
            XB_SPIN(xb_ld(&bar[XB_XGEN(b.x)]) == gen, bar);
            __builtin_amdgcn_fence(__ATOMIC_ACQUIRE, "agent");
            asm volatile("s_waitcnt vmcnt(0)" ::: "memory");
        }
    }
    __syncthreads();
}

__global__ void __launch_bounds__(NTHR, 2) fwd_kernel(Args args) {
    extern __shared__ __attribute__((aligned(16))) unsigned char lds_raw[];
    LAS unsigned char* lds = (LAS unsigned char*)lds_raw;
    cg::grid_group grid = cg::this_grid();
    const int tid = threadIdx.x, lane = tid & 63, wave = __builtin_amdgcn_readfirstlane(tid >> 6);
    const int G = gridDim.x, bx = blockIdx.x;
    const int gw = bx * NWAVES + wave, NGW = G * NWAVES;
    const int gt = bx * NTHR + tid, NGT = G * NTHR;
    unsigned char* ws = args.ws;
    const int lo = args.ph_lo, hi = args.ph_hi;
#ifndef GEMM_REP
#define GEMM_REP 1
#endif
#ifndef PH_MASK
#define PH_MASK 0xfff
#endif
#define IN(k) (((PH_MASK >> (k)) & 1) && lo <= (k) && (k) < hi)
#define SEAM(k) do { if (IN(k) && IN((k) + 1)) { if ((k) == 0) { asm volatile("s_waitcnt vmcnt(0) lgkmcnt(0)" ::: "memory"); grid.sync(); \
    if (tid == 0) { __builtin_amdgcn_fence(__ATOMIC_ACQUIRE, "agent"); asm volatile("s_waitcnt vmcnt(0)" ::: "memory"); } __syncthreads(); } else { xcd_barrier(xbar); } } } while (0)
    volatile LAS unsigned* xst = (volatile LAS unsigned*)(lds + LDS_BYTES - 64);
    if (tid < 2) xst[tid] = 0u;
    __syncthreads();
    XcdBarrier xbar = xcd_barrier_post((unsigned*)ws, xst);
    float* OUT = (float*)(GAS float*)args.out;
#define INP(k) ((const float*)(const GAS float*)args.in[k])
#define PHASE_PTRS() unsigned char* wsb0 = ws; asm volatile("" : "+s"(wsb0)); GAS unsigned char* wsb = (GAS unsigned char*)wsb0; \
    bf16* WinT = (bf16*)(wsb + WS_WIN); bf16* WgaT = (bf16*)(wsb + WS_WGA); bf16* WgbT = (bf16*)(wsb + WS_WGB); bf16* WuaT = (bf16*)(wsb + WS_WUA); bf16* WubT = (bf16*)(wsb + WS_WUB); \
    bf16* WoutT = (bf16*)(wsb + WS_WOUT); bf16* Wff1T = (bf16*)(wsb + WS_WFF1); bf16* Wff2T = (bf16*)(wsb + WS_WFF2); bf16* WpgT = (bf16*)(wsb + WS_WPG); bf16* WppT = (bf16*)(wsb + WS_WPP); \
    float* COS = (float*)(wsb + WS_COS); float* SIN = (float*)(wsb + WS_SIN); float* WI = (float*)(wsb + WS_WI); float* IG = (float*)(wsb + WS_IG); float* LF = (float*)(wsb + WS_LF); \
    bf16* KA = (bf16*)(wsb + WS_KA); bf16* KI = (bf16*)(wsb + WS_KI); bf16* VAT = (bf16*)(wsb + WS_VAT); \
    float* BCUM = (float*)(wsb + WS_BCUM); float* CS = (float*)(wsb + WS_CS); float* MST = (float*)(wsb + WS_MST); float* DN = (float*)(wsb + WS_DN); \
    bf16* XB = (bf16*)(wsb + WS_XB); bf16* PB = (bf16*)(wsb + WS_PB); bf16* QA = (bf16*)(wsb + WS_QA); bf16* QI = (bf16*)(wsb + WS_QI); bf16* MLQK = (bf16*)(wsb + WS_MLQK); \
    bf16* MLV = (bf16*)(wsb + WS_MLV); bf16* MLO = (bf16*)(wsb + WS_MLO); bf16* QC = (bf16*)(wsb + WS_QC); bf16* DC = (bf16*)(wsb + WS_DC); \
    bf16* TMP = (bf16*)(wsb + WS_TMP); bf16* MRG = (bf16*)(wsb + WS_MRG); bf16* H1 = (bf16*)(wsb + WS_H1); bf16* HF = (bf16*)(wsb + WS_HF); bf16* RB = (bf16*)(wsb + WS_RB); \
    float* PROJ = (float*)(wsb + WS_PROJ); bf16* YA = (bf16*)(wsb + WS_YA); (void)YA; bf16* CST = (bf16*)(wsb + WS_CST); float* NST = (float*)(wsb + WS_NST); (void)CST; (void)NST; \
    (void)WinT; (void)WgaT; (void)WgbT; (void)WuaT; (void)WubT; (void)WoutT; (void)Wff1T; (void)Wff2T; (void)WpgT; (void)WppT; (void)COS; (void)SIN; (void)WI; (void)IG; (void)LF; (void)KA; (void)KI; (void)VAT; \
    (void)BCUM; (void)CS; (void)MST; (void)DN; (void)XB; (void)PB; (void)QA; (void)QI; (void)MLQK; (void)MLV; (void)MLO; (void)QC; (void)DC; (void)TMP; (void)MRG; (void)H1; (void)HF; (void)RB; (void)PROJ
#define LAUNDER_I(v) asm volatile("" : "+s"(v))

    if (IN(0)) { PHASE_PTRS();
        LAS float* scr = (LAS float*)(lds + wave * 16384);
        const float* w_in = INP(I_WIN); const float* x = INP(I_X);
        constexpr int I_A = 16 * (NWIN / 32), I_G = 16 * 32, I_U = 8 * 32, I_O = 16 * 32, I_1 = 16 * 128, I_2 = 64 * 32, I_PG = 16 * 32, I_PP = 4 * 32;
        constexpr int NITEMS = I_A + 2 * I_G + 2 * I_U + I_O + I_1 + I_2 + I_PG + I_PP;
        for (int it = gw; it < NITEMS; it += NGW) {
            int r = it;
            if (r < I_A) { transpose_item(w_in, 1024, WIN_LD, WinT, NWIN, scr, r, lane, [](int n) { return win_src(n); }); continue; } r -= I_A;
            if (r < I_G) { transpose_item(w_in, 1024, WIN_LD, WgaT, 1024, scr, r, lane, [](int n) { return 3280 + n; }); continue; } r -= I_G;
            if (r < I_G) { transpose_item(w_in, 1024, WIN_LD, WgbT, 1024, scr, r, lane, [](int n) { return 4304 + n; }); continue; } r -= I_G;
            if (r < I_U) { transpose_item(INP(I_WUA), 512, 1024, WuaT, 1024, scr, r, lane, [](int n) { return n; }); continue; } r -= I_U;
            if (r < I_U) { transpose_item(INP(I_WUB), 512, 1024, WubT, 1024, scr, r, lane, [](int n) { return n; }); continue; } r -= I_U;
            if (r < I_O) { transpose_item(INP(I_WOUT), 1024, 1024, WoutT, 1024, scr, r, lane, [](int n) { return n; }); continue; } r -= I_O;
            if (r < I_1) { transpose_item(INP(I_WFF1), 1024, 4096, Wff1T, 4096, scr, r, lane, [](int n) { return n; }); continue; } r -= I_1;
            if (r < I_2) { transpose_item(INP(I_WFF2), 4096, 1024, Wff2T, 1024, scr, r, lane, [](int n) { return n; }); continue; } r -= I_2;
            if (r < I_PG) { transpose_item(INP(I_WPG), 1024, 1024, WpgT, 1024, scr, r, lane, [](int n) { return n; }); continue; } r -= I_PG;
            transpose_item(INP(I_WPP), 256, 1024, WppT, 1024, scr, r, lane, [](int n) { return n; });
        }
        { const f32x4* xs = (const f32x4*)x; u32x4* xd = (u32x4*)XB;
            for (int i = gt; i < M * D / 8; i += 4 * NGT) { f32x4 a[4], b[4];
#pragma unroll
                for (int k = 0; k < 4; ++k) { a[k] = xs[2 * (i + k * NGT)]; b[k] = xs[2 * (i + k * NGT) + 1]; }
#pragma unroll
                for (int k = 0; k < 4; ++k) { u32x4 o; o.x = pk2(a[k][0], a[k][1]); o.y = pk2(a[k][2], a[k][3]); o.z = pk2(b[k][0], b[k][1]); o.w = pk2(b[k][2], b[k][3]); xd[i + k * NGT] = o; } } }
        { const f32x4* ps = (const f32x4*)INP(I_P); u32x4* pd = (u32x4*)PB;
            for (int i = gt; i < M * PLE / 8; i += 4 * NGT) { f32x4 a[4], b[4];
#pragma unroll
                for (int k = 0; k < 4; ++k) { a[k] = ps[2 * (i + k * NGT)]; b[k] = ps[2 * (i + k * NGT) + 1]; }
#pragma unroll
                for (int k = 0; k < 4; ++k) { u32x4 o; o.x = pk2(a[k][0], a[k][1]); o.y = pk2(a[k][2], a[k][3]); o.z = pk2(b[k][0], b[k][1]); o.w = pk2(b[k][2], b[k][3]); pd[i + k * NGT] = o; } } }
        { const int* pos = (const int*)INP(I_POS);
            for (int i = gt; i < M * 32; i += NGT) { const int m = i >> 5, f = i & 31; const double a = (double)pos[m] * INVF[f] * 0.15915494309189535;
                const float rev = (float)(a - floor(a)); COS[i] = __builtin_amdgcn_cosf(rev); SIN[i] = __builtin_amdgcn_sinf(rev); } }
    }
    SEAM(0);
    if (IN(1)) { PHASE_PTRS();
        int Kv = D; LAUNDER_I(Kv); pg8::Gemm gm{XB, WinT, M, NWIN, Kv}; pg8::StaticOrder S; S.init(M, NWIN, G, bx);
        EpiWin E{QA, QI, KA, KI, VAT, MLQK, MLV, MLO, WI, IG, LF, COS, SIN, INP(I_BIG), INP(I_BFG)};
        pg8::gemm_phase<EpiWin, pg8::StaticOrder, true, true>(lds, gm, S, E);
    }
    SEAM(1);
    if (IN(2)) { PHASE_PTRS();
#ifdef NO_MIXA
        for (int i = gt; i < M * 512 / 8; i += NGT) ((u32x4*)YA)[i] = (u32x4){0u, 0u, 0u, 0u};
#else
        for (int pr = bx; pr < NB * 64; pr += G) { const int b = pr >> 6, j = pr & 63;
            mixa_unit(QI, KI, WI, QA, YA, KA, VAT, lds, b, 127 - j);
            mixa_unit(QI, KI, WI, QA, YA, KA, VAT, lds, b, j); }
#endif
#ifdef DUPMIXA
        for (int pr = bx; pr < NB * 64; pr += G) { const int b = pr >> 6, j = pr & 63;
            mixa_unit(QI, KI, WI, QA, YA, KA, VAT, lds, b, 127 - j);
            mixa_unit(QI, KI, WI, QA, YA, KA, VAT, lds, b, j); }
#endif
        for (int u = bx; u < 2048; u += G) m1_unit(MLQK, MLV, IG, LF, INP(I_CONVW), INP(I_CONVB), QC, DC, DN, BCUM, CS, lds, u);
    }
    SEAM(2);
    if (IN(3)) { PHASE_PTRS();
        for (int item = gt; item < 64 * 2048; item += NGT) { const int bh = item >> 11, rem = item & 2047;
            float st[8] = {0.f, 0.f, 0.f, 0.f, 0.f, 0.f, 0.f, 0.f}; float m = 0.f;
            const bf16* src = DC + (size_t)(bh * 32) * 16384 + rem * 8; bf16* dst = CST + (size_t)(bh * 32) * 16384 + rem * 8;
#pragma unroll 1
            for (int c0 = 0; c0 < 32; c0 += 8) { u32x4 dv[8]; float bl[8], mg[8];
#pragma unroll
                for (int k = 0; k < 8; ++k) { dv[k] = *(const u32x4*)(src + (size_t)(c0 + k) * 16384); bl[k] = CS[(bh * 32 + c0 + k) * 2]; mg[k] = CS[(bh * 32 + c0 + k) * 2 + 1]; }
#pragma unroll
                for (int k = 0; k < 8; ++k) { const float mn = fmaxf(bl[k] + m, mg[k]), a = __expf(bl[k] + m - mn), sg = __expf(mg[k] - mn); m = mn; const u32x4 d = dv[k];
                    u32x4 o; o.x = pk2(st[0], st[1]); o.y = pk2(st[2], st[3]); o.z = pk2(st[4], st[5]); o.w = pk2(st[6], st[7]); *(u32x4*)(dst + (size_t)(c0 + k) * 16384) = o;
                    st[0] = a * st[0] + sg * bflo(d.x); st[1] = a * st[1] + sg * bfhi(d.x); st[2] = a * st[2] + sg * bflo(d.y); st[3] = a * st[3] + sg * bfhi(d.y);
                    st[4] = a * st[4] + sg * bflo(d.z); st[5] = a * st[5] + sg * bfhi(d.z); st[6] = a * st[6] + sg * bflo(d.w); st[7] = a * st[7] + sg * bfhi(d.w); } } }
        for (int item = gt; item < 64 * 128; item += NGT) { const int bh = item >> 7, dd = item & 127; float st = 0.f, m = 0.f;
            for (int c = 0; c < 32; ++c) { const float bl = CS[(bh * 32 + c) * 2], mg = CS[(bh * 32 + c) * 2 + 1];
                if (dd == 0) MST[bh * 32 + c] = m;
                const float mn = fmaxf(bl + m, mg), a = __expf(bl + m - mn), s = __expf(mg - mn); m = mn;
                const float d = DN[(size_t)(bh * 32 + c) * 128 + dd]; NST[(size_t)(bh * 32 + c) * 128 + dd] = st; st = a * st + s * d; } }
    }
    SEAM(3);
    if (IN(4)) { PHASE_PTRS();
        for (int u = bx; u < 2048; u += G) m3_unit(QC, MLV, MLO, IG, BCUM, MST, CST, NST, INP(I_MLNG), lds, u);
    }
    SEAM(4);
    if (IN(5)) { PHASE_PTRS();
        pg8::StaticOrder S; S.init(M, D, G, bx);
        { int Kv = D; LAUNDER_I(Kv); pg8::Gemm gm{XB, WgaT, M, D, Kv}; EpiB<0> E{TMP, nullptr, nullptr, nullptr, D}; pg8::gemm_phase<EpiB<0>, pg8::StaticOrder, true, true>(lds, gm, S, E); }
        { int Kv = 512; LAUNDER_I(Kv); pg8::Gemm gm{YA, WuaT, M, D, Kv}; EpiB<1> E{nullptr, OUT, TMP, nullptr, D}; pg8::gemm_phase<EpiB<1>, pg8::StaticOrder, true, true>(lds, gm, S, E); }
        { int Kv = D; LAUNDER_I(Kv); pg8::Gemm gm{XB, WgbT, M, D, Kv}; EpiB<0> E{TMP, nullptr, nullptr, nullptr, D}; pg8::gemm_phase<EpiB<0>, pg8::StaticOrder, true, true>(lds, gm, S, E); }
        { int Kv = 512; LAUNDER_I(Kv); pg8::Gemm gm{MLV, WubT, M, D, Kv}; EpiB<2> E{MRG, nullptr, TMP, OUT, D}; pg8::gemm_phase<EpiB<2>, pg8::StaticOrder, true, true>(lds, gm, S, E); }
    }
    SEAM(5);
    if (IN(6)) { PHASE_PTRS();
        pg8::StaticOrder S; S.init(M, D, G, bx);
        int Kv = D; LAUNDER_I(Kv); pg8::Gemm gm{MRG, WoutT, M, D, Kv}; EpiF<0> E{OUT, nullptr, INP(I_X), nullptr, D}; pg8::gemm_phase<EpiF<0>, pg8::StaticOrder, true, true>(lds, gm, S, E);
    }
    SEAM(6);
    if (IN(7)) { PHASE_PTRS(); for (int m = gw; m < M / 2; m += NGW) ln_row2<true>(OUT + (size_t)m * D, OUT + (size_t)(m + M / 2) * D, INP(I_LN1G), INP(I_LN1B), nullptr, nullptr, H1 + (size_t)m * D, H1 + (size_t)(m + M / 2) * D, lane); }
    SEAM(7);
    if (IN(8)) { PHASE_PTRS();
        pg8::StaticOrder S; S.init(M, FF, G, bx);
        int Kv = D; LAUNDER_I(Kv); pg8::Gemm gm{H1, Wff1T, M, FF, Kv}; EpiB<3> E{HF, nullptr, nullptr, nullptr, FF}; pg8::gemm_phase<EpiB<3>, pg8::StaticOrder, true, true>(lds, gm, S, E);
    }
#ifdef DUP89
    SEAM(8);
    if (IN(8) && true) { PHASE_PTRS();
        pg8::StaticOrder S; S.init(M, FF, G, bx);
        int Kv = D; LAUNDER_I(Kv); pg8::Gemm gm{H1, Wff1T, M, FF, Kv}; EpiB<3> E{HF, nullptr, nullptr, nullptr, FF}; pg8::gemm_phase<EpiB<3>, pg8::StaticOrder, true, true>(lds, gm, S, E);
    }
#endif
    SEAM(8);
    if (IN(9)) { PHASE_PTRS();
        pg8::StaticOrder S; S.init(M, D, G, bx);
        int Kv = FF; LAUNDER_I(Kv); pg8::Gemm gm{HF, Wff2T, M, D, Kv}; EpiF<1> E{OUT, RB, nullptr, H1, D}; pg8::gemm_phase<EpiF<1>, pg8::StaticOrder, true, true>(lds, gm, S, E);
    }
#ifdef DUP89
    SEAM(9);
    if (IN(9) && true) { PHASE_PTRS();
        pg8::StaticOrder S; S.init(M, D, G, bx);
        int Kv = FF; LAUNDER_I(Kv); pg8::Gemm gm{HF, Wff2T, M, D, Kv}; EpiF<1> E{OUT, RB, nullptr, H1, D}; pg8::gemm_phase<EpiF<1>, pg8::StaticOrder, true, true>(lds, gm, S, E);
    }
#endif
    SEAM(9);
    if (IN(10)) { PHASE_PTRS();
        pg8::StaticOrder S; S.init(M, D, G, bx);
#if !defined(P10_ONLY) || P10_ONLY == 1
        { int Kv = PLE; LAUNDER_I(Kv); pg8::Gemm gm{PB, WppT, M, D, Kv}; EpiF<2> E{PROJ, nullptr, nullptr, nullptr, D}; pg8::gemm_phase<EpiF<2>, pg8::StaticOrder, true, true>(lds, gm, S, E); }
#endif
#if !defined(P10_ONLY) || P10_ONLY == 2
        { int Kv = D; LAUNDER_I(Kv); pg8::Gemm gm{RB, WpgT, M, D, Kv}; EpiF<3> E{OUT, nullptr, PROJ, nullptr, D}; pg8::gemm_phase<EpiF<3>, pg8::StaticOrder, true, true>(lds, gm, S, E); }
#endif
    }
    SEAM(10);
    if (IN(11)) { PHASE_PTRS(); for (int m = gw; m < M / 2; m += NGW) ln_row2<false>(OUT + (size_t)m * D, OUT + (size_t)(m + M / 2) * D, INP(I_LN2G), INP(I_LN2B), OUT + (size_t)m * D, OUT + (size_t)(m + M / 2) * D, nullptr, nullptr, lane); }
#undef IN
#undef SEAM
}

extern "C" void kernel_launch(void* const* d_in, const int* in_sizes, int n_in, void* d_out, int out_size, void* d_ws, size_t ws_size, hipStream_t stream) {
    static int grid = 0;
    if (grid == 0) {
        if (n_in != 20 || out_size != M * D || ws_size < WS_END) { fprintf(stderr, "kernel_launch: unexpected problem shape (n_in %d, out %d, ws %zu)\n", n_in, out_size, ws_size); grid = -1; return; }
        int dev = 0, cus = 0, per_cu = 0;
        hipGetDevice(&dev); hipDeviceGetAttribute(&cus, hipDeviceAttributeMultiprocessorCount, dev);
        if (hipFuncSetAttribute((const void*)fwd_kernel, hipFuncAttributeMaxDynamicSharedMemorySize, LDS_BYTES) != hipSuccess) { fprintf(stderr, "kernel_launch: hipFuncSetAttribute failed\n"); grid = -1; return; }
        if (hipOccupancyMaxActiveBlocksPerMultiprocessor(&per_cu, (const void*)fwd_kernel, NTHR, LDS_BYTES) != hipSuccess || per_cu < 1) { fprintf(stderr, "kernel_launch: occupancy query says %d\n", per_cu); per_cu = 1; }
        (void)hipGetLastError();
        grid = cus * (per_cu > 1 ? 1 : per_cu);
        if (grid <= 0) { grid = -1; return; }
    }
    if (grid < 0) return;
    if (hipMemsetAsync(d_ws, 0, 16384, stream) != hipSuccess) { fprintf(stderr, "kernel_launch: memset failed\n"); return; }
    Args a{};
    for (int i = 0; i < 20; ++i) a.in[i] = (const float*)d_in[i];
    a.out = (float*)d_out; a.ws = (unsigned char*)d_ws;
#if MK_ONE
    a.ph_lo = 0; a.ph_hi = NPHASE;
    void* params[] = {&a};
    hipError_t e = hipLaunchCooperativeKernel((const void*)fwd_kernel, dim3(grid), dim3(NTHR), params, LDS_BYTES, stream);
    if (e != hipSuccess) fprintf(stderr, "cooperative launch failed: %s (grid %d)\n", hipGetErrorString(e), grid);
#else
    for (int ph = 0; ph < NPHASE; ++ph) { a.ph_lo = ph; a.ph_hi = ph + 1; hipLaunchKernelGGL(fwd_kernel, dim3(grid), dim3(NTHR), LDS_BYTES, stream, a); }
#endif
}
```

```cpp
#include <hip/hip_runtime.h>
#include <hip/hip_cooperative_groups.h>
#include <cstdio>
#include <cstdint>
namespace cg = cooperative_groups;
#define MK_ONE 1
namespace pg8 {
#define PG8_LAS __attribute__((address_space(3)))
typedef unsigned short bf16_t;
typedef short bf16x8 __attribute__((ext_vector_type(8)));
typedef float f32x4 __attribute__((ext_vector_type(4)));
typedef unsigned u32x4 __attribute__((ext_vector_type(4)));
constexpr int BM = 256, BK = 64, HALF = 128, HTB = HALF * BK * 2  , STAGE_BYTES = 8 * HTB, NXCD = 8, WGM = 8;

__host__ __device__ __forceinline__ int lds_byte(int r, int c) { const int st = (r >> 4) * 2 + (c >> 5), rr = r & 15, cc = c & 31, ob = rr * 64 + cc * 2; return st * 1024 + (ob ^ (((ob >> 9) & 1) << 5)); }
__host__ __device__ __forceinline__ void stage_rc(int b, int& R, int& C) { const int st = b / 1024, sb = b % 1024, swz = sb ^ (((sb >> 9) & 1) << 5); R = (st >> 1) * 16 + swz / 64; C = (st & 1) * 32 + (swz % 64) / 2; }
__host__ __device__ __forceinline__ int perm32(int rho) { const int n = rho >> 4, i = rho & 15; return 8 * (i >> 2) + 4 * n + (i & 3); }

struct Unit { int pm, pn; };
struct Gemm { const bf16_t* A; const bf16_t* Bt; int M, N, K; };

struct StaticOrder {
    int nM, nN, nwg, G, c;
    __host__ __device__ void init(int M, int N, int G_, int c_) { nM = M / BM; nN = N / BM; nwg = nM * nN; G = G_; c = c_; }
    __host__ __device__ bool next(int i, Unit& u) const {
        const long L = (long)i * G + c; if (L >= nwg) return false;
        int wgid = (int)L; { const int q = nwg / NXCD, r = nwg % NXCD, xcd = wgid % NXCD, off = wgid / NXCD; wgid = (xcd < r ? xcd * (q + 1) : r * (q + 1) + (xcd - r) * q) + off; }
        const int nig = WGM * nN, gid = wgid / nig, fm = gid * WGM, gsz = (nM - fm) < WGM ? (nM - fm) : WGM;
        u.pm = fm + ((wgid % nig) % gsz); u.pn = (wgid % nig) / gsz; return true;
    }
    __device__ __forceinline__ void a_ready(const Unit&) const {}
    __device__ __forceinline__ void done(const Unit&) const {}
};

__device__ __forceinline__ unsigned cvt_pk_bf16(float lo, float hi) { unsigned r; asm volatile("v_cvt_pk_bf16_f32 %0, %1, %2" : "=v"(r) : "v"(lo), "v"(hi)); return r; }
template <class Epi, class Sched, bool ALIGN_EPI = false, bool SP2 = false>
__device__ __forceinline__ void gemm_phase(PG8_LAS unsigned char* lds, const Gemm g, const Sched& S, const Epi& E) {
    const int tid = threadIdx.x, wid = __builtin_amdgcn_readfirstlane(tid >> 6), lane = tid & 63, wr = wid >> 2, wc = wid & 3, fr = lane & 15, fq = lane >> 4;
    const int K = g.K, nt = K / BK;
    unsigned voffA[2], voffB[2];
#pragma unroll
    for (int i = 0; i < 2; ++i) { int R, C; stage_rc(tid * 16 + i * 8192, R, C); const int Rb = Epi::PERM ? ((R & ~31) + perm32(R & 31)) : R;
        voffA[i] = (unsigned)(R * K + C) * 2u; voffB[i] = (unsigned)(Rb * K + C) * 2u; }
    const size_t kstep = (size_t)(BK * 2);
    const size_t hstep = (size_t)HALF * K * 2;
    const size_t tstep = 2 * hstep;
    const unsigned ldsw = (unsigned)wid * 1024u;
    const int aoff = lds_byte(wr * 64 + fr, fq * 8), boff = lds_byte(wc * 32 + fr, fq * 8);
#define PG8_SA(b, h) (((b) * 2 + (h)) * HTB)
#define PG8_SB(b, h) ((4 + (b) * 2 + (h)) * HTB)
#define PG8_STAGE(bufoff, gbase, voff) do { _Pragma("unroll") for (int _i = 0; _i < 2; ++_i) \
        __builtin_amdgcn_global_load_lds((const unsigned*)((const char*)(gbase) + (voff)[_i]), (PG8_LAS unsigned*)(lds + (bufoff) + ldsw + _i * 8192), 16, 0, 0); } while (0)
#define PG8_LDA(dst, b, h) do { _Pragma("unroll") for (int m = 0; m < 4; ++m) _Pragma("unroll") for (int k = 0; k < 2; ++k) dst[m][k] = *(const PG8_LAS bf16x8*)(lds + PG8_SA(b, h) + aoff + m * 2048 + k * 1024); } while (0)
#define PG8_LDB(dst, b, h) do { _Pragma("unroll") for (int n = 0; n < 2; ++n) _Pragma("unroll") for (int k = 0; k < 2; ++k) dst[n][k] = *(const PG8_LAS bf16x8*)(lds + PG8_SB(b, h) + boff + n * 2048 + k * 1024); } while (0)
#define PG8_MMA(ai, bj, At, Bt) do { __builtin_amdgcn_s_setprio(1); _Pragma("unroll") for (int m = 0; m < 4; ++m) _Pragma("unroll") for (int n = 0; n < 2; ++n) _Pragma("unroll") for (int k = 0; k < 2; ++k) \
        acc[ai][bj][m][n] = __builtin_amdgcn_mfma_f32_16x16x32_bf16(Bt[n][k], At[m][k], acc[ai][bj][m][n], 0, 0, 0); __builtin_amdgcn_s_setprio(0); } while (0)
#define PG8_WAIT_V(n) asm volatile("s_waitcnt vmcnt(" #n ")" ::: "memory")
#define PG8_WAIT_L(n) asm volatile("s_waitcnt lgkmcnt(" #n ")" ::: "memory")
#define PG8_BAR __builtin_amdgcn_s_barrier()
#define PG8_SCHED __builtin_amdgcn_sched_barrier(0)
    Unit cur, nxt; int ui = 0;
    if (!S.next(0, cur)) return;
    f32x4 acc[2][2][4][2];
#pragma unroll
    for (int a = 0; a < 2; ++a)
#pragma unroll
        for (int b = 0; b < 2; ++b)
#pragma unroll
            for (int m = 0; m < 4; ++m)
#pragma unroll
                for (int n = 0; n < 2; ++n) acc[a][b][m][n] = (f32x4){0.f, 0.f, 0.f, 0.f};
    bf16x8 At[4][2], B0[2][2], B1[2][2];
    const char* cA = (const char*)g.A + (size_t)cur.pm * tstep; const char* cB = (const char*)g.Bt + (size_t)cur.pn * tstep;
    S.a_ready(cur);
    if constexpr (SP2) {
        PG8_STAGE(PG8_SB(0, 0), cB, voffB); PG8_STAGE(PG8_SB(0, 1), cB + hstep, voffB); PG8_STAGE(PG8_SA(0, 0), cA, voffA); PG8_STAGE(PG8_SA(0, 1), cA + hstep, voffA);
        if (wr == 1) PG8_BAR;
        PG8_WAIT_V(2); PG8_BAR;
        PG8_STAGE(PG8_SB(1, 0), cB + kstep, voffB); PG8_STAGE(PG8_SA(1, 0), cA + kstep, voffA); PG8_STAGE(PG8_SB(1, 1), cB + hstep + kstep, voffB);
        PG8_WAIT_V(6); PG8_BAR;
    } else {
        PG8_STAGE(PG8_SB(0, 0), cB, voffB); PG8_STAGE(PG8_SA(0, 0), cA, voffA); PG8_STAGE(PG8_SB(0, 1), cB + hstep, voffB); PG8_STAGE(PG8_SA(0, 1), cA + hstep, voffA);
        if (wr == 1) PG8_BAR;
        PG8_WAIT_V(4); PG8_BAR;
        PG8_STAGE(PG8_SB(1, 0), cB + kstep, voffB); PG8_STAGE(PG8_SA(1, 0), cA + kstep, voffA); PG8_STAGE(PG8_SB(1, 1), cB + hstep + kstep, voffB);
        PG8_WAIT_V(6); PG8_BAR;
    }
    for (;;) {
        const bool has_next = S.next(ui + 1, nxt);
        const char* nA = has_next ? (const char*)g.A + (size_t)nxt.pm * tstep : cA; const char* nB = has_next ? (const char*)g.Bt + (size_t)nxt.pn * tstep : cB;
        for (int t = 0; t < nt; t += 2) {
            const bool last = (t == nt - 2);
            const char* a1 = cA + (size_t)(t + 1) * kstep;
            const char* a2 = last ? nA : cA + (size_t)(t + 2) * kstep; const char* b2 = last ? nB : cB + (size_t)(t + 2) * kstep;
            const char* a3 = a2 + kstep; const char* b3 = b2 + kstep;
            if (last && has_next) S.a_ready(nxt);
            if constexpr (SP2) {
            PG8_LDB(B0, 0, 0); PG8_LDB(B1, 0, 1); PG8_SCHED; PG8_LDA(At, 0, 0); PG8_STAGE(PG8_SA(1, 1), a1 + hstep, voffA);
            PG8_WAIT_V(8); PG8_WAIT_L(0); PG8_BAR; PG8_MMA(0, 0, At, B0); PG8_MMA(0, 1, At, B1); PG8_BAR; PG8_SCHED;
            PG8_LDA(At, 0, 1); PG8_STAGE(PG8_SB(0, 0), b2, voffB); PG8_STAGE(PG8_SB(0, 1), b2 + hstep, voffB); PG8_STAGE(PG8_SA(0, 0), a2, voffA);
            PG8_WAIT_V(8); PG8_WAIT_L(0); PG8_BAR; PG8_MMA(1, 0, At, B0); PG8_MMA(1, 1, At, B1); PG8_BAR; PG8_SCHED;
            PG8_LDB(B0, 1, 0); PG8_LDB(B1, 1, 1); PG8_SCHED; PG8_LDA(At, 1, 0); PG8_STAGE(PG8_SA(0, 1), a2 + hstep, voffA);
            PG8_WAIT_V(8); PG8_WAIT_L(0); PG8_BAR; PG8_MMA(0, 0, At, B0); PG8_MMA(0, 1, At, B1); PG8_BAR; PG8_SCHED;
            PG8_LDA(At, 1, 1); PG8_STAGE(PG8_SB(1, 0), b3, voffB); PG8_STAGE(PG8_SB(1, 1), b3 + hstep, voffB); PG8_STAGE(PG8_SA(1, 0), a3, voffA);
            PG8_WAIT_V(8); PG8_WAIT_L(0); PG8_BAR; PG8_MMA(1, 0, At, B0); PG8_MMA(1, 1, At, B1); PG8_BAR; PG8_SCHED;
            } else {
            PG8_LDB(B0, 0, 0); PG8_SCHED; PG8_LDA(At, 0, 0); PG8_STAGE(PG8_SA(1, 1), a1 + hstep, voffA);
            PG8_WAIT_L(8); PG8_BAR; PG8_WAIT_L(0); PG8_MMA(0, 0, At, B0); PG8_BAR; PG8_SCHED;
            PG8_LDB(B1, 0, 1); PG8_STAGE(PG8_SB(0, 0), b2, voffB);
            PG8_BAR; PG8_WAIT_L(0); PG8_MMA(0, 1, At, B1); PG8_BAR;
            PG8_LDA(At, 0, 1); PG8_STAGE(PG8_SA(0, 0), a2, voffA);
            PG8_BAR; PG8_WAIT_L(0); PG8_MMA(1, 0, At, B0); PG8_BAR; PG8_SCHED;
            PG8_STAGE(PG8_SB(0, 1), b2 + hstep, voffB);
            PG8_WAIT_V(6); PG8_BAR; PG8_MMA(1, 1, At, B1); PG8_BAR;
            PG8_LDB(B0, 1, 0); PG8_SCHED; PG8_LDA(At, 1, 0); PG8_STAGE(PG8_SA(0, 1), a2 + hstep, voffA);
            PG8_WAIT_L(8); PG8_BAR; PG8_WAIT_L(0); PG8_MMA(0, 0, At, B0); PG8_BAR; PG8_SCHED;
            PG8_LDB(B1, 1, 1); PG8_STAGE(PG8_SB(1, 0), b3, voffB);
            PG8_BAR; PG8_WAIT_L(0); PG8_MMA(0, 1, At, B1); PG8_BAR;
            PG8_LDA(At, 1, 1); PG8_STAGE(PG8_SA(1, 0), a3, voffA);
            PG8_BAR; PG8_WAIT_L(0); PG8_MMA(1, 0, At, B0); PG8_BAR; PG8_SCHED;
            PG8_STAGE(PG8_SB(1, 1), b3 + hstep, voffB);
            PG8_WAIT_V(6); PG8_BAR; PG8_MMA(1, 1, At, B1); PG8_BAR;
            }
        }
        if constexpr (ALIGN_EPI) { if (wr == 0) PG8_BAR; }
        if constexpr (!Epi::AFTER_DRAIN) { E(acc, cur, wr, wc, fr, fq); S.done(cur); }
        if (!has_next) break;
#pragma unroll
        for (int a = 0; a < 2; ++a)
#pragma unroll
            for (int b = 0; b < 2; ++b)
#pragma unroll
                for (int m = 0; m < 4; ++m)
#pragma unroll
                    for (int n = 0; n < 2; ++n) acc[a][b][m][n] = (f32x4){0.f, 0.f, 0.f, 0.f};
        cur = nxt; cA = nA; cB = nB; ++ui;
        if constexpr (ALIGN_EPI) { if (wr == 1) PG8_BAR; }
    }
    PG8_WAIT_V(0);
    if constexpr (!ALIGN_EPI) { if (wr == 0) PG8_BAR; }
    PG8_BAR;
    if constexpr (Epi::AFTER_DRAIN) { E.fused(acc, cur, wr, wc, fr, fq, lds, wid, lane); S.done(cur); }
#undef PG8_SA
#undef PG8_SB
#undef PG8_STAGE
#undef PG8_LDA
#undef PG8_LDB
#undef PG8_MMA
#undef PG8_WAIT_V
#undef PG8_WAIT_L
#undef PG8_BAR
#undef PG8_SCHED
}
}

#ifndef MK_ONE
#define MK_ONE 1
#endif
#define GAS __attribute__((address_space(1)))
#define LAS __attribute__((address_space(3)))
typedef unsigned short bf16;
typedef short bf16x8 __attribute__((ext_vector_type(8)));
typedef float f32x4 __attribute__((ext_vector_type(4)));
typedef unsigned u32x4 __attribute__((ext_vector_type(4)));
typedef unsigned u32x2 __attribute__((ext_vector_type(2)));

constexpr int NWAVES = 8, NTHR = 512;
constexpr int M = 32768, SEQ = 2048, NB = 16, D = 1024, FF = 4096, PLE = 256;
constexpr int NWIN = 3328, WIN_LD = 5328;
constexpr float LN_EPS = 1e-5f;
constexpr float ALPHA = 1.189207115002721f;
constexpr float IDX_W_SCALE = 0.04419417382415922f;
constexpr float QA_SCALE = 0.125f * 1.4426950408889634f;
constexpr float MLK_SCALE = 0.08838834764831845f;
constexpr int LDS_BYTES = 147456;
constexpr int NPHASE = 12;

constexpr size_t MiB = 1u << 20;
constexpr size_t WS_WIN = 1 * MiB, WS_WGA = 8 * MiB, WS_WGB = 10 * MiB, WS_WUA = 12 * MiB, WS_WUB = 13 * MiB, WS_WOUT = 14 * MiB,
                 WS_WFF1 = 16 * MiB, WS_WFF2 = 24 * MiB, WS_WPG = 32 * MiB, WS_WPP = 34 * MiB;
constexpr size_t WS_COS = 35 * MiB, WS_SIN = 39 * MiB, WS_WI = 43 * MiB, WS_IG = 44 * MiB, WS_LF = 44 * MiB + 512 * 1024;
constexpr size_t WS_KA = 45 * MiB, WS_KI = 49 * MiB, WS_VAT = 53 * MiB;
constexpr size_t WS_BCUM = 57 * MiB, WS_CS = 58 * MiB, WS_MST = 59 * MiB, WS_DN = 60 * MiB, WS_NST = 61 * MiB, WS_CST = 208 * MiB;
constexpr size_t WS_XB = 64 * MiB, WS_PB = 128 * MiB, WS_QA = 144 * MiB, WS_QI = 176 * MiB, WS_MLQK = 208 * MiB, WS_MLV = 272 * MiB,
                 WS_MLO = 304 * MiB, WS_QC = 336 * MiB, WS_DC = 400 * MiB, WS_YA = 464 * MiB, WS_END = 496 * MiB;
constexpr size_t WS_TMP = 336 * MiB, WS_MRG = 400 * MiB, WS_H1 = 64 * MiB, WS_HF = 144 * MiB, WS_RB = 400 * MiB, WS_PROJ = 144 * MiB;

__device__ __forceinline__ unsigned f2bf(float f) { unsigned u = __builtin_bit_cast(unsigned, f); return (u + 0x7fffu + ((u >> 16) & 1u)) >> 16; }
typedef float f32x2_t __attribute__((ext_vector_type(2)));
typedef __bf16 bf16x2_t __attribute__((ext_vector_type(2)));
__device__ __forceinline__ unsigned pk2(float lo, float hi) { f32x2_t v = {lo, hi}; bf16x2_t b = __builtin_convertvector(v, bf16x2_t); return __builtin_bit_cast(unsigned, b); }
__device__ __forceinline__ float bflo(unsigned w) { return __builtin_bit_cast(float, w << 16); }
__device__ __forceinline__ float bfhi(unsigned w) { return __builtin_bit_cast(float, w & 0xffff0000u); }
__device__ __forceinline__ float sigmoidf_(float x) { return __builtin_amdgcn_rcpf(1.0f + __expf(-x)); }
#define LDS_WAIT() asm volatile("s_waitcnt lgkmcnt(0)" ::: "memory")

__constant__ double INVF[32] = {1.0, 0.7498942093324559, 0.5623413251903491, 0.4216965034285822, 0.31622776601683794, 0.23713737056616552, 0.1778279410038923, 0.1333521432163324,
    0.1, 0.07498942093324558, 0.05623413251903491, 0.042169650342858224, 0.03162277660168379, 0.023713737056616554, 0.01778279410038923, 0.01333521432163324,
    0.01, 0.007498942093324558, 0.005623413251903491, 0.004216965034285823, 0.0031622776601683794, 0.0023713737056616554, 0.0017782794100389228, 0.001333521432163324,
    0.001, 0.0007498942093324559, 0.0005623413251903491, 0.00042169650342858224, 0.00031622776601683794, 0.00023713737056616554, 0.00017782794100389227, 0.0001333521432163324};

struct Args {
    const float* in[20]; float* out; unsigned char* ws; int ph_lo, ph_hi;
};
enum { I_X = 0, I_P, I_POS, I_WIN, I_CONVW, I_CONVB, I_BIG, I_BFG, I_MLNG, I_WUA, I_WUB, I_WOUT, I_LN1G, I_LN1B, I_WFF1, I_WFF2, I_WPG, I_WPP, I_LN2G, I_LN2B };

__device__ __forceinline__ int win_src(int n) {
    if (n < 512) { const int hh = n >> 6, j = n & 63; return hh * 64 + (j >> 1) + 32 * (j & 1); }
    if (n < 1024) { const int mm = n - 512, hh = mm >> 6, j = mm & 63; return 640 + hh * 64 + (j >> 1) + 32 * (j & 1); }
    if (n < 1280) { const int mm = n - 1024;
        if (mm < 64) return 512 + (mm >> 1) + 32 * (mm & 1);
        if (mm < 128) { const int j = mm - 64; return 1152 + (j >> 1) + 32 * (j & 1); }
        if (mm < 192) return 576 + (mm - 128);
        if (mm < 200) return 1216 + (mm - 192);
        if (mm < 204) return 2760 + (mm - 200);
        if (mm < 208) return 2764 + (mm - 204);
        return -1; }
    if (n < 2304) return 1224 + (n - 1280);
    if (n < 2816) return 2248 + (n - 2304);
    return 2768 + (n - 2816);
}

template <class SrcF>
__device__ __forceinline__ void transpose_item(const float* W, int K, int ldw, bf16* WT, int Nrows, LAS float* scr, int item, int lane, SrcF src) {
    const int nblk = Nrows / 32, kb = item / nblk, nb = item % nblk, k0 = 64 * kb, n0 = 32 * nb;
    const int sc = src(n0 + (lane & 31));
#pragma unroll 8
    for (int i = 0; i < 32; ++i) { const int kk = 2 * i + (lane >> 5); scr[kk * 33 + (lane & 31)] = sc >= 0 ? W[(size_t)(k0 + kk) * ldw + sc] : 0.f; }
    LDS_WAIT(); asm volatile("" ::: "memory");
    const int c = lane & 7;
#pragma unroll
    for (int j = 0; j < 4; ++j) { const int n = (lane >> 3) + 8 * j; const LAS float* s = scr + (8 * c) * 33 + n;
        u32x4 o; o.x = pk2(s[0 * 33], s[1 * 33]); o.y = pk2(s[2 * 33], s[3 * 33]); o.z = pk2(s[4 * 33], s[5 * 33]); o.w = pk2(s[6 * 33], s[7 * 33]);
        *(u32x4*)(WT + (size_t)(n0 + n) * K + k0 + 8 * c) = o; }
    LDS_WAIT(); asm volatile("" ::: "memory");
}

struct EpiWin {
    static constexpr bool PERM = true, AFTER_DRAIN = false;
    bf16 *QA, *QI, *KA, *KI, *VAT, *MLQK, *MLV, *MLO; float *WI, *IG, *LF; const float *COS, *SIN, *b_ig, *b_fg;
    __device__ __forceinline__ void operator()(const f32x4 (&acc)[2][2][4][2], const pg8::Unit& u, int wr, int wc, int fr, int fq) const {
        const int pn = u.pn, row0 = u.pm * 256 + wr * 64 + fr;
#pragma unroll
        for (int ai = 0; ai < 2; ++ai)
#pragma unroll
            for (int m = 0; m < 4; ++m) { const int r = row0 + ai * 128 + m * 16;
#pragma unroll
                for (int bj = 0; bj < 2; ++bj) { const int cl = bj * 128 + wc * 32 + 8 * fq; f32x4 v0 = acc[ai][bj][m][0], v1 = acc[ai][bj][m][1];
                    const bool rope = (pn < 4) || (pn == 4 && cl < 128);
                    if (rope) {
                        const int i0 = (cl & 63) >> 1;
                        const f32x4 c = *(const f32x4*)(COS + (unsigned)r * 32 + i0), s = *(const f32x4*)(SIN + (unsigned)r * 32 + i0);
                        const float sc = (pn < 2) ? QA_SCALE : 1.0f;
                        f32x4 o0, o1;
                        o0[0] = (v0[0] * c[0] - v0[1] * s[0]) * sc; o0[1] = (v0[1] * c[0] + v0[0] * s[0]) * sc;
                        o0[2] = (v0[2] * c[1] - v0[3] * s[1]) * sc; o0[3] = (v0[3] * c[1] + v0[2] * s[1]) * sc;
                        o1[0] = (v1[0] * c[2] - v1[1] * s[2]) * sc; o1[1] = (v1[1] * c[2] + v1[0] * s[2]) * sc;
                        o1[2] = (v1[2] * c[3] - v1[3] * s[3]) * sc; o1[3] = (v1[3] * c[3] + v1[2] * s[3]) * sc;
                        bf16* dst;
                        if (pn < 2) dst = QA + (unsigned)r * 512 + pn * 256 + cl;
                        else if (pn < 4) dst = QI + (unsigned)r * 512 + (pn - 2) * 256 + cl;
                        else dst = (cl < 64) ? (KA + (unsigned)r * 64 + cl) : (KI + (unsigned)r * 64 + (cl - 64));
                        u32x4 w; w.x = pk2(o0[0], o0[1]); w.y = pk2(o0[2], o0[3]); w.z = pk2(o1[0], o1[1]); w.w = pk2(o1[2], o1[3]);
                        *(u32x4*)dst = w;
                    } else if (pn == 4) {
                        if (cl < 192) { const int d0 = cl - 128, b = r >> 11, t = r & 2047; bf16* base = VAT + ((unsigned)(b * 64 + d0)) * 2048 + t;
#pragma unroll
                            for (int j = 0; j < 4; ++j) { base[(unsigned)j * 2048] = (bf16)f2bf(v0[j]); base[(unsigned)(j + 4) * 2048] = (bf16)f2bf(v1[j]); } }
                        else if (cl == 192) { *(f32x4*)(WI + (unsigned)r * 8) = v0 * IDX_W_SCALE; *(f32x4*)(WI + (unsigned)r * 8 + 4) = v1 * IDX_W_SCALE; }
                        else if (cl == 200) { f32x4 ig, lf;
#pragma unroll
                            for (int j = 0; j < 4; ++j) { ig[j] = v0[j] + b_ig[j]; const float f = v1[j] + b_fg[j]; lf[j] = fminf(f, 0.f) - log1pf(__expf(-fabsf(f))); }
                            *(f32x4*)(IG + (unsigned)r * 4) = ig; *(f32x4*)(LF + (unsigned)r * 4) = lf; }
                    } else {
                        bf16* dst;
                        if (pn < 9) dst = MLQK + (unsigned)r * 1024 + (pn - 5) * 256 + cl;
                        else if (pn < 11) dst = MLV + (unsigned)r * 512 + (pn - 9) * 256 + cl;
                        else { dst = MLO + (unsigned)r * 512 + (pn - 11) * 256 + cl;
#pragma unroll
                            for (int j = 0; j < 4; ++j) { v0[j] = sigmoidf_(v0[j]); v1[j] = sigmoidf_(v1[j]); } }
                        u32x4 w; w.x = pk2(v0[0], v0[1]); w.y = pk2(v0[2], v0[3]); w.z = pk2(v1[0], v1[1]); w.w = pk2(v1[2], v1[3]);
                        *(u32x4*)dst = w;
                    }
                }
                asm volatile("" ::: "memory"); }
    }
};

template <int MODE> struct EpiB {
    static constexpr bool PERM = true, AFTER_DRAIN = false;
    bf16* O; float* OF; const bf16* IB; const float* IF; int ldc;
    __device__ __forceinline__ void operator()(const f32x4 (&acc)[2][2][4][2], const pg8::Unit& u, int wr, int wc, int fr, int fq) const {
        const int row0 = u.pm * 256 + wr * 64 + fr, col0 = u.pn * 256 + wc * 32 + 8 * fq;
#pragma unroll
        for (int ai = 0; ai < 2; ++ai)
#pragma unroll
            for (int m = 0; m < 4; ++m) { const unsigned ro = (unsigned)(row0 + ai * 128 + m * 16) * ldc + col0;
#pragma unroll
                for (int bj = 0; bj < 2; ++bj) { const unsigned off = ro + bj * 128; f32x4 v0 = acc[ai][bj][m][0], v1 = acc[ai][bj][m][1];
                    if (MODE == 0) {
#pragma unroll
                        for (int j = 0; j < 4; ++j) { v0[j] = sigmoidf_(v0[j]); v1[j] = sigmoidf_(v1[j]); }
                    } else if (MODE == 3) {
#pragma unroll
                        for (int j = 0; j < 4; ++j) { const float a = fmaxf(v0[j], 0.f), b = fmaxf(v1[j], 0.f); v0[j] = a * a; v1[j] = b * b; }
                    } else {
                        const u32x4 t = *(const u32x4*)(IB + off);
                        v0[0] *= bflo(t.x); v0[1] *= bfhi(t.x); v0[2] *= bflo(t.y); v0[3] *= bfhi(t.y);
                        v1[0] *= bflo(t.z); v1[1] *= bfhi(t.z); v1[2] *= bflo(t.w); v1[3] *= bfhi(t.w);
                        if (MODE == 2) { v0 += *(const f32x4*)(IF + off); v1 += *(const f32x4*)(IF + off + 4); }
                    }
                    if (MODE == 1) { *(f32x4*)(OF + off) = v0; *(f32x4*)(OF + off + 4) = v1; }
                    else { u32x4 w; w.x = pk2(v0[0], v0[1]); w.y = pk2(v0[2], v0[3]); w.z = pk2(v1[0], v1[1]); w.w = pk2(v1[2], v1[3]); *(u32x4*)(O + off) = w; }
                }
                if (MODE == 1 || MODE == 2) asm volatile("" ::: "memory"); }
    }
};
template <int MODE> struct EpiF {
    static constexpr bool PERM = false, AFTER_DRAIN = false;
    float* OF; bf16* O; const float* IF; const bf16* IB; int ldc;
    __device__ __forceinline__ void operator()(const f32x4 (&acc)[2][2][4][2], const pg8::Unit& u, int wr, int wc, int fr, int fq) const {
        const int row0 = u.pm * 256 + wr * 64 + fr, col0 = u.pn * 256 + wc * 32 + 4 * fq;
#pragma unroll
        for (int ai = 0; ai < 2; ++ai)
#pragma unroll
            for (int m = 0; m < 4; ++m) { const unsigned ro = (unsigned)(row0 + ai * 128 + m * 16) * ldc + col0;
#pragma unroll
                for (int bj = 0; bj < 2; ++bj)
#pragma unroll
                    for (int n = 0; n < 2; ++n) { const unsigned off = ro + bj * 128 + n * 16; f32x4 v = acc[ai][bj][m][n];
                        if (MODE == 0) { v += ALPHA * *(const f32x4*)(IF + off); *(f32x4*)(OF + off) = v; }
                        else if (MODE == 1) { const u32x2 t = *(const u32x2*)(IB + off);
                            v[0] += ALPHA * bflo(t.x); v[1] += ALPHA * bfhi(t.x); v[2] += ALPHA * bflo(t.y); v[3] += ALPHA * bfhi(t.y);
                            *(f32x4*)(OF + off) = v; u32x2 w; w.x = pk2(v[0], v[1]); w.y = pk2(v[2], v[3]); *(u32x2*)(O + off) = w; }
                        else if (MODE == 2) { *(f32x4*)(OF + off) = v; }
                        else { const f32x4 pr = *(const f32x4*)(IF + off); f32x4 r = *(const f32x4*)(OF + off);
#pragma unroll
                            for (int j = 0; j < 4; ++j) r[j] += sigmoidf_(v[j]) * pr[j];
                            *(f32x4*)(OF + off) = r; }
                    }
                if (MODE != 2) asm volatile("" ::: "memory"); }
    }
};

__device__ __forceinline__ float wave_sum(float v) {
#pragma unroll
    for (int o = 1; o < 64; o <<= 1) v += __shfl_xor(v, o);
    return v;
}
__device__ __forceinline__ float wave_max(float v) {
#pragma unroll
    for (int o = 1; o < 64; o <<= 1) v = fmaxf(v, __shfl_xor(v, o));
    return v;
}
#define MFMA16(a, b, c) __builtin_amdgcn_mfma_f32_16x16x32_bf16((a), (b), (c), 0, 0, 0)

template <bool TO_BF16>
__device__ __forceinline__ void ln_row2(const float* x0, const float* x1, const float* gam, const float* bet, float* of0, float* of1, bf16* ob0, bf16* ob1, int lane) {
    const f32x4* xr0 = (const f32x4*)x0 + lane; const f32x4* xr1 = (const f32x4*)x1 + lane;
    f32x4 v[4], u[4]; float s = 0.f, t = 0.f;
#pragma unroll
    for (int j = 0; j < 4; ++j) { v[j] = xr0[64 * j]; u[j] = xr1[64 * j]; }
#pragma unroll
    for (int j = 0; j < 4; ++j) { s += (v[j][0] + v[j][1]) + (v[j][2] + v[j][3]); t += (u[j][0] + u[j][1]) + (u[j][2] + u[j][3]); }
#pragma unroll
    for (int o = 1; o < 64; o <<= 1) { s += __shfl_xor(s, o); t += __shfl_xor(t, o); }
    const float mean0 = s * (1.f / 1024.f), mean1 = t * (1.f / 1024.f); float s2 = 0.f, t2 = 0.f;
#pragma unroll
    for (int j = 0; j < 4; ++j) { v[j] = v[j] - mean0; u[j] = u[j] - mean1;
        s2 += (v[j][0] * v[j][0] + v[j][1] * v[j][1]) + (v[j][2] * v[j][2] + v[j][3] * v[j][3]); t2 += (u[j][0] * u[j][0] + u[j][1] * u[j][1]) + (u[j][2] * u[j][2] + u[j][3] * u[j][3]); }
#pragma unroll
    for (int o = 1; o < 64; o <<= 1) { s2 += __shfl_xor(s2, o); t2 += __shfl_xor(t2, o); }
    const float r0 = 1.f / sqrtf(s2 * (1.f / 1024.f) + LN_EPS), r1 = 1.f / sqrtf(t2 * (1.f / 1024.f) + LN_EPS);
#pragma unroll
    for (int j = 0; j < 4; ++j) { const f32x4 g = ((const f32x4*)gam)[lane + 64 * j], b = ((const f32x4*)bet)[lane + 64 * j]; const f32x4 o0 = v[j] * r0 * g + b, o1 = u[j] * r1 * g + b;
        if (TO_BF16) { u32x2 w; w.x = pk2(o0[0], o0[1]); w.y = pk2(o0[2], o0[3]); ((u32x2*)ob0)[lane + 64 * j] = w; w.x = pk2(o1[0], o1[1]); w.y = pk2(o1[2], o1[3]); ((u32x2*)ob1)[lane + 64 * j] = w; }
        else { ((f32x4*)of0)[lane + 64 * j] = o0; ((f32x4*)of1)[lane + 64 * j] = o1; } }
}

constexpr int SC_LD = 2052;
constexpr int MK_OFF = 16 * SC_LD * 4;
template <int MODE>
__device__ __forceinline__ void mixa_unit(const bf16* QI, const bf16* KI, const float* WI, const bf16* QA, bf16* YA, const bf16* KA, const bf16* VAT,
                                          LAS unsigned char* lds, int b, int qt) {
    const int tid = threadIdx.x, w = __builtin_amdgcn_readfirstlane(tid >> 6), lane = tid & 63, n = lane & 15, g = lane >> 4;
    const int rowbase = b * SEQ + qt * 16, nk16 = qt + 1;
    LAS float* SC = (LAS float*)lds;
    LAS unsigned long long* MK = (LAS unsigned long long*)(lds + MK_OFF);
    const f32x4 zero4 = {0.f, 0.f, 0.f, 0.f};
    {
        bf16x8 qf[8][2];
        const bf16* qrow = QI + (size_t)(rowbase + n) * 512 + 8 * g;
#pragma unroll
        for (int h = 0; h < 8; ++h) { qf[h][0] = *(const bf16x8*)(qrow + h * 64); qf[h][1] = *(const bf16x8*)(qrow + h * 64 + 32); }
        const f32x4 w0 = *(const f32x4*)(WI + (size_t)(rowbase + n) * 8), w1 = *(const f32x4*)(WI + (size_t)(rowbase + n) * 8 + 4);
        const float wv[8] = {w0[0], w0[1], w0[2], w0[3], w1[0], w1[1], w1[2], w1[3]};
        const bf16* kbase = KI + (size_t)(b * SEQ + n) * 64 + 8 * g;
        const int ntw = (nk16 > w) ? ((nk16 - w + 7) >> 3) : 0;
        bf16x8 ka[2][2], kbv[2][2];
#define P1_LOAD(dst, g0) do { _Pragma("unroll") for (int i_ = 0; i_ < 2; ++i_) { int ti_ = (g0) * 2 + i_; ti_ = ti_ < ntw ? ti_ : (ntw - 1); const bf16* p_ = kbase + (size_t)(w + 8 * ti_) * 1024; \
            dst[i_][0] = *(const bf16x8*)p_; dst[i_][1] = *(const bf16x8*)(p_ + 32); } } while (0)
#define P1_COMP(src, g0) do { _Pragma("unroll") for (int i_ = 0; i_ < 2; ++i_) { const int ti_ = (g0) * 2 + i_; if (ti_ < ntw) { const int kt = w + 8 * ti_; f32x4 sc = zero4; \
            _Pragma("unroll") for (int h = 0; h < 8; ++h) { f32x4 a = MFMA16(src[i_][0], qf[h][0], zero4); a = MFMA16(src[i_][1], qf[h][1], a); \
                _Pragma("unroll") for (int i = 0; i < 4; ++i) sc[i] += fmaxf(a[i], 0.f) * wv[h]; } \
            if (kt == qt) { _Pragma("unroll") for (int i = 0; i < 4; ++i) if (4 * g + i > n) sc[i] = -INFINITY; } \
            *(LAS f32x4*)(SC + n * SC_LD + kt * 16 + 4 * g) = sc; } } } while (0)
        if (ntw > 0) {
            const int ng = (ntw + 1) >> 1;
            P1_LOAD(ka, 0);
            for (int g0 = 0; g0 < ng; g0 += 2) {
                if (g0 + 1 < ng) P1_LOAD(kbv, g0 + 1);
                P1_COMP(ka, g0);
                if (g0 + 1 >= ng) break;
                if (g0 + 2 < ng) P1_LOAD(ka, g0 + 2);
                P1_COMP(kbv, g0 + 1);
            }
        }
#undef P1_LOAD
#undef P1_COMP
    }
    __syncthreads();
#ifndef SELREP
#define SELREP 1
#endif
#pragma unroll 1
    for (int qq_ = 0; qq_ < ((MODE & 4) ? 2 * SELREP : 0); ++qq_) { const int qq = qq_ & 1;
        const int nq = 2 * w + qq, t = qt * 16 + nq, Lr = 16 * nk16, nj = (Lr + 63) >> 6;
        unsigned key[32];
#pragma unroll
        for (int j = 0; j < 32; ++j) { const int idx = lane + 64 * j; float v = SC[nq * SC_LD + idx]; v = (idx < Lr) ? v : -INFINITY;
            const unsigned uu = __builtin_bit_cast(unsigned, v); key[j] = (uu & 0x80000000u) ? ~uu : (uu | 0x80000000u); }
        if (t + 1 <= 256) {
            { const int lo = lane * 64; unsigned long long mm = 0ull;
              if (lo + 63 <= t) mm = ~0ull; else if (lo <= t) mm = (2ull << (t - lo)) - 1ull;
              if (lane < 32) MK[nq * 32 + lane] = mm; }
        } else {
#define SEL_CNT(OP, N, TH, OUT) do { _Pragma("unroll") for (int j = 0; j < (N); j += 4) { unsigned long long m0_, m1_, m2_, m3_; \
        asm("v_cmp_" OP "_u32_e64 %0, %4, %8\n\tv_cmp_" OP "_u32_e64 %1, %5, %8\n\tv_cmp_" OP "_u32_e64 %2, %6, %8\n\tv_cmp_" OP "_u32_e64 %3, %7, %8" \
            : "=&s"(m0_), "=&s"(m1_), "=&s"(m2_), "=&s"(m3_) : "v"(key[j]), "v"(key[j + 1]), "v"(key[j + 2]), "v"(key[j + 3]), "v"(TH)); \
        OUT += __builtin_popcountll(m0_) + __builtin_popcountll(m1_) + __builtin_popcountll(m2_) + __builtin_popcountll(m3_); } } while (0)
#define SEL_CNT_NJ(OP, TH, OUT) do { if (nj <= 8) SEL_CNT(OP, 8, TH, OUT); else if (nj <= 16) SEL_CNT(OP, 16, TH, OUT); else if (nj <= 24) SEL_CNT(OP, 24, TH, OUT); else SEL_CNT(OP, 32, TH, OUT); } while (0)
            unsigned T = 0u; bool exact = false;
#pragma unroll 1
            for (int bit = (MODE & 8) ? -1 : 31; bit >= 0; --bit) {
                const unsigned cand = T | (1u << bit); int cnt = 0;
                SEL_CNT_NJ("ge", cand, cnt);
                if (cnt >= 256) { T = cand; if (cnt == 256) { exact = true; break; } }
            }
            int need = 0x7fffffff;
            if (!exact) { int cgt = 0; SEL_CNT_NJ("gt", T, cgt); need = 256 - cgt; }
#undef SEL_CNT
#undef SEL_CNT_NJ
            unsigned wlo = 0u, whi = 0u;
            if (exact) {
#pragma unroll
                for (int j = 0; j < 32; ++j) if (j < nj) { unsigned long long m_; asm("v_cmp_ge_u32_e64 %0, %1, %2" : "=s"(m_) : "v"(key[j]), "v"(T));
                    wlo = (lane == j) ? (unsigned)m_ : wlo; whi = (lane == j) ? (unsigned)(m_ >> 32) : whi; }
            } else {
                int tb = 0; const unsigned long long ltm = (1ull << lane) - 1ull;
#pragma unroll
                for (int j = 0; j < 32; ++j) if (j < nj) { const bool eq = key[j] == T; const unsigned long long eqm = __ballot(eq);
                    const int myrank = tb + __popcll(eqm & ltm);
                    const unsigned long long selm = __ballot(key[j] > T || (eq && myrank < need)); tb += __popcll(eqm);
                    wlo = (lane == j) ? (unsigned)selm : wlo; whi = (lane == j) ? (unsigned)(selm >> 32) : whi; }
            }
            if (lane < 32) MK[nq * 32 + lane] = ((unsigned long long)whi << 32) | wlo;
        }
    }
    __syncthreads();
#ifndef P2REP
#define P2REP 1
#endif
    if (MODE & 2) for (int p2r_ = 0; p2r_ < P2REP; ++p2r_) {
        constexpr int KLD = 72, VLD = 136;
        LAS bf16* KT = (LAS bf16*)lds;
        LAS bf16* VTT = (LAS bf16*)(lds + 2 * 128 * KLD * 2);
        const bf16* qrow = QA + (size_t)(rowbase + n) * 512 + w * 64 + 8 * g;
        const bf16x8 qa0 = *(const bf16x8*)qrow, qa1 = *(const bf16x8*)(qrow + 32);
        f32x4 o[4] = {zero4, zero4, zero4, zero4}, osum = zero4; float mrun = -1e30f;
        const u32x4 onesw = {0x3f803f80u, 0x3f803f80u, 0x3f803f80u, 0x3f803f80u}; const bf16x8 ones8 = __builtin_bit_cast(bf16x8, onesw);
        const int nT = (nk16 + 7) >> 3;
        const int kr0 = tid >> 3, kc = tid & 7, vd0 = tid >> 4, vc = tid & 15;
        const bf16* kg = KA + (size_t)(b * SEQ + kr0) * 64 + kc * 8;
        const bf16* vg = VAT + (size_t)(b * 64 + vd0) * 2048 + vc * 8;
        const int klds = kr0 * KLD + kc * 8, vlds = vd0 * VLD + vc * 8;
#define P2_LOAD(R, T) do { R[0] = *(const u32x4*)(kg + (size_t)(T) * 8192); R[1] = *(const u32x4*)(kg + (size_t)(T) * 8192 + 4096); \
                           R[2] = *(const u32x4*)(vg + (T) * 128); R[3] = *(const u32x4*)(vg + (T) * 128 + 32 * 2048); } while (0)
#define P2_STORE(R, buf) do { *(LAS u32x4*)(KT + (buf) * 128 * KLD + klds) = R[0]; *(LAS u32x4*)(KT + (buf) * 128 * KLD + klds + 64 * KLD) = R[1]; \
                              *(LAS u32x4*)(VTT + (buf) * 64 * VLD + vlds) = R[2]; *(LAS u32x4*)(VTT + (buf) * 64 * VLD + vlds + 32 * VLD) = R[3]; } while (0)
        u32x4 rA[4], rB[4];
        P2_LOAD(rA, 0);
        if (nT > 1) P2_LOAD(rB, 1);
        P2_STORE(rA, 0);
        __syncthreads();
#define MIXA_TILE(T, buf) do { \
            const LAS bf16* kt = KT + (buf) * 128 * KLD; const LAS bf16* vt = VTT + (buf) * 64 * VLD; \
            const unsigned long long mw0 = MK[n * 32 + 2 * (T)] >> (4 * g), mw1 = MK[n * 32 + 2 * (T) + 1] >> (4 * g); \
            const int wd4[4] = {(int)(unsigned)mw0, (int)(unsigned)(mw0 >> 32), (int)(unsigned)mw1, (int)(unsigned)(mw1 >> 32)}; \
            f32x4 st[8]; \
            _Pragma("unroll") for (int c8 = 0; c8 < 8; ++c8) { const LAS bf16* kp = kt + (16 * c8 + n) * KLD + 8 * g; \
                const bf16x8 k0 = *(const LAS bf16x8*)kp, k1 = *(const LAS bf16x8*)(kp + 32); \
                st[c8] = MFMA16(k0, qa0, zero4); st[c8] = MFMA16(k1, qa1, st[c8]); } \
            float bm = st[0][0]; \
            _Pragma("unroll") for (int c8 = 0; c8 < 8; ++c8) \
                _Pragma("unroll") for (int i = 0; i < 4; ++i) bm = fmaxf(bm, st[c8][i]);                   \
            bm = fmaxf(bm, __shfl_xor(bm, 16)); bm = fmaxf(bm, __shfl_xor(bm, 32)); \
            const float mn = fmaxf(mrun, bm), alpha = __builtin_amdgcn_exp2f(mrun - mn); mrun = mn; \
            _Pragma("unroll") for (int c8 = 0; c8 < 8; ++c8) \
                _Pragma("unroll") for (int i = 0; i < 4; ++i) { const int mk_ = (wd4[c8 >> 1] << (31 - (16 * (c8 & 1) + i))) >> 31;     \
                    st[c8][i] = __builtin_bit_cast(float, __builtin_bit_cast(int, __builtin_amdgcn_exp2f(st[c8][i] - mn)) & mk_); } \
            _Pragma("unroll") for (int dt = 0; dt < 4; ++dt) o[dt] = o[dt] * alpha; \
            osum = osum * alpha; \
            _Pragma("unroll") for (int kb4 = 0; kb4 < 4; ++kb4) { \
                u32x4 pw; pw.x = pk2(st[2 * kb4][0], st[2 * kb4][1]); pw.y = pk2(st[2 * kb4][2], st[2 * kb4][3]); pw.z = pk2(st[2 * kb4 + 1][0], st[2 * kb4 + 1][1]); pw.w = pk2(st[2 * kb4 + 1][2], st[2 * kb4 + 1][3]); \
                const bf16x8 pb = __builtin_bit_cast(bf16x8, pw); \
                osum = MFMA16(ones8, pb, osum);                                                             \
                _Pragma("unroll") for (int dt = 0; dt < 4; ++dt) { const LAS bf16* vp = vt + (16 * dt + n) * VLD + 32 * kb4 + 4 * g; \
                    const u32x2 lo = *(const LAS u32x2*)vp, hi = *(const LAS u32x2*)(vp + 16); \
                    u32x4 vv; vv.x = lo.x; vv.y = lo.y; vv.z = hi.x; vv.w = hi.y; \
                    o[dt] = MFMA16(__builtin_bit_cast(bf16x8, vv), pb, o[dt]); } } \
        } while (0)
        for (int T0 = 0; T0 < nT; T0 += 2) {
            if (T0 + 2 < nT) P2_LOAD(rA, T0 + 2);
            MIXA_TILE(T0, 0);
            if (T0 + 1 < nT) P2_STORE(rB, 1);
            __syncthreads();
            if (T0 + 1 >= nT) break;
            if (T0 + 3 < nT) P2_LOAD(rB, T0 + 3);
            MIXA_TILE(T0 + 1, 1);
            if (T0 + 2 < nT) P2_STORE(rA, 0);
            __syncthreads();
        }
#undef MIXA_TILE
#undef P2_LOAD
#undef P2_STORE
        const float inv = 1.0f / osum[0];
        bf16* orow = YA + (size_t)(rowbase + n) * 512 + w * 64 + 4 * g;
#pragma unroll
        for (int dt = 0; dt < 4; ++dt) { u32x2 ww; ww.x = pk2(o[dt][0] * inv, o[dt][1] * inv); ww.y = pk2(o[dt][2] * inv, o[dt][3] * inv); *(u32x2*)(orow + dt * 16) = ww; }
    }
    __syncthreads();
}

constexpr int KW_LD = 72;
__device__ __forceinline__ void m1_unit(const bf16* MLQK, const bf16* MLV, const float* IG, const float* LF, const float* conv_w, const float* conv_b,
                                        bf16* QC, bf16* DC, float* DN, float* BCUM, float* CS, LAS unsigned char* lds, int unit) {
    const int c = unit & 31, bh = unit >> 5, h = bh & 3, b = bh >> 2;
    const int tid = threadIdx.x, w = __builtin_amdgcn_readfirstlane(tid >> 6), lane = tid & 63, n = lane & 15, g = lane >> 4;
    const int rowbase = b * SEQ + c * 64;
    LAS float* WK = (LAS float*)lds;
    LAS bf16* KWT = (LAS bf16*)(lds + 1024);
    LAS bf16* VT = (LAS bf16*)(lds + 1024 + 128 * KW_LD * 2);
    if (w == 0) {
        const float lf = LF[(size_t)(rowbase + lane) * 4 + h], ig = IG[(size_t)(rowbase + lane) * 4 + h];
        float bc = lf;
#pragma unroll
        for (int o = 1; o < 64; o <<= 1) { const float tt = __shfl_up(bc, o); if (lane >= o) bc += tt; }
        const float bl = __shfl(bc, 63), gj = bl - bc + ig, mg = wave_max(gj);
        WK[lane] = __expf(gj - mg);
        BCUM[(size_t)(rowbase + lane) * 4 + h] = bc;
        if (lane == 0) { CS[unit * 2] = bl; CS[unit * 2 + 1] = mg; }
    }
    __syncthreads();
    {
        const int isk = (tid >> 4) & 1, cgi = tid & 15, rl = tid >> 5;
        const int ch = isk * 512 + h * 128 + cgi * 8;
        float cw[4][8], cb[8];
#pragma unroll
        for (int j = 0; j < 4; ++j) { const f32x4 a = *(const f32x4*)(conv_w + j * 1024 + ch), bb = *(const f32x4*)(conv_w + j * 1024 + ch + 4);
            cw[j][0] = a[0]; cw[j][1] = a[1]; cw[j][2] = a[2]; cw[j][3] = a[3]; cw[j][4] = bb[0]; cw[j][5] = bb[1]; cw[j][6] = bb[2]; cw[j][7] = bb[3]; }
        { const f32x4 a = *(const f32x4*)(conv_b + ch), bb = *(const f32x4*)(conv_b + ch + 4);
            cb[0] = a[0]; cb[1] = a[1]; cb[2] = a[2]; cb[3] = a[3]; cb[4] = bb[0]; cb[5] = bb[1]; cb[6] = bb[2]; cb[7] = bb[3]; }
        float x[7][8];
#pragma unroll
        for (int rr = 0; rr < 7; ++rr) { const int tl = c * 64 + 4 * rl + rr - 3;
            u32x4 t = {0u, 0u, 0u, 0u};
            if (tl >= 0) t = *(const u32x4*)(MLQK + (size_t)(b * SEQ + tl) * 1024 + ch);
            x[rr][0] = bflo(t.x); x[rr][1] = bfhi(t.x); x[rr][2] = bflo(t.y); x[rr][3] = bfhi(t.y); x[rr][4] = bflo(t.z); x[rr][5] = bfhi(t.z); x[rr][6] = bflo(t.w); x[rr][7] = bfhi(t.w); }
#pragma unroll
        for (int oo = 0; oo < 4; ++oo) { const int jr = 4 * rl + oo; float y[8];
#pragma unroll
            for (int e = 0; e < 8; ++e) { float a = cb[e];
#pragma unroll
                for (int j = 0; j < 4; ++j) a += cw[j][e] * x[oo + j][e];
                a = a * sigmoidf_(a); y[e] = isk ? a * MLK_SCALE : a; }
            u32x4 wv; wv.x = pk2(y[0], y[1]); wv.y = pk2(y[2], y[3]); wv.z = pk2(y[4], y[5]); wv.w = pk2(y[6], y[7]);
            *(u32x4*)(QC + (size_t)(rowbase + jr) * 1024 + ch) = wv;
            if (isk) { const float wk = WK[jr];
#pragma unroll
                for (int e = 0; e < 8; ++e) KWT[(cgi * 8 + e) * KW_LD + jr] = (bf16)f2bf(y[e] * wk); }
        }
#pragma unroll
        for (int q = 0; q < 2; ++q) { const int idx = tid + 512 * q, row = idx >> 4, cgv = idx & 15;
            const u32x4 t = *(const u32x4*)(MLV + (size_t)(rowbase + row) * 512 + h * 128 + cgv * 8);
            LAS bf16* vp = VT + (cgv * 8) * KW_LD + row;
            vp[0 * KW_LD] = (bf16)(t.x & 0xffffu); vp[1 * KW_LD] = (bf16)(t.x >> 16); vp[2 * KW_LD] = (bf16)(t.y & 0xffffu); vp[3 * KW_LD] = (bf16)(t.y >> 16);
            vp[4 * KW_LD] = (bf16)(t.z & 0xffffu); vp[5 * KW_LD] = (bf16)(t.z >> 16); vp[6 * KW_LD] = (bf16)(t.w & 0xffffu); vp[7 * KW_LD] = (bf16)(t.w >> 16); }
    }
    __syncthreads();
    {
        f32x4 acc[8];
#pragma unroll
        for (int et = 0; et < 8; ++et) acc[et] = (f32x4){0.f, 0.f, 0.f, 0.f};
#pragma unroll
        for (int ks = 0; ks < 2; ++ks) { const bf16x8 a = *(const LAS bf16x8*)(KWT + (16 * w + n) * KW_LD + 32 * ks + 8 * g);
#pragma unroll
            for (int et = 0; et < 8; ++et) { const bf16x8 bfr = *(const LAS bf16x8*)(VT + (16 * et + n) * KW_LD + 32 * ks + 8 * g); acc[et] = MFMA16(a, bfr, acc[et]); } }
        bf16* dcu = DC + (size_t)unit * 16384;
#pragma unroll
        for (int et = 0; et < 8; ++et) { u32x2 ww; ww.x = pk2(acc[et][0], acc[et][1]); ww.y = pk2(acc[et][2], acc[et][3]); *(u32x2*)(dcu + (16 * et + n) * 128 + 16 * w + 4 * g) = ww; }
        if (tid < 128) { float s = 0.f;
#pragma unroll 8
            for (int j = 0; j < 64; ++j) s += __builtin_bit_cast(float, (unsigned)KWT[tid * KW_LD + j] << 16);
            DN[(size_t)unit * 128 + tid] = s; }
    }
    __syncthreads();
}

constexpr int CT_LD = 136;
__device__ __forceinline__ void m3_unit(const bf16* QC, const bf16* MLV, bf16* YB, const bf16* MLO, const float* IG, const float* BCUM, const float* MST,
                                        const bf16* DC, const float* DN, const float* gnorm, LAS unsigned char* lds, int unit) {
    const int c = unit & 31, bh = unit >> 5, h = bh & 3, b = bh >> 2;
    const int tid = threadIdx.x, w = __builtin_amdgcn_readfirstlane(tid >> 6), lane = tid & 63, n = lane & 15, g = lane >> 4;
    const int rowbase = b * SEQ + c * 64;
    LAS float* U = (LAS float*)lds; LAS float* R = U + 64; LAS float* WINT = U + 128; LAS float* EMR = U + 192; LAS float* NS = U + 256; LAS float* XCH = U + 384;
    LAS bf16* CT = (LAS bf16*)(lds + 4096);
    LAS bf16* KS = (LAS bf16*)(lds + 4096 + 128 * CT_LD * 2);
    LAS bf16* VT = (LAS bf16*)(lds + 4096 + 128 * CT_LD * 2 + 64 * CT_LD * 2);
    if (w == 0) {
        const float bc = BCUM[(size_t)(rowbase + lane) * 4 + h], ig = IG[(size_t)(rowbase + lane) * 4 + h], mc = MST[unit];
        const float uu = ig - bc; float a = uu;
#pragma unroll
        for (int o = 1; o < 64; o <<= 1) { const float tt = __shfl_up(a, o); if (lane >= o) a = fmaxf(a, tt); }
        const float mrow = bc + fmaxf(a, mc);
        U[lane] = uu; R[lane] = bc - mrow; WINT[lane] = __expf(bc + mc - mrow); EMR[lane] = __expf(-mrow);
    }
    {
        const bf16* dcu = DC + (size_t)unit * 16384;
#pragma unroll
        for (int q = 0; q < 4; ++q) { const int idx = tid + 512 * q, e = idx >> 4, dg = idx & 15; *(LAS u32x4*)(CT + e * CT_LD + dg * 8) = *(const u32x4*)(dcu + idx * 8); }
#pragma unroll
        for (int q = 0; q < 2; ++q) { const int idx = tid + 512 * q, s = idx >> 4, dg = idx & 15;
            *(LAS u32x4*)(KS + s * CT_LD + dg * 8) = *(const u32x4*)(QC + (size_t)(rowbase + s) * 1024 + 512 + h * 128 + dg * 8); }
#pragma unroll
        for (int q = 0; q < 2; ++q) { const int idx = tid + 512 * q, row = idx >> 4, cgv = idx & 15;
            const u32x4 t = *(const u32x4*)(MLV + (size_t)(rowbase + row) * 512 + h * 128 + cgv * 8);
            LAS bf16* vp = VT + (cgv * 8) * KW_LD + row;
            vp[0 * KW_LD] = (bf16)(t.x & 0xffffu); vp[1 * KW_LD] = (bf16)(t.x >> 16); vp[2 * KW_LD] = (bf16)(t.y & 0xffffu); vp[3 * KW_LD] = (bf16)(t.y >> 16);
            vp[4 * KW_LD] = (bf16)(t.z & 0xffffu); vp[5 * KW_LD] = (bf16)(t.z >> 16); vp[6 * KW_LD] = (bf16)(t.w & 0xffffu); vp[7 * KW_LD] = (bf16)(t.w >> 16); }
        if (tid < 128) NS[tid] = DN[(size_t)unit * 128 + tid];
    }
    const int lt = w & 3, eh = w >> 2, l = 16 * lt + n;
    bf16x8 qf[4];
    { const bf16* qrow = QC + (size_t)(rowbase + l) * 1024 + h * 128 + 8 * g;
#pragma unroll
        for (int ks = 0; ks < 4; ++ks) qf[ks] = *(const bf16x8*)(qrow + 32 * ks); }
    __syncthreads();
#ifdef M3_LITE
    {
        const int lt = w & 3, eh = w >> 2, l = 16 * lt + n;
#pragma unroll
        for (int j = 0; j < 4; ++j) { const int e0 = 16 * (4 * eh + j) + 4 * g; float y[4];
#pragma unroll
            for (int i = 0; i < 4; ++i) { const int e = e0 + i;
                y[i] = 0.f;
                if (M3_LITE & 1) y[i] += __builtin_bit_cast(float, (unsigned)CT[e * CT_LD + ((l * 2 + 1) & 127)] << 16);
                if (M3_LITE & 2) y[i] += __builtin_bit_cast(float, (unsigned)KS[l * CT_LD + e] << 16);
                if (M3_LITE & 4) y[i] += __builtin_bit_cast(float, (unsigned)VT[e * KW_LD + l] << 16);
                if (M3_LITE & 8) y[i] += NS[e];
                if (M3_LITE & 16) y[i] += U[l] + R[l];
                if (M3_LITE & 32) y[i] += WINT[l] + EMR[l]; }
            const size_t off = (size_t)(rowbase + l) * 512 + h * 128 + e0;
            u32x2 ww; ww.x = pk2(y[0], y[1]); ww.y = pk2(y[2], y[3]); *(u32x2*)(YB + off) = ww; }
        __syncthreads();
        return;
    }
#endif
    const f32x4 zero4 = {0.f, 0.f, 0.f, 0.f};
    f32x4 sw[4]; const float Rl = R[l], wint = WINT[l], emr = EMR[l];
    float dsum = 0.f;
#pragma unroll
    for (int st = 0; st < 4; ++st) {
        sw[st] = zero4;
        if (st <= lt) { f32x4 acc = zero4;
#pragma unroll
            for (int ks = 0; ks < 4; ++ks) { const bf16x8 a = *(const LAS bf16x8*)(KS + (16 * st + n) * CT_LD + 32 * ks + 8 * g); acc = MFMA16(a, qf[ks], acc); }
#pragma unroll
            for (int i = 0; i < 4; ++i) { const int s = 16 * st + 4 * g + i; const float wgt = (s <= l) ? __expf(U[s] + Rl) : 0.f; sw[st][i] = acc[i] * wgt; dsum += sw[st][i]; } }
    }
    dsum += __shfl_xor(dsum, 16); dsum += __shfl_xor(dsum, 32);
    float qn = 0.f;
#pragma unroll
    for (int ks = 0; ks < 4; ++ks) { const u32x4 qq = __builtin_bit_cast(u32x4, qf[ks]); const LAS float* np = NS + 32 * ks + 8 * g;
        qn += bflo(qq.x) * np[0] + bfhi(qq.x) * np[1] + bflo(qq.y) * np[2] + bfhi(qq.y) * np[3] + bflo(qq.z) * np[4] + bfhi(qq.z) * np[5] + bflo(qq.w) * np[6] + bfhi(qq.w) * np[7]; }
    qn += __shfl_xor(qn, 16); qn += __shfl_xor(qn, 32);
    const float den = wint * qn + dsum;
    const float rden = 1.0f / fmaxf(fabsf(den), emr);
    f32x4 hv[4]; float s1 = 0.f;
#pragma unroll
    for (int j = 0; j < 4; ++j) { const int et = 4 * eh + j;
        f32x4 accS = zero4, accC = zero4;
#pragma unroll
        for (int kb = 0; kb < 2; ++kb) if (2 * kb <= lt) {
            u32x4 pw; pw.x = pk2(sw[2 * kb][0], sw[2 * kb][1]); pw.y = pk2(sw[2 * kb][2], sw[2 * kb][3]); pw.z = pk2(sw[2 * kb + 1][0], sw[2 * kb + 1][1]); pw.w = pk2(sw[2 * kb + 1][2], sw[2 * kb + 1][3]);
            const LAS bf16* vp = VT + (16 * et + n) * KW_LD + 32 * kb + 4 * g;
            const u32x2 lo = *(const LAS u32x2*)vp, hi = *(const LAS u32x2*)(vp + 16);
            u32x4 vv; vv.x = lo.x; vv.y = lo.y; vv.z = hi.x; vv.w = hi.y;
            accS = MFMA16(__builtin_bit_cast(bf16x8, vv), __builtin_bit_cast(bf16x8, pw), accS); }
#pragma unroll
        for (int ks = 0; ks < 4; ++ks) { const bf16x8 a = *(const LAS bf16x8*)(CT + (16 * et + n) * CT_LD + 32 * ks + 8 * g); accC = MFMA16(a, qf[ks], accC); }
#pragma unroll
        for (int i = 0; i < 4; ++i) { hv[j][i] = (wint * accC[i] + accS[i]) * rden; s1 += hv[j][i]; }
    }
    s1 += __shfl_xor(s1, 16); s1 += __shfl_xor(s1, 32);
    const float mloc = s1 * (1.f / 64.f); float q2 = 0.f;
#pragma unroll
    for (int j = 0; j < 4; ++j)
#pragma unroll
        for (int i = 0; i < 4; ++i) { const float dd = hv[j][i] - mloc; q2 += dd * dd; }
    q2 += __shfl_xor(q2, 16); q2 += __shfl_xor(q2, 32);
    if (g == 0) { XCH[(l * 2 + eh) * 2] = mloc; XCH[(l * 2 + eh) * 2 + 1] = q2; }
    __syncthreads();
    {
        const float mo = XCH[(l * 2 + (eh ^ 1)) * 2], qo = XCH[(l * 2 + (eh ^ 1)) * 2 + 1];
        const float mean = 0.5f * (mloc + mo), dm = mloc - mo, m2 = q2 + qo + 32.f * dm * dm;
        const float rstd = 1.0f / sqrtf(m2 * (1.f / 128.f) + LN_EPS);
#pragma unroll
        for (int j = 0; j < 4; ++j) { const int e0 = 16 * (4 * eh + j) + 4 * g;
            const f32x4 gn = *(const f32x4*)(gnorm + h * 128 + e0);
            const size_t off = (size_t)(rowbase + l) * 512 + h * 128 + e0;
            const u32x2 so = *(const u32x2*)(MLO + off);
            const float y0 = (hv[j][0] - mean) * rstd * gn[0] * bflo(so.x), y1 = (hv[j][1] - mean) * rstd * gn[1] * bfhi(so.x);
            const float y2 = (hv[j][2] - mean) * rstd * gn[2] * bflo(so.y), y3 = (hv[j][3] - mean) * rstd * gn[3] * bfhi(so.y);
            u32x2 ww; ww.x = pk2(y0, y1); ww.y = pk2(y2, y3); *(u32x2*)(YB + off) = ww; }
    }
    __syncthreads();
}

#define XB_TMO      128
#define XB_XCNT(j)  (256  + 64 * (j))
#define XB_XSUB(j)  (1280 + 64 * (j))
#define XB_XGEN(j)  (2304 + 64 * (j))
#define XB_TOP      3328
#define XB_TOPGEN   3392
#define XCD_BAR_WORDS 3456
#define XB_SPIN_CAP (1u << 18)

__device__ __forceinline__ unsigned xb_ld(unsigned* p)              { return __hip_atomic_load(p, __ATOMIC_RELAXED, __HIP_MEMORY_SCOPE_AGENT); }
__device__ __forceinline__ unsigned xb_add(unsigned* p, unsigned v) { return __hip_atomic_fetch_add(p, v, __ATOMIC_RELAXED, __HIP_MEMORY_SCOPE_AGENT); }
__device__ __forceinline__ unsigned xb_xcc_id() { return (unsigned)__builtin_amdgcn_s_getreg((3 << 11) | 20) & 0xFu; }
#define XB_SPIN(cond, bar) do { unsigned _sp = 0; while (cond) { __builtin_amdgcn_s_sleep(1); \
    if ((++_sp & 255u) == 0u) { if (xb_ld(&(bar)[XB_TMO])) break; if (_sp > XB_SPIN_CAP) { atomicAdd(&(bar)[XB_TMO], 1u); break; } } } } while (0)

struct XcdBarrier {
    unsigned* bar; unsigned x;
    volatile LAS unsigned* st;
};

__device__ __forceinline__ XcdBarrier xcd_barrier_post(unsigned* bar, volatile LAS unsigned* st) {
    XcdBarrier b; b.bar = bar; b.x = xb_xcc_id(); b.st = st;
    if (threadIdx.x == 0) (void)xb_add(&bar[XB_XCNT(b.x)], 1u);
    return b;
}
__device__ __forceinline__ void xcd_barrier_complete(unsigned* bar, unsigned x, unsigned& nloc, unsigned& nx) {
    const unsigned G = gridDim.x * gridDim.y * gridDim.z;
    unsigned sum, cnt, mine, sp = 0u;
    for (;;) {
        sum = 0u; cnt = 0u; mine = 0u;
#pragma unroll
        for (unsigned j = 0; j < 16; ++j) { const unsigned c = xb_ld(&bar[XB_XCNT(j)]); sum += c; cnt += (c > 0u) ? 1u : 0u; mine = (j == x) ? c : mine; }
        if (sum == G) break;
        __builtin_amdgcn_s_sleep(1);
        if ((++sp & 255u) == 0u) { if (xb_ld(&bar[XB_TMO])) break; if (sp > XB_SPIN_CAP) { atomicAdd(&bar[XB_TMO], 1u); break; } }
    }
    nloc = mine > 0u ? mine : 1u; nx = cnt > 0u ? cnt : 1u;
}

__device__ __forceinline__ void xcd_barrier(const XcdBarrier& b) {
    asm volatile("s_waitcnt vmcnt(0)" ::: "memory");
    __syncthreads();
    if (threadIdx.x == 0) {
        unsigned* bar = b.bar;
        __builtin_amdgcn_s_waitcnt(0);
        unsigned nloc = b.st[0], nx = b.st[1];
        if (nloc == 0u) { xcd_barrier_complete(bar, b.x, nloc, nx); b.st[0] = nloc; b.st[1] = nx; }
        const unsigned old = xb_add(&bar[XB_XSUB(b.x)], 1u);
        const unsigned gen = old / nloc;
        if (old + 1u == (gen + 1u) * nloc) {
            __builtin_amdgcn_fence(__ATOMIC_RELEASE, "agent");
            asm volatile("s_waitcnt vmcnt(0)" ::: "memory");
            const unsigned og = xb_add(&bar[XB_TOP], 1u);
            const unsigned tg = og / nx;
            if (og + 1u == (tg + 1u) * nx) xb_add(&bar[XB_TOPGEN], 1u);
            else XB_SPIN(xb_ld(&bar[XB_TOPGEN]) == tg, bar);
            __builtin_amdgcn_fence(__ATOMIC_ACQUIRE, "agent");
            xb_add(&bar[XB_XGEN(b.x)], 1u);
            asm volatile("s_waitcnt vmcnt(0)" ::: "memory");
        } else {
            XB_SPIN(xb_ld(&bar[XB_XGEN(b.x)]) == gen, bar);
            __builtin_amdgcn_fence(__ATOMIC_ACQUIRE, "agent");
            asm volatile("s_waitcnt vmcnt(0)" ::: "memory");
        }
    }
    __syncthreads();
}

__global__ void __launch_bounds__(NTHR, 2) fwd_kernel(Args args) {
    extern __shared__ __attribute__((aligned(16))) unsigned char lds_raw[];
    LAS unsigned char* lds = (LAS unsigned char*)lds_raw;
    cg::grid_group grid = cg::this_grid();
    const int tid = threadIdx.x, lane = tid & 63, wave = __builtin_amdgcn_readfirstlane(tid >> 6);
    const int G = gridDim.x, bx = blockIdx.x;
    const int gw = bx * NWAVES + wave, NGW = G * NWAVES;
    const int gt = bx * NTHR + tid, NGT = G * NTHR;
    unsigned char* ws = args.ws;
    const int lo = args.ph_lo, hi = args.ph_hi;
#ifndef GEMM_REP
#define GEMM_REP 1
#endif
#ifndef PH_MASK
#define PH_MASK 0xfff
#endif
#define IN(k) (((PH_MASK >> (k)) & 1) && lo <= (k) && (k) < hi)
#define SEAM(k) do { if (IN(k) && IN((k) + 1)) { if ((k) == 0) { asm volatile("s_waitcnt vmcnt(0) lgkmcnt(0)" ::: "memory"); grid.sync(); \
    if (tid == 0) { __builtin_amdgcn_fence(__ATOMIC_ACQUIRE, "agent"); asm volatile("s_waitcnt vmcnt(0)" ::: "memory"); } __syncthreads(); } else { xcd_barrier(xbar); } } } while (0)
    volatile LAS unsigned* xst = (volatile LAS unsigned*)(lds + LDS_BYTES - 64);
    if (tid < 2) xst[tid] = 0u;
    __syncthreads();
    XcdBarrier xbar = xcd_barrier_post((unsigned*)ws, xst);
    float* OUT = (float*)(GAS float*)args.out;
#define INP(k) ((const float*)(const GAS float*)args.in[k])
#define PHASE_PTRS() unsigned char* wsb0 = ws; asm volatile("" : "+s"(wsb0)); GAS unsigned char* wsb = (GAS unsigned char*)wsb0; \
    bf16* WinT = (bf16*)(wsb + WS_WIN); bf16* WgaT = (bf16*)(wsb + WS_WGA); bf16* WgbT = (bf16*)(wsb + WS_WGB); bf16* WuaT = (bf16*)(wsb + WS_WUA); bf16* WubT = (bf16*)(wsb + WS_WUB); \
    bf16* WoutT = (bf16*)(wsb + WS_WOUT); bf16* Wff1T = (bf16*)(wsb + WS_WFF1); bf16* Wff2T = (bf16*)(wsb + WS_WFF2); bf16* WpgT = (bf16*)(wsb + WS_WPG); bf16* WppT = (bf16*)(wsb + WS_WPP); \
    float* COS = (float*)(wsb + WS_COS); float* SIN = (float*)(wsb + WS_SIN); float* WI = (float*)(wsb + WS_WI); float* IG = (float*)(wsb + WS_IG); float* LF = (float*)(wsb + WS_LF); \
    bf16* KA = (bf16*)(wsb + WS_KA); bf16* KI = (bf16*)(wsb + WS_KI); bf16* VAT = (bf16*)(wsb + WS_VAT); \
    float* BCUM = (float*)(wsb + WS_BCUM); float* CS = (float*)(wsb + WS_CS); float* MST = (float*)(wsb + WS_MST); float* DN = (float*)(wsb + WS_DN); \
    bf16* XB = (bf16*)(wsb + WS_XB); bf16* PB = (bf16*)(wsb + WS_PB); bf16* QA = (bf16*)(wsb + WS_QA); bf16* QI = (bf16*)(wsb + WS_QI); bf16* MLQK = (bf16*)(wsb + WS_MLQK); \
    bf16* MLV = (bf16*)(wsb + WS_MLV); bf16* MLO = (bf16*)(wsb + WS_MLO); bf16* QC = (bf16*)(wsb + WS_QC); bf16* DC = (bf16*)(wsb + WS_DC); \
    bf16* TMP = (bf16*)(wsb + WS_TMP); bf16* MRG = (bf16*)(wsb + WS_MRG); bf16* H1 = (bf16*)(wsb + WS_H1); bf16* HF = (bf16*)(wsb + WS_HF); bf16* RB = (bf16*)(wsb + WS_RB); \
    float* PROJ = (float*)(wsb + WS_PROJ); bf16* YA = (bf16*)(wsb + WS_YA); (void)YA; bf16* CST = (bf16*)(wsb + WS_CST); float* NST = (float*)(wsb + WS_NST); (void)CST; (void)NST; \
    (void)WinT; (void)WgaT; (void)WgbT; (void)WuaT; (void)WubT; (void)WoutT; (void)Wff1T; (void)Wff2T; (void)WpgT; (void)WppT; (void)COS; (void)SIN; (void)WI; (void)IG; (void)LF; (void)KA; (void)KI; (void)VAT; \
    (void)BCUM; (void)CS; (void)MST; (void)DN; (void)XB; (void)PB; (void)QA; (void)QI; (void)MLQK; (void)MLV; (void)MLO; (void)QC; (void)DC; (void)TMP; (void)MRG; (void)H1; (void)HF; (void)RB; (void)PROJ
#define LAUNDER_I(v) asm volatile("" : "+s"(v))

#ifndef REP0
#define REP0 1
#endif
    if (IN(0)) for (int r0_ = 0; r0_ < REP0; ++r0_) { PHASE_PTRS();
        LAS float* scr = (LAS float*)(lds + wave * 16384);
        const float* w_in = INP(I_WIN); const float* x = INP(I_X);
        constexpr int I_A = 16 * (NWIN / 32), I_G = 16 * 32, I_U = 8 * 32, I_O = 16 * 32, I_1 = 16 * 128, I_2 = 64 * 32, I_PG = 16 * 32, I_PP = 4 * 32;
        constexpr int NITEMS = I_A + 2 * I_G + 2 * I_U + I_O + I_1 + I_2 + I_PG + I_PP;
        for (int it = gw; it < NITEMS; it += NGW) {
            int r = it;
            if (r < I_A) { transpose_item(w_in, 1024, WIN_LD, WinT, NWIN, scr, r, lane, [](int n) { return win_src(n); }); continue; } r -= I_A;
            if (r < I_G) { transpose_item(w_in, 1024, WIN_LD, WgaT, 1024, scr, r, lane, [](int n) { return 3280 + n; }); continue; } r -= I_G;
            if (r < I_G) { transpose_item(w_in, 1024, WIN_LD, WgbT, 1024, scr, r, lane, [](int n) { return 4304 + n; }); continue; } r -= I_G;
            if (r < I_U) { transpose_item(INP(I_WUA), 512, 1024, WuaT, 1024, scr, r, lane, [](int n) { return n; }); continue; } r -= I_U;
            if (r < I_U) { transpose_item(INP(I_WUB), 512, 1024, WubT, 1024, scr, r, lane, [](int n) { return n; }); continue; } r -= I_U;
            if (r < I_O) { transpose_item(INP(I_WOUT), 1024, 1024, WoutT, 1024, scr, r, lane, [](int n) { return n; }); continue; } r -= I_O;
            if (r < I_1) { transpose_item(INP(I_WFF1), 1024, 4096, Wff1T, 4096, scr, r, lane, [](int n) { return n; }); continue; } r -= I_1;
            if (r < I_2) { transpose_item(INP(I_WFF2), 4096, 1024, Wff2T, 1024, scr, r, lane, [](int n) { return n; }); continue; } r -= I_2;
            if (r < I_PG) { transpose_item(INP(I_WPG), 1024, 1024, WpgT, 1024, scr, r, lane, [](int n) { return n; }); continue; } r -= I_PG;
            transpose_item(INP(I_WPP), 256, 1024, WppT, 1024, scr, r, lane, [](int n) { return n; });
        }
        { const f32x4* xs = (const f32x4*)x; u32x4* xd = (u32x4*)XB;
            for (int i = gt; i < M * D / 8; i += 4 * NGT) { f32x4 a[4], b[4];
#pragma unroll
                for (int k = 0; k < 4; ++k) { a[k] = xs[2 * (i + k * NGT)]; b[k] = xs[2 * (i + k * NGT) + 1]; }
#pragma unroll
                for (int k = 0; k < 4; ++k) { u32x4 o; o.x = pk2(a[k][0], a[k][1]); o.y = pk2(a[k][2], a[k][3]); o.z = pk2(b[k][0], b[k][1]); o.w = pk2(b[k][2], b[k][3]); xd[i + k * NGT] = o; } } }
        { const f32x4* ps = (const f32x4*)INP(I_P); u32x4* pd = (u32x4*)PB;
            for (int i = gt; i < M * PLE / 8; i += 4 * NGT) { f32x4 a[4], b[4];
#pragma unroll
                for (int k = 0; k < 4; ++k) { a[k] = ps[2 * (i + k * NGT)]; b[k] = ps[2 * (i + k * NGT) + 1]; }
#pragma unroll
                for (int k = 0; k < 4; ++k) { u32x4 o; o.x = pk2(a[k][0], a[k][1]); o.y = pk2(a[k][2], a[k][3]); o.z = pk2(b[k][0], b[k][1]); o.w = pk2(b[k][2], b[k][3]); pd[i + k * NGT] = o; } } }
        { const int* pos = (const int*)INP(I_POS);
            for (int i = gt; i < M * 32; i += NGT) { const int m = i >> 5, f = i & 31; const double a = (double)pos[m] * INVF[f] * 0.15915494309189535;
                const float rev = (float)(a - floor(a)); COS[i] = __builtin_amdgcn_cosf(rev); SIN[i] = __builtin_amdgcn_sinf(rev); } }
    }
    SEAM(0);
#ifndef REP1
#define REP1 1
#endif
    if (IN(1)) for (int r1_ = 0; r1_ < REP1; ++r1_) { PHASE_PTRS();
        int Kv = D; LAUNDER_I(Kv); pg8::Gemm gm{XB, WinT, M, NWIN, Kv}; pg8::StaticOrder S; S.init(M, NWIN, G, bx);
        EpiWin E{QA, QI, KA, KI, VAT, MLQK, MLV, MLO, WI, IG, LF, COS, SIN, INP(I_BIG), INP(I_BFG)};
        pg8::gemm_phase<EpiWin, pg8::StaticOrder, true, true>(lds, gm, S, E);
    }
    SEAM(1);
    if (IN(2)) { PHASE_PTRS();
#ifdef NO_MIXA
        for (int i = gt; i < M * 512 / 8; i += NGT) ((u32x4*)YA)[i] = (u32x4){0u, 0u, 0u, 0u};
#else
        for (int pr = bx; pr < NB * 64; pr += G) { const int b = pr >> 6, j = pr & 63;
            mixa_unit<7>(QI, KI, WI, QA, YA, KA, VAT, lds, b, 127 - j);
            mixa_unit<7>(QI, KI, WI, QA, YA, KA, VAT, lds, b, j); }
#endif
#ifdef DUPMIXA
        for (int pr = bx; pr < NB * 64; pr += G) { const int b = pr >> 6, j = pr & 63;
            mixa_unit<DUPMIXA>(QI, KI, WI, QA, YA, KA, VAT, lds, b, 127 - j);
            mixa_unit<DUPMIXA>(QI, KI, WI, QA, YA, KA, VAT, lds, b, j); }
#endif
        for (int u = bx; u < 2048; u += G) m1_unit(MLQK, MLV, IG, LF, INP(I_CONVW), INP(I_CONVB), QC, DC, DN, BCUM, CS, lds, u);
    }
    SEAM(2);
#ifndef REP3
#define REP3 1
#endif
    if (IN(3)) for (int r3_ = 0; r3_ < REP3; ++r3_) { PHASE_PTRS();
        for (int item = gt; item < 64 * 2048; item += NGT) { const int bh = item >> 11, rem = item & 2047;
            float st[8] = {0.f, 0.f, 0.f, 0.f, 0.f, 0.f, 0.f, 0.f}; float m = 0.f;
            const bf16* src = DC + (size_t)(bh * 32) * 16384 + rem * 8; bf16* dst = CST + (size_t)(bh * 32) * 16384 + rem * 8;
#pragma unroll 1
            for (int c0 = 0; c0 < 32; c0 += 8) { u32x4 dv[8]; float bl[8], mg[8];
#pragma unroll
                for (int k = 0; k < 8; ++k) { dv[k] = *(const u32x4*)(src + (size_t)(c0 + k) * 16384); bl[k] = CS[(bh * 32 + c0 + k) * 2]; mg[k] = CS[(bh * 32 + c0 + k) * 2 + 1]; }
#pragma unroll
                for (int k = 0; k < 8; ++k) { const float mn = fmaxf(bl[k] + m, mg[k]), a = __expf(bl[k] + m - mn), sg = __expf(mg[k] - mn); m = mn; const u32x4 d = dv[k];
                    u32x4 o; o.x = pk2(st[0], st[1]); o.y = pk2(st[2], st[3]); o.z = pk2(st[4], st[5]); o.w = pk2(st[6], st[7]); *(u32x4*)(dst + (size_t)(c0 + k) * 16384) = o;
                    st[0] = a * st[0] + sg * bflo(d.x); st[1] = a * st[1] + sg * bfhi(d.x); st[2] = a * st[2] + sg * bflo(d.y); st[3] = a * st[3] + sg * bfhi(d.y);
                    st[4] = a * st[4] + sg * bflo(d.z); st[5] = a * st[5] + sg * bfhi(d.z); st[6] = a * st[6] + sg * bflo(d.w); st[7] = a * st[7] + sg * bfhi(d.w); } } }
        for (int item = gt; item < 64 * 128; item += NGT) { const int bh = item >> 7, dd = item & 127; float st = 0.f, m = 0.f;
            for (int c = 0; c < 32; ++c) { const float bl = CS[(bh * 32 + c) * 2], mg = CS[(bh * 32 + c) * 2 + 1];
                if (dd == 0) MST[bh * 32 + c] = m;
                const float mn = fmaxf(bl + m, mg), a = __expf(bl + m - mn), s = __expf(mg - mn); m = mn;
                const float d = DN[(size_t)(bh * 32 + c) * 128 + dd]; NST[(size_t)(bh * 32 + c) * 128 + dd] = st; st = a * st + s * d; } }
    }
    SEAM(3);
#ifndef REP4
#define REP4 1
#endif
    if (IN(4)) for (int r4_ = 0; r4_ < REP4; ++r4_) { PHASE_PTRS();
        for (int u = bx; u < 2048; u += G) m3_unit(QC, MLV, QI  , MLO, IG, BCUM, MST, CST, NST, INP(I_MLNG), lds, u);
    }
    SEAM(4);
#ifndef REP5
#define REP5 1
#endif
    if (IN(5)) for (int r5_ = 0; r5_ < REP5; ++r5_) { PHASE_PTRS();
        pg8::StaticOrder S; S.init(M, D, G, bx);
        { int Kv = D; LAUNDER_I(Kv); pg8::Gemm gm{XB, WgaT, M, D, Kv}; EpiB<0> E{TMP, nullptr, nullptr, nullptr, D}; pg8::gemm_phase<EpiB<0>, pg8::StaticOrder, true, true>(lds, gm, S, E); }
        { int Kv = 512; LAUNDER_I(Kv); pg8::Gemm gm{YA, WuaT, M, D, Kv}; EpiB<1> E{nullptr, OUT, TMP, nullptr, D}; pg8::gemm_phase<EpiB<1>, pg8::StaticOrder, true, true>(lds, gm, S, E); }
        { int Kv = D; LAUNDER_I(Kv); pg8::Gemm gm{XB, WgbT, M, D, Kv}; EpiB<0> E{TMP, nullptr, nullptr, nullptr, D}; pg8::gemm_phase<EpiB<0>, pg8::StaticOrder, true, true>(lds, gm, S, E); }
        { int Kv = 512; LAUNDER_I(Kv); pg8::Gemm gm{QI, WubT, M, D, Kv}; EpiB<2> E{MRG, nullptr, TMP, OUT, D}; pg8::gemm_phase<EpiB<2>, pg8::StaticOrder, true, true>(lds, gm, S, E); }
    }
    SEAM(5);
#ifndef REP6
#define REP6 1
#endif
    if (IN(6)) for (int r6_ = 0; r6_ < REP6; ++r6_) { PHASE_PTRS();
        pg8::StaticOrder S; S.init(M, D, G, bx);
        int Kv = D; LAUNDER_I(Kv); pg8::Gemm gm{MRG, WoutT, M, D, Kv}; EpiF<0> E{OUT, nullptr, INP(I_X), nullptr, D}; pg8::gemm_phase<EpiF<0>, pg8::StaticOrder, true, true>(lds, gm, S, E);
    }
    SEAM(6);
#ifndef REP7
#define REP7 1
#endif
    if (IN(7)) for (int r7_ = 0; r7_ < REP7; ++r7_) { PHASE_PTRS(); for (int m = gw; m < M / 2; m += NGW) ln_row2<true>(OUT + (size_t)m * D, OUT + (size_t)(m + M / 2) * D, INP(I_LN1G), INP(I_LN1B), nullptr, nullptr, H1 + (size_t)m * D, H1 + (size_t)(m + M / 2) * D, lane); }
    SEAM(7);
    if (IN(8)) { PHASE_PTRS();
        pg8::StaticOrder S; S.init(M, FF, G, bx);
        int Kv = D; LAUNDER_I(Kv); pg8::Gemm gm{H1, Wff1T, M, FF, Kv}; EpiB<3> E{HF, nullptr, nullptr, nullptr, FF}; pg8::gemm_phase<EpiB<3>, pg8::StaticOrder, true, true>(lds, gm, S, E);
    }
#ifdef DUP89
    SEAM(8);
    if (IN(8) && true) { PHASE_PTRS();
        pg8::StaticOrder S; S.init(M, FF, G, bx);
        int Kv = D; LAUNDER_I(Kv); pg8::Gemm gm{H1, Wff1T, M, FF, Kv}; EpiB<3> E{HF, nullptr, nullptr, nullptr, FF}; pg8::gemm_phase<EpiB<3>, pg8::StaticOrder, true, true>(lds, gm, S, E);
    }
#endif
    SEAM(8);
    if (IN(9)) { PHASE_PTRS();
        pg8::StaticOrder S; S.init(M, D, G, bx);
        int Kv = FF; LAUNDER_I(Kv); pg8::Gemm gm{HF, Wff2T, M, D, Kv}; EpiF<1> E{OUT, RB, nullptr, H1, D}; pg8::gemm_phase<EpiF<1>, pg8::StaticOrder, true, true>(lds, gm, S, E);
    }
#ifdef DUP89
    SEAM(9);
    if (IN(9) && true) { PHASE_PTRS();
        pg8::StaticOrder S; S.init(M, D, G, bx);
        int Kv = FF; LAUNDER_I(Kv); pg8::Gemm gm{HF, Wff2T, M, D, Kv}; EpiF<1> E{OUT, RB, nullptr, H1, D}; pg8::gemm_phase<EpiF<1>, pg8::StaticOrder, true, true>(lds, gm, S, E);
    }
#endif
    SEAM(9);
    if (IN(10)) { PHASE_PTRS();
        pg8::StaticOrder S; S.init(M, D, G, bx);
#if !defined(P10_ONLY) || P10_ONLY == 1
        { int Kv = PLE; LAUNDER_I(Kv); pg8::Gemm gm{PB, WppT, M, D, Kv}; EpiF<2> E{PROJ, nullptr, nullptr, nullptr, D}; pg8::gemm_phase<EpiF<2>, pg8::StaticOrder, true, true>(lds, gm, S, E); }
#endif
#if !defined(P10_ONLY) || P10_ONLY == 2
        { int Kv = D; LAUNDER_I(Kv); pg8::Gemm gm{RB, WpgT, M, D, Kv}; EpiF<3> E{OUT, nullptr, PROJ, nullptr, D}; pg8::gemm_phase<EpiF<3>, pg8::StaticOrder, true, true>(lds, gm, S, E); }
#endif
    }
    SEAM(10);
    if (IN(11)) { PHASE_PTRS(); for (int m = gw; m < M / 2; m += NGW) ln_row2<false>(OUT + (size_t)m * D, OUT + (size_t)(m + M / 2) * D, INP(I_LN2G), INP(I_LN2B), OUT + (size_t)m * D, OUT + (size_t)(m + M / 2) * D, nullptr, nullptr, lane); }
#undef IN
#undef SEAM
}

extern "C" void kernel_launch(void* const* d_in, const int* in_sizes, int n_in, void* d_out, int out_size, void* d_ws, size_t ws_size, hipStream_t stream) {
    static int grid = 0;
    if (grid == 0) {
        if (n_in != 20 || out_size != M * D || ws_size < WS_END) { fprintf(stderr, "kernel_launch: unexpected problem shape (n_in %d, out %d, ws %zu)\n", n_in, out_size, ws_size); grid = -1; return; }
        int dev = 0, cus = 0, per_cu = 0;
        hipGetDevice(&dev); hipDeviceGetAttribute(&cus, hipDeviceAttributeMultiprocessorCount, dev);
        if (hipFuncSetAttribute((const void*)fwd_kernel, hipFuncAttributeMaxDynamicSharedMemorySize, LDS_BYTES) != hipSuccess) { fprintf(stderr, "kernel_launch: hipFuncSetAttribute failed\n"); grid = -1; return; }
        if (hipOccupancyMaxActiveBlocksPerMultiprocessor(&per_cu, (const void*)fwd_kernel, NTHR, LDS_BYTES) != hipSuccess || per_cu < 1) { fprintf(stderr, "kernel_launch: occupancy query says %d\n", per_cu); per_cu = 1; }
        (void)hipGetLastError();
        grid = cus * (per_cu > 1 ? 1 : per_cu);
        if (grid <= 0) { grid = -1; return; }
    }
    if (grid < 0) return;
    if (hipMemsetAsync(d_ws, 0, 16384, stream) != hipSuccess) { fprintf(stderr, "kernel_launch: memset failed\n"); return; }
    Args a{};
    for (int i = 0; i < 20; ++i) a.in[i] = (const float*)d_in[i];
    a.out = (float*)d_out; a.ws = (unsigned char*)d_ws;
#if MK_ONE
    a.ph_lo = 0; a.ph_hi = NPHASE;
    void* params[] = {&a};
    hipError_t e = hipLaunchCooperativeKernel((const void*)fwd_kernel, dim3(grid), dim3(NTHR), params, LDS_BYTES, stream);
    if (e != hipSuccess) fprintf(stderr, "cooperative launch failed: %s (grid %d)\n", hipGetErrorString(e), grid);
#else
    for (int ph = 0; ph < NPHASE; ++ph) { a.ph_lo = ph; a.ph_hi = ph + 1; hipLaunchKernelGGL(fwd_kernel, dim3(grid), dim3(NTHR), LDS_BYTES, stream, a); }
#endif
}
```

```cpp
#include <hip/hip_runtime.h>
#include <hip/hip_cooperative_groups.h>
#include <cstdio>
#include <cstdint>
namespace cg = cooperative_groups;
#define MK_ONE 1
namespace pg8 {
#define PG8_LAS __attribute__((address_space(3)))
typedef unsigned short bf16_t;
typedef short bf16x8 __attribute__((ext_vector_type(8)));
typedef float f32x4 __attribute__((ext_vector_type(4)));
typedef unsigned u32x4 __attribute__((ext_vector_type(4)));
constexpr int BM = 256, BK = 64, HALF = 128, HTB = HALF * BK * 2  , STAGE_BYTES = 8 * HTB, NXCD = 8, WGM = 8;

__host__ __device__ __forceinline__ int lds_byte(int r, int c) { const int st = (r >> 4) * 2 + (c >> 5), rr = r & 15, cc = c & 31, ob = rr * 64 + cc * 2; return st * 1024 + (ob ^ (((ob >> 9) & 1) << 5)); }
__host__ __device__ __forceinline__ void stage_rc(int b, int& R, int& C) { const int st = b / 1024, sb = b % 1024, swz = sb ^ (((sb >> 9) & 1) << 5); R = (st >> 1) * 16 + swz / 64; C = (st & 1) * 32 + (swz % 64) / 2; }
__host__ __device__ __forceinline__ int perm32(int rho) { const int n = rho >> 4, i = rho & 15; return 8 * (i >> 2) + 4 * n + (i & 3); }

struct Unit { int pm, pn; };
struct Gemm { const bf16_t* A; const bf16_t* Bt; int M, N, K; };

struct StaticOrder {
    int nM, nN, nwg, G, c;
    __host__ __device__ void init(int M, int N, int G_, int c_) { nM = M / BM; nN = N / BM; nwg = nM * nN; G = G_; c = c_; }
    __host__ __device__ bool next(int i, Unit& u) const {
        const long L = (long)i * G + c; if (L >= nwg) return false;
        int wgid = (int)L; { const int q = nwg / NXCD, r = nwg % NXCD, xcd = wgid % NXCD, off = wgid / NXCD; wgid = (xcd < r ? xcd * (q + 1) : r * (q + 1) + (xcd - r) * q) + off; }
        const int nig = WGM * nN, gid = wgid / nig, fm = gid * WGM, gsz = (nM - fm) < WGM ? (nM - fm) : WGM;
        u.pm = fm + ((wgid % nig) % gsz); u.pn = (wgid % nig) / gsz; return true;
    }
    __device__ __forceinline__ void a_ready(const Unit&) const {}
    __device__ __forceinline__ void done(const Unit&) const {}
};

__device__ __forceinline__ unsigned cvt_pk_bf16(float lo, float hi) { unsigned r; asm volatile("v_cvt_pk_bf16_f32 %0, %1, %2" : "=v"(r) : "v"(lo), "v"(hi)); return r; }
template <class Epi, class Sched, bool ALIGN_EPI = false, bool SP2 = false>
__device__ __forceinline__ void gemm_phase(PG8_LAS unsigned char* lds, const Gemm g, const Sched& S, const Epi& E) {
    const int tid = threadIdx.x, wid = __builtin_amdgcn_readfirstlane(tid >> 6), lane = tid & 63, wr = wid >> 2, wc = wid & 3, fr = lane & 15, fq = lane >> 4;
    const int K = g.K, nt = K / BK;
    unsigned voffA[2], voffB[2];
#pragma unroll
    for (int i = 0; i < 2; ++i) { int R, C; stage_rc(tid * 16 + i * 8192, R, C); const int Rb = Epi::PERM ? ((R & ~31) + perm32(R & 31)) : R;
        voffA[i] = (unsigned)(R * K + C) * 2u; voffB[i] = (unsigned)(Rb * K + C) * 2u; }
    const size_t kstep = (size_t)(BK * 2);
    const size_t hstep = (size_t)HALF * K * 2;
    const size_t tstep = 2 * hstep;
    const unsigned ldsw = (unsigned)wid * 1024u;
    const int aoff = lds_byte(wr * 64 + fr, fq * 8), boff = lds_byte(wc * 32 + fr, fq * 8);
#define PG8_SA(b, h) (((b) * 2 + (h)) * HTB)
#define PG8_SB(b, h) ((4 + (b) * 2 + (h)) * HTB)
#define PG8_STAGE(bufoff, gbase, voff) do { _Pragma("unroll") for (int _i = 0; _i < 2; ++_i) \
        __builtin_amdgcn_global_load_lds((const unsigned*)((const char*)(gbase) + (voff)[_i]), (PG8_LAS unsigned*)(lds + (bufoff) + ldsw + _i * 8192), 16, 0, 0); } while (0)
#define PG8_LDA(dst, b, h) do { _Pragma("unroll") for (int m = 0; m < 4; ++m) _Pragma("unroll") for (int k = 0; k < 2; ++k) dst[m][k] = *(const PG8_LAS bf16x8*)(lds + PG8_SA(b, h) + aoff + m * 2048 + k * 1024); } while (0)
#define PG8_LDB(dst, b, h) do { _Pragma("unroll") for (int n = 0; n < 2; ++n) _Pragma("unroll") for (int k = 0; k < 2; ++k) dst[n][k] = *(const PG8_LAS bf16x8*)(lds + PG8_SB(b, h) + boff + n * 2048 + k * 1024); } while (0)
#define PG8_MMA(ai, bj, At, Bt) do { __builtin_amdgcn_s_setprio(1); _Pragma("unroll") for (int m = 0; m < 4; ++m) _Pragma("unroll") for (int n = 0; n < 2; ++n) _Pragma("unroll") for (int k = 0; k < 2; ++k) \
        acc[ai][bj][m][n] = __builtin_amdgcn_mfma_f32_16x16x32_bf16(Bt[n][k], At[m][k], acc[ai][bj][m][n], 0, 0, 0); __builtin_amdgcn_s_setprio(0); } while (0)
#define PG8_WAIT_V(n) asm volatile("s_waitcnt vmcnt(" #n ")" ::: "memory")
#define PG8_WAIT_L(n) asm volatile("s_waitcnt lgkmcnt(" #n ")" ::: "memory")
#define PG8_BAR __builtin_amdgcn_s_barrier()
#define PG8_SCHED __builtin_amdgcn_sched_barrier(0)
    Unit cur, nxt; int ui = 0;
    if (!S.next(0, cur)) return;
    f32x4 acc[2][2][4][2];
#pragma unroll
    for (int a = 0; a < 2; ++a)
#pragma unroll
        for (int b = 0; b < 2; ++b)
#pragma unroll
            for (int m = 0; m < 4; ++m)
#pragma unroll
                for (int n = 0; n < 2; ++n) acc[a][b][m][n] = (f32x4){0.f, 0.f, 0.f, 0.f};
    bf16x8 At[4][2], B0[2][2], B1[2][2];
    const char* cA = (const char*)g.A + (size_t)cur.pm * tstep; const char* cB = (const char*)g.Bt + (size_t)cur.pn * tstep;
    S.a_ready(cur);
    if constexpr (SP2) {
        PG8_STAGE(PG8_SB(0, 0), cB, voffB); PG8_STAGE(PG8_SB(0, 1), cB + hstep, voffB); PG8_STAGE(PG8_SA(0, 0), cA, voffA); PG8_STAGE(PG8_SA(0, 1), cA + hstep, voffA);
        if (wr == 1) PG8_BAR;
        PG8_WAIT_V(2); PG8_BAR;
        PG8_STAGE(PG8_SB(1, 0), cB + kstep, voffB); PG8_STAGE(PG8_SA(1, 0), cA + kstep, voffA); PG8_STAGE(PG8_SB(1, 1), cB + hstep + kstep, voffB);
        PG8_WAIT_V(6); PG8_BAR;
    } else {
        PG8_STAGE(PG8_SB(0, 0), cB, voffB); PG8_STAGE(PG8_SA(0, 0), cA, voffA); PG8_STAGE(PG8_SB(0, 1), cB + hstep, voffB); PG8_STAGE(PG8_SA(0, 1), cA + hstep, voffA);
        if (wr == 1) PG8_BAR;
        PG8_WAIT_V(4); PG8_BAR;
        PG8_STAGE(PG8_SB(1, 0), cB + kstep, voffB); PG8_STAGE(PG8_SA(1, 0), cA + kstep, voffA); PG8_STAGE(PG8_SB(1, 1), cB + hstep + kstep, voffB);
        PG8_WAIT_V(6); PG8_BAR;
    }
    for (;;) {
        const bool has_next = S.next(ui + 1, nxt);
        const char* nA = has_next ? (const char*)g.A + (size_t)nxt.pm * tstep : cA; const char* nB = has_next ? (const char*)g.Bt + (size_t)nxt.pn * tstep : cB;
        for (int t = 0; t < nt; t += 2) {
            const bool last = (t == nt - 2);
            const char* a1 = cA + (size_t)(t + 1) * kstep;
            const char* a2 = last ? nA : cA + (size_t)(t + 2) * kstep; const char* b2 = last ? nB : cB + (size_t)(t + 2) * kstep;
            const char* a3 = a2 + kstep; const char* b3 = b2 + kstep;
            if (last && has_next) S.a_ready(nxt);
            if constexpr (SP2) {
            PG8_LDB(B0, 0, 0); PG8_LDB(B1, 0, 1); PG8_SCHED; PG8_LDA(At, 0, 0); PG8_STAGE(PG8_SA(1, 1), a1 + hstep, voffA);
            PG8_WAIT_V(8); PG8_WAIT_L(0); PG8_BAR; PG8_MMA(0, 0, At, B0); PG8_MMA(0, 1, At, B1); PG8_BAR; PG8_SCHED;
            PG8_LDA(At, 0, 1); PG8_STAGE(PG8_SB(0, 0), b2, voffB); PG8_STAGE(PG8_SB(0, 1), b2 + hstep, voffB); PG8_STAGE(PG8_SA(0, 0), a2, voffA);
            PG8_WAIT_V(8); PG8_WAIT_L(0); PG8_BAR; PG8_MMA(1, 0, At, B0); PG8_MMA(1, 1, At, B1); PG8_BAR; PG8_SCHED;
            PG8_LDB(B0, 1, 0); PG8_LDB(B1, 1, 1); PG8_SCHED; PG8_LDA(At, 1, 0); PG8_STAGE(PG8_SA(0, 1), a2 + hstep, voffA);
            PG8_WAIT_V(8); PG8_WAIT_L(0); PG8_BAR; PG8_MMA(0, 0, At, B0); PG8_MMA(0, 1, At, B1); PG8_BAR; PG8_SCHED;
            PG8_LDA(At, 1, 1); PG8_STAGE(PG8_SB(1, 0), b3, voffB); PG8_STAGE(PG8_SB(1, 1), b3 + hstep, voffB); PG8_STAGE(PG8_SA(1, 0), a3, voffA);
            PG8_WAIT_V(8); PG8_WAIT_L(0); PG8_BAR; PG8_MMA(1, 0, At, B0); PG8_MMA(1, 1, At, B1); PG8_BAR; PG8_SCHED;
            } else {
            PG8_LDB(B0, 0, 0); PG8_SCHED; PG8_LDA(At, 0, 0); PG8_STAGE(PG8_SA(1, 1), a1 + hstep, voffA);
            PG8_WAIT_L(8); PG8_BAR; PG8_WAIT_L(0); PG8_MMA(0, 0, At, B0); PG8_BAR; PG8_SCHED;
            PG8_LDB(B1, 0, 1); PG8_STAGE(PG8_SB(0, 0), b2, voffB);
            PG8_BAR; PG8_WAIT_L(0); PG8_MMA(0, 1, At, B1); PG8_BAR;
            PG8_LDA(At, 0, 1); PG8_STAGE(PG8_SA(0, 0), a2, voffA);
            PG8_BAR; PG8_WAIT_L(0); PG8_MMA(1, 0, At, B0); PG8_BAR; PG8_SCHED;
            PG8_STAGE(PG8_SB(0, 1), b2 + hstep, voffB);
            PG8_WAIT_V(6); PG8_BAR; PG8_MMA(1, 1, At, B1); PG8_BAR;
            PG8_LDB(B0, 1, 0); PG8_SCHED; PG8_LDA(At, 1, 0); PG8_STAGE(PG8_SA(0, 1), a2 + hstep, voffA);
            PG8_WAIT_L(8); PG8_BAR; PG8_WAIT_L(0); PG8_MMA(0, 0, At, B0); PG8_BAR; PG8_SCHED;
            PG8_LDB(B1, 1, 1); PG8_STAGE(PG8_SB(1, 0), b3, voffB);
            PG8_BAR; PG8_WAIT_L(0); PG8_MMA(0, 1, At, B1); PG8_BAR;
            PG8_LDA(At, 1, 1); PG8_STAGE(PG8_SA(1, 0), a3, voffA);
            PG8_BAR; PG8_WAIT_L(0); PG8_MMA(1, 0, At, B0); PG8_BAR; PG8_SCHED;
            PG8_STAGE(PG8_SB(1, 1), b3 + hstep, voffB);
            PG8_WAIT_V(6); PG8_BAR; PG8_MMA(1, 1, At, B1); PG8_BAR;
            }
        }
        if constexpr (ALIGN_EPI) { if (wr == 0) PG8_BAR; }
        if constexpr (!Epi::AFTER_DRAIN) { E(acc, cur, wr, wc, fr, fq); S.done(cur); }
        if (!has_next) break;
#pragma unroll
        for (int a = 0; a < 2; ++a)
#pragma unroll
            for (int b = 0; b < 2; ++b)
#pragma unroll
                for (int m = 0; m < 4; ++m)
#pragma unroll
                    for (int n = 0; n < 2; ++n) acc[a][b][m][n] = (f32x4){0.f, 0.f, 0.f, 0.f};
        cur = nxt; cA = nA; cB = nB; ++ui;
        if constexpr (ALIGN_EPI) { if (wr == 1) PG8_BAR; }
    }
    PG8_WAIT_V(0);
    if constexpr (!ALIGN_EPI) { if (wr == 0) PG8_BAR; }
    PG8_BAR;
    if constexpr (Epi::AFTER_DRAIN) { E.fused(acc, cur, wr, wc, fr, fq, lds, wid, lane); S.done(cur); }
#undef PG8_SA
#undef PG8_SB
#undef PG8_STAGE
#undef PG8_LDA
#undef PG8_LDB
#undef PG8_MMA
#undef PG8_WAIT_V
#undef PG8_WAIT_L
#undef PG8_BAR
#undef PG8_SCHED
}
}

#ifndef PG8_ALIGN_EPI
#define PG8_ALIGN_EPI true
#endif
#ifndef MK_ONE
#define MK_ONE 1
#endif
#define GAS __attribute__((address_space(1)))
#define LAS __attribute__((address_space(3)))
typedef unsigned short bf16;
typedef short bf16x8 __attribute__((ext_vector_type(8)));
typedef float f32x4 __attribute__((ext_vector_type(4)));
typedef unsigned u32x4 __attribute__((ext_vector_type(4)));
typedef unsigned u32x2 __attribute__((ext_vector_type(2)));

constexpr int NWAVES = 8, NTHR = 512;
constexpr int M = 32768, SEQ = 2048, NB = 16, D = 1024, FF = 4096, PLE = 256;
constexpr int NWIN = 3328, WIN_LD = 5328;
constexpr float LN_EPS = 1e-5f;
constexpr float ALPHA = 1.189207115002721f;
constexpr float IDX_W_SCALE = 0.04419417382415922f;
constexpr float QA_SCALE = 0.125f * 1.4426950408889634f;
constexpr float MLK_SCALE = 0.08838834764831845f;
constexpr int LDS_BYTES = 147456;
constexpr int NPHASE = 12;

constexpr size_t MiB = 1u << 20;
constexpr size_t WS_WIN = 1 * MiB, WS_WGA = 8 * MiB, WS_WGB = 10 * MiB, WS_WUA = 12 * MiB, WS_WUB = 13 * MiB, WS_WOUT = 14 * MiB,
                 WS_WFF1 = 16 * MiB, WS_WFF2 = 24 * MiB, WS_WPG = 32 * MiB, WS_WPP = 34 * MiB;
constexpr size_t WS_COS = 35 * MiB, WS_SIN = 39 * MiB, WS_WI = 43 * MiB, WS_IG = 44 * MiB, WS_LF = 44 * MiB + 512 * 1024;
constexpr size_t WS_KA = 45 * MiB, WS_KI = 49 * MiB, WS_VAT = 53 * MiB;
constexpr size_t WS_BCUM = 57 * MiB, WS_CS = 58 * MiB, WS_MST = 59 * MiB, WS_DN = 60 * MiB, WS_NST = 61 * MiB, WS_CST = 208 * MiB;
constexpr size_t WS_XB = 64 * MiB, WS_PB = 128 * MiB, WS_QA = 144 * MiB, WS_QI = 176 * MiB, WS_MLQK = 208 * MiB, WS_MLV = 272 * MiB,
                 WS_MLO = 304 * MiB, WS_QC = 336 * MiB, WS_DC = 400 * MiB, WS_YA = 464 * MiB, WS_END = 496 * MiB;
constexpr size_t WS_TMP = 336 * MiB, WS_MRG = 400 * MiB, WS_H1 = 64 * MiB, WS_HF = 144 * MiB, WS_RB = 400 * MiB, WS_PROJ = 144 * MiB;

__device__ __forceinline__ unsigned f2bf(float f) { unsigned u = __builtin_bit_cast(unsigned, f); return (u + 0x7fffu + ((u >> 16) & 1u)) >> 16; }
typedef float f32x2_t __attribute__((ext_vector_type(2)));
typedef __bf16 bf16x2_t __attribute__((ext_vector_type(2)));
__device__ __forceinline__ unsigned pk2(float lo, float hi) { f32x2_t v = {lo, hi}; bf16x2_t b = __builtin_convertvector(v, bf16x2_t); return __builtin_bit_cast(unsigned, b); }
__device__ __forceinline__ float bflo(unsigned w) { return __builtin_bit_cast(float, w << 16); }
__device__ __forceinline__ float bfhi(unsigned w) { return __builtin_bit_cast(float, w & 0xffff0000u); }
__device__ __forceinline__ float sigmoidf_(float x) { return __builtin_amdgcn_rcpf(1.0f + __expf(-x)); }
#define LDS_WAIT() asm volatile("s_waitcnt lgkmcnt(0)" ::: "memory")

__constant__ double INVF[32] = {1.0, 0.7498942093324559, 0.5623413251903491, 0.4216965034285822, 0.31622776601683794, 0.23713737056616552, 0.1778279410038923, 0.1333521432163324,
    0.1, 0.07498942093324558, 0.05623413251903491, 0.042169650342858224, 0.03162277660168379, 0.023713737056616554, 0.01778279410038923, 0.01333521432163324,
    0.01, 0.007498942093324558, 0.005623413251903491, 0.004216965034285823, 0.0031622776601683794, 0.0023713737056616554, 0.0017782794100389228, 0.001333521432163324,
    0.001, 0.0007498942093324559, 0.0005623413251903491, 0.00042169650342858224, 0.00031622776601683794, 0.00023713737056616554, 0.00017782794100389227, 0.0001333521432163324};

struct Args {
    const float* in[20]; float* out; unsigned char* ws; int ph_lo, ph_hi;
};
enum { I_X = 0, I_P, I_POS, I_WIN, I_CONVW, I_CONVB, I_BIG, I_BFG, I_MLNG, I_WUA, I_WUB, I_WOUT, I_LN1G, I_LN1B, I_WFF1, I_WFF2, I_WPG, I_WPP, I_LN2G, I_LN2B };

__device__ __forceinline__ int win_src(int n) {
    if (n < 512) { const int hh = n >> 6, j = n & 63; return hh * 64 + (j >> 1) + 32 * (j & 1); }
    if (n < 1024) { const int mm = n - 512, hh = mm >> 6, j = mm & 63; return 640 + hh * 64 + (j >> 1) + 32 * (j & 1); }
    if (n < 1280) { const int mm = n - 1024;
        if (mm < 64) return 512 + (mm >> 1) + 32 * (mm & 1);
        if (mm < 128) { const int j = mm - 64; return 1152 + (j >> 1) + 32 * (j & 1); }
        if (mm < 192) return 576 + (mm - 128);
        if (mm < 200) return 1216 + (mm - 192);
        if (mm < 204) return 2760 + (mm - 200);
        if (mm < 208) return 2764 + (mm - 204);
        return -1; }
    if (n < 2304) return 1224 + (n - 1280);
    if (n < 2816) return 2248 + (n - 2304);
    return 2768 + (n - 2816);
}

template <class SrcF>
__device__ __forceinline__ void transpose_item(const float* W, int K, int ldw, bf16* WT, int Nrows, LAS float* scr, int item, int lane, SrcF src) {
    const int nblk = Nrows / 32, kb = item / nblk, nb = item % nblk, k0 = 64 * kb, n0 = 32 * nb;
    const int sc = src(n0 + (lane & 31));
#pragma unroll 8
    for (int i = 0; i < 32; ++i) { const int kk = 2 * i + (lane >> 5); scr[kk * 33 + (lane & 31)] = sc >= 0 ? W[(size_t)(k0 + kk) * ldw + sc] : 0.f; }
    LDS_WAIT(); asm volatile("" ::: "memory");
    const int c = lane & 7;
#pragma unroll
    for (int j = 0; j < 4; ++j) { const int n = (lane >> 3) + 8 * j; const LAS float* s = scr + (8 * c) * 33 + n;
        u32x4 o; o.x = pk2(s[0 * 33], s[1 * 33]); o.y = pk2(s[2 * 33], s[3 * 33]); o.z = pk2(s[4 * 33], s[5 * 33]); o.w = pk2(s[6 * 33], s[7 * 33]);
        *(u32x4*)(WT + (size_t)(n0 + n) * K + k0 + 8 * c) = o; }
    LDS_WAIT(); asm volatile("" ::: "memory");
}

struct EpiWin {
    static constexpr bool PERM = true, AFTER_DRAIN = false;
    bf16 *QA, *QI, *KA, *KI, *VAT, *MLQK, *MLV, *MLO; float *WI, *IG, *LF; const float *COS, *SIN, *b_ig, *b_fg;
    __device__ __forceinline__ void operator()(const f32x4 (&acc)[2][2][4][2], const pg8::Unit& u, int wr, int wc, int fr, int fq) const {
        const int pn = u.pn, row0 = u.pm * 256 + wr * 64 + fr;
#pragma unroll
        for (int ai = 0; ai < 2; ++ai)
#pragma unroll
            for (int m = 0; m < 4; ++m) { const int r = row0 + ai * 128 + m * 16;
#pragma unroll
                for (int bj = 0; bj < 2; ++bj) { const int cl = bj * 128 + wc * 32 + 8 * fq; f32x4 v0 = acc[ai][bj][m][0], v1 = acc[ai][bj][m][1];
                    const bool rope = (pn < 4) || (pn == 4 && cl < 128);
                    if (rope) {
                        const int i0 = (cl & 63) >> 1;
                        const f32x4 c = *(const f32x4*)(COS + (unsigned)r * 32 + i0), s = *(const f32x4*)(SIN + (unsigned)r * 32 + i0);
                        const float sc = (pn < 2) ? QA_SCALE : 1.0f;
                        f32x4 o0, o1;
                        o0[0] = (v0[0] * c[0] - v0[1] * s[0]) * sc; o0[1] = (v0[1] * c[0] + v0[0] * s[0]) * sc;
                        o0[2] = (v0[2] * c[1] - v0[3] * s[1]) * sc; o0[3] = (v0[3] * c[1] + v0[2] * s[1]) * sc;
                        o1[0] = (v1[0] * c[2] - v1[1] * s[2]) * sc; o1[1] = (v1[1] * c[2] + v1[0] * s[2]) * sc;
                        o1[2] = (v1[2] * c[3] - v1[3] * s[3]) * sc; o1[3] = (v1[3] * c[3] + v1[2] * s[3]) * sc;
                        bf16* dst;
                        if (pn < 2) dst = QA + (unsigned)r * 512 + pn * 256 + cl;
                        else if (pn < 4) dst = QI + (unsigned)r * 512 + (pn - 2) * 256 + cl;
                        else dst = (cl < 64) ? (KA + (unsigned)r * 64 + cl) : (KI + (unsigned)r * 64 + (cl - 64));
                        u32x4 w; w.x = pk2(o0[0], o0[1]); w.y = pk2(o0[2], o0[3]); w.z = pk2(o1[0], o1[1]); w.w = pk2(o1[2], o1[3]);
                        *(u32x4*)dst = w;
                    } else if (pn == 4) {
                        if (cl < 192) { const int d0 = cl - 128, b = r >> 11, t = r & 2047; bf16* base = VAT + ((unsigned)(b * 64 + d0)) * 2048 + t;
#pragma unroll
                            for (int j = 0; j < 4; ++j) { base[(unsigned)j * 2048] = (bf16)f2bf(v0[j]); base[(unsigned)(j + 4) * 2048] = (bf16)f2bf(v1[j]); } }
                        else if (cl == 192) { *(f32x4*)(WI + (unsigned)r * 8) = v0 * IDX_W_SCALE; *(f32x4*)(WI + (unsigned)r * 8 + 4) = v1 * IDX_W_SCALE; }
                        else if (cl == 200) { f32x4 ig, lf;
#pragma unroll
                            for (int j = 0; j < 4; ++j) { ig[j] = v0[j] + b_ig[j]; const float f = v1[j] + b_fg[j]; lf[j] = fminf(f, 0.f) - log1pf(__expf(-fabsf(f))); }
                            *(f32x4*)(IG + (unsigned)r * 4) = ig; *(f32x4*)(LF + (unsigned)r * 4) = lf; }
                    } else {
                        bf16* dst;
                        if (pn < 9) dst = MLQK + (unsigned)r * 1024 + (pn - 5) * 256 + cl;
                        else if (pn < 11) dst = MLV + (unsigned)r * 512 + (pn - 9) * 256 + cl;
                        else { dst = MLO + (unsigned)r * 512 + (pn - 11) * 256 + cl;
#pragma unroll
                            for (int j = 0; j < 4; ++j) { v0[j] = sigmoidf_(v0[j]); v1[j] = sigmoidf_(v1[j]); } }
                        u32x4 w; w.x = pk2(v0[0], v0[1]); w.y = pk2(v0[2], v0[3]); w.z = pk2(v1[0], v1[1]); w.w = pk2(v1[2], v1[3]);
                        *(u32x4*)dst = w;
                    }
                }
                asm volatile("" ::: "memory"); }
    }
};

template <int MODE> struct EpiB {
    static constexpr bool PERM = true, AFTER_DRAIN = false;
    bf16* O; float* OF; const bf16* IB; const float* IF; int ldc;
    __device__ __forceinline__ void operator()(const f32x4 (&acc)[2][2][4][2], const pg8::Unit& u, int wr, int wc, int fr, int fq) const {
        const int row0 = u.pm * 256 + wr * 64 + fr, col0 = u.pn * 256 + wc * 32 + 8 * fq;
#pragma unroll
        for (int ai = 0; ai < 2; ++ai)
#pragma unroll
            for (int m = 0; m < 4; ++m) { const unsigned ro = (unsigned)(row0 + ai * 128 + m * 16) * ldc + col0;
#pragma unroll
                for (int bj = 0; bj < 2; ++bj) { const unsigned off = ro + bj * 128; f32x4 v0 = acc[ai][bj][m][0], v1 = acc[ai][bj][m][1];
                    if (MODE == 0) {
#pragma unroll
                        for (int j = 0; j < 4; ++j) { v0[j] = sigmoidf_(v0[j]); v1[j] = sigmoidf_(v1[j]); }
                    } else if (MODE == 3) {
#pragma unroll
                        for (int j = 0; j < 4; ++j) { const float a = fmaxf(v0[j], 0.f), b = fmaxf(v1[j], 0.f); v0[j] = a * a; v1[j] = b * b; }
                    } else {
                        const u32x4 t = *(const u32x4*)(IB + off);
                        v0[0] *= bflo(t.x); v0[1] *= bfhi(t.x); v0[2] *= bflo(t.y); v0[3] *= bfhi(t.y);
                        v1[0] *= bflo(t.z); v1[1] *= bfhi(t.z); v1[2] *= bflo(t.w); v1[3] *= bfhi(t.w);
                        if (MODE == 2) { v0 += *(const f32x4*)(IF + off); v1 += *(const f32x4*)(IF + off + 4); }
                    }
                    if (MODE == 1) { *(f32x4*)(OF + off) = v0; *(f32x4*)(OF + off + 4) = v1; }
                    else { u32x4 w; w.x = pk2(v0[0], v0[1]); w.y = pk2(v0[2], v0[3]); w.z = pk2(v1[0], v1[1]); w.w = pk2(v1[2], v1[3]); *(u32x4*)(O + off) = w; }
                }
                if (MODE == 1 || MODE == 2) asm volatile("" ::: "memory"); }
    }
};
template <int MODE> struct EpiF {
    static constexpr bool PERM = false, AFTER_DRAIN = false;
    float* OF; bf16* O; const float* IF; const bf16* IB; int ldc;
    __device__ __forceinline__ void operator()(const f32x4 (&acc)[2][2][4][2], const pg8::Unit& u, int wr, int wc, int fr, int fq) const {
        const int row0 = u.pm * 256 + wr * 64 + fr, col0 = u.pn * 256 + wc * 32 + 4 * fq;
#pragma unroll
        for (int ai = 0; ai < 2; ++ai)
#pragma unroll
            for (int m = 0; m < 4; ++m) { const unsigned ro = (unsigned)(row0 + ai * 128 + m * 16) * ldc + col0;
#pragma unroll
                for (int bj = 0; bj < 2; ++bj)
#pragma unroll
                    for (int n = 0; n < 2; ++n) { const unsigned off = ro + bj * 128 + n * 16; f32x4 v = acc[ai][bj][m][n];
                        if (MODE == 0) { v += ALPHA * *(const f32x4*)(IF + off); *(f32x4*)(OF + off) = v; }
                        else if (MODE == 1) { const u32x2 t = *(const u32x2*)(IB + off);
                            v[0] += ALPHA * bflo(t.x); v[1] += ALPHA * bfhi(t.x); v[2] += ALPHA * bflo(t.y); v[3] += ALPHA * bfhi(t.y);
                            *(f32x4*)(OF + off) = v; u32x2 w; w.x = pk2(v[0], v[1]); w.y = pk2(v[2], v[3]); *(u32x2*)(O + off) = w; }
                        else if (MODE == 2) { *(f32x4*)(OF + off) = v; }
                        else { const f32x4 pr = *(const f32x4*)(IF + off); f32x4 r = *(const f32x4*)(OF + off);
#pragma unroll
                            for (int j = 0; j < 4; ++j) r[j] += sigmoidf_(v[j]) * pr[j];
                            *(f32x4*)(OF + off) = r; }
                    }
                if (MODE != 2) asm volatile("" ::: "memory"); }
    }
};

__device__ __forceinline__ float wave_sum(float v) {
#pragma unroll
    for (int o = 1; o < 64; o <<= 1) v += __shfl_xor(v, o);
    return v;
}
__device__ __forceinline__ float wave_max(float v) {
#pragma unroll
    for (int o = 1; o < 64; o <<= 1) v = fmaxf(v, __shfl_xor(v, o));
    return v;
}
#define MFMA16(a, b, c) __builtin_amdgcn_mfma_f32_16x16x32_bf16((a), (b), (c), 0, 0, 0)

template <bool TO_BF16>
__device__ __forceinline__ void ln_row2(const float* x0, const float* x1, const float* gam, const float* bet, float* of0, float* of1, bf16* ob0, bf16* ob1, int lane) {
    const f32x4* xr0 = (const f32x4*)x0 + lane; const f32x4* xr1 = (const f32x4*)x1 + lane;
    f32x4 v[4], u[4]; float s = 0.f, t = 0.f;
#pragma unroll
    for (int j = 0; j < 4; ++j) { v[j] = xr0[64 * j]; u[j] = xr1[64 * j]; }
#pragma unroll
    for (int j = 0; j < 4; ++j) { s += (v[j][0] + v[j][1]) + (v[j][2] + v[j][3]); t += (u[j][0] + u[j][1]) + (u[j][2] + u[j][3]); }
#pragma unroll
    for (int o = 1; o < 64; o <<= 1) { s += __shfl_xor(s, o); t += __shfl_xor(t, o); }
    const float mean0 = s * (1.f / 1024.f), mean1 = t * (1.f / 1024.f); float s2 = 0.f, t2 = 0.f;
#pragma unroll
    for (int j = 0; j < 4; ++j) { v[j] = v[j] - mean0; u[j] = u[j] - mean1;
        s2 += (v[j][0] * v[j][0] + v[j][1] * v[j][1]) + (v[j][2] * v[j][2] + v[j][3] * v[j][3]); t2 += (u[j][0] * u[j][0] + u[j][1] * u[j][1]) + (u[j][2] * u[j][2] + u[j][3] * u[j][3]); }
#pragma unroll
    for (int o = 1; o < 64; o <<= 1) { s2 += __shfl_xor(s2, o); t2 += __shfl_xor(t2, o); }
    const float r0 = 1.f / sqrtf(s2 * (1.f / 1024.f) + LN_EPS), r1 = 1.f / sqrtf(t2 * (1.f / 1024.f) + LN_EPS);
#pragma unroll
    for (int j = 0; j < 4; ++j) { const f32x4 g = ((const f32x4*)gam)[lane + 64 * j], b = ((const f32x4*)bet)[lane + 64 * j]; const f32x4 o0 = v[j] * r0 * g + b, o1 = u[j] * r1 * g + b;
        if (TO_BF16) { u32x2 w; w.x = pk2(o0[0], o0[1]); w.y = pk2(o0[2], o0[3]); ((u32x2*)ob0)[lane + 64 * j] = w; w.x = pk2(o1[0], o1[1]); w.y = pk2(o1[2], o1[3]); ((u32x2*)ob1)[lane + 64 * j] = w; }
        else { ((f32x4*)of0)[lane + 64 * j] = o0; ((f32x4*)of1)[lane + 64 * j] = o1; } }
}

constexpr int SC_LD = 2052;
constexpr int MK_OFF = 16 * SC_LD * 4;
template <int MODE>
__device__ __forceinline__ void mixa_unit(const bf16* QI, const bf16* KI, const float* WI, const bf16* QA, bf16* YA, const bf16* KA, const bf16* VAT,
                                          LAS unsigned char* lds, int b, int qt) {
    const int tid = threadIdx.x, w = __builtin_amdgcn_readfirstlane(tid >> 6), lane = tid & 63, n = lane & 15, g = lane >> 4;
    const int rowbase = b * SEQ + qt * 16, nk16 = qt + 1;
    LAS float* SC = (LAS float*)lds;
    LAS unsigned long long* MK = (LAS unsigned long long*)(lds + MK_OFF);
    const f32x4 zero4 = {0.f, 0.f, 0.f, 0.f};
    {
        bf16x8 qf[8][2];
        const bf16* qrow = QI + (size_t)(rowbase + n) * 512 + 8 * g;
#pragma unroll
        for (int h = 0; h < 8; ++h) { qf[h][0] = *(const bf16x8*)(qrow + h * 64); qf[h][1] = *(const bf16x8*)(qrow + h * 64 + 32); }
        const f32x4 w0 = *(const f32x4*)(WI + (size_t)(rowbase + n) * 8), w1 = *(const f32x4*)(WI + (size_t)(rowbase + n) * 8 + 4);
        const float wv[8] = {w0[0], w0[1], w0[2], w0[3], w1[0], w1[1], w1[2], w1[3]};
        const bf16* kbase = KI + (size_t)(b * SEQ + n) * 64 + 8 * g;
        const int ntw = (nk16 > w) ? ((nk16 - w + 7) >> 3) : 0;
        bf16x8 ka[2][2], kbv[2][2];
#define P1_LOAD(dst, g0) do { _Pragma("unroll") for (int i_ = 0; i_ < 2; ++i_) { int ti_ = (g0) * 2 + i_; ti_ = ti_ < ntw ? ti_ : (ntw - 1); const bf16* p_ = kbase + (size_t)(w + 8 * ti_) * 1024; \
            dst[i_][0] = *(const bf16x8*)p_; dst[i_][1] = *(const bf16x8*)(p_ + 32); } } while (0)
#define P1_COMP(src, g0) do { _Pragma("unroll") for (int i_ = 0; i_ < 2; ++i_) { const int ti_ = (g0) * 2 + i_; if (ti_ < ntw) { const int kt = w + 8 * ti_; f32x4 sc = zero4; \
            _Pragma("unroll") for (int h = 0; h < 8; ++h) { f32x4 a = MFMA16(src[i_][0], qf[h][0], zero4); a = MFMA16(src[i_][1], qf[h][1], a); \
                _Pragma("unroll") for (int i = 0; i < 4; ++i) sc[i] += fmaxf(a[i], 0.f) * wv[h]; } \
            if (kt == qt) { _Pragma("unroll") for (int i = 0; i < 4; ++i) if (4 * g + i > n) sc[i] = -INFINITY; } \
            *(LAS f32x4*)(SC + n * SC_LD + kt * 16 + 4 * g) = sc; } } } while (0)
        if (ntw > 0) {
            const int ng = (ntw + 1) >> 1;
            P1_LOAD(ka, 0);
            for (int g0 = 0; g0 < ng; g0 += 2) {
                if (g0 + 1 < ng) P1_LOAD(kbv, g0 + 1);
                P1_COMP(ka, g0);
                if (g0 + 1 >= ng) break;
                if (g0 + 2 < ng) P1_LOAD(ka, g0 + 2);
                P1_COMP(kbv, g0 + 1);
            }
        }
#undef P1_LOAD
#undef P1_COMP
    }
    __syncthreads();
#ifndef SELREP
#define SELREP 1
#endif
#pragma unroll 1
    for (int qq_ = 0; qq_ < ((MODE & 4) ? 2 * SELREP : 0); ++qq_) { const int qq = qq_ & 1;
        const int nq = 2 * w + qq, t = qt * 16 + nq, Lr = 16 * nk16, nj = (Lr + 63) >> 6;
        unsigned key[32];
#pragma unroll
        for (int j = 0; j < 32; ++j) { const int idx = lane + 64 * j; float v = SC[nq * SC_LD + idx]; v = (idx < Lr) ? v : -INFINITY;
            const unsigned uu = __builtin_bit_cast(unsigned, v); key[j] = (uu & 0x80000000u) ? ~uu : (uu | 0x80000000u); }
        if (t + 1 <= 256) {
            { const int lo = lane * 64; unsigned long long mm = 0ull;
              if (lo + 63 <= t) mm = ~0ull; else if (lo <= t) mm = (2ull << (t - lo)) - 1ull;
              if (lane < 32) MK[nq * 32 + lane] = mm; }
        } else {
#define SEL_CNT(OP, N, TH, OUT) do { _Pragma("unroll") for (int j = 0; j < (N); j += 4) { unsigned long long m0_, m1_, m2_, m3_; \
        asm("v_cmp_" OP "_u32_e64 %0, %4, %8\n\tv_cmp_" OP "_u32_e64 %1, %5, %8\n\tv_cmp_" OP "_u32_e64 %2, %6, %8\n\tv_cmp_" OP "_u32_e64 %3, %7, %8" \
            : "=&s"(m0_), "=&s"(m1_), "=&s"(m2_), "=&s"(m3_) : "v"(key[j]), "v"(key[j + 1]), "v"(key[j + 2]), "v"(key[j + 3]), "v"(TH)); \
        OUT += __builtin_popcountll(m0_) + __builtin_popcountll(m1_) + __builtin_popcountll(m2_) + __builtin_popcountll(m3_); } } while (0)
#define SEL_CNT_NJ(OP, TH, OUT) do { if (nj <= 8) SEL_CNT(OP, 8, TH, OUT); else if (nj <= 16) SEL_CNT(OP, 16, TH, OUT); else if (nj <= 24) SEL_CNT(OP, 24, TH, OUT); else SEL_CNT(OP, 32, TH, OUT); } while (0)
            unsigned T = 0u; bool exact = false;
#pragma unroll 1
            for (int bit = (MODE & 8) ? -1 : 31; bit >= 0; --bit) {
                const unsigned cand = T | (1u << bit); int cnt = 0;
                SEL_CNT_NJ("ge", cand, cnt);
                if (cnt >= 256) { T = cand; if (cnt == 256) { exact = true; break; } }
            }
            int need = 0x7fffffff;
            if (!exact) { int cgt = 0; SEL_CNT_NJ("gt", T, cgt); need = 256 - cgt; }
#undef SEL_CNT
#undef SEL_CNT_NJ
            unsigned wlo = 0u, whi = 0u;
            if (exact) {
#pragma unroll
                for (int j = 0; j < 32; ++j) if (j < nj) { unsigned long long m_; asm("v_cmp_ge_u32_e64 %0, %1, %2" : "=s"(m_) : "v"(key[j]), "v"(T));
                    wlo = (lane == j) ? (unsigned)m_ : wlo; whi = (lane == j) ? (unsigned)(m_ >> 32) : whi; }
            } else {
                int tb = 0; const unsigned long long ltm = (1ull << lane) - 1ull;
#pragma unroll
                for (int j = 0; j < 32; ++j) if (j < nj) { const bool eq = key[j] == T; const unsigned long long eqm = __ballot(eq);
                    const int myrank = tb + __popcll(eqm & ltm);
                    const unsigned long long selm = __ballot(key[j] > T || (eq && myrank < need)); tb += __popcll(eqm);
                    wlo = (lane == j) ? (unsigned)selm : wlo; whi = (lane == j) ? (unsigned)(selm >> 32) : whi; }
            }
            if (lane < 32) MK[nq * 32 + lane] = ((unsigned long long)whi << 32) | wlo;
        }
    }
    __syncthreads();
#ifndef P2REP
#define P2REP 1
#endif
    if (MODE & 2) for (int p2r_ = 0; p2r_ < P2REP; ++p2r_) {
        constexpr int KLD = 72, VLD = 136;
        LAS bf16* KT = (LAS bf16*)lds;
        LAS bf16* VTT = (LAS bf16*)(lds + 2 * 128 * KLD * 2);
        const bf16* qrow = QA + (size_t)(rowbase + n) * 512 + w * 64 + 8 * g;
        const bf16x8 qa0 = *(const bf16x8*)qrow, qa1 = *(const bf16x8*)(qrow + 32);
        f32x4 o[4] = {zero4, zero4, zero4, zero4}, osum = zero4; float mrun = -1e30f;
        const u32x4 onesw = {0x3f803f80u, 0x3f803f80u, 0x3f803f80u, 0x3f803f80u}; const bf16x8 ones8 = __builtin_bit_cast(bf16x8, onesw);
        const int nT = (nk16 + 7) >> 3;
        const int kr0 = tid >> 3, kc = tid & 7, vd0 = tid >> 4, vc = tid & 15;
        const bf16* kg = KA + (size_t)(b * SEQ + kr0) * 64 + kc * 8;
        const bf16* vg = VAT + (size_t)(b * 64 + vd0) * 2048 + vc * 8;
        const int klds = kr0 * KLD + kc * 8, vlds = vd0 * VLD + vc * 8;
#define P2_LOAD(R, T) do { R[0] = *(const u32x4*)(kg + (size_t)(T) * 8192); R[1] = *(const u32x4*)(kg + (size_t)(T) * 8192 + 4096); \
                           R[2] = *(const u32x4*)(vg + (T) * 128); R[3] = *(const u32x4*)(vg + (T) * 128 + 32 * 2048); } while (0)
#define P2_STORE(R, buf) do { *(LAS u32x4*)(KT + (buf) * 128 * KLD + klds) = R[0]; *(LAS u32x4*)(KT + (buf) * 128 * KLD + klds + 64 * KLD) = R[1]; \
                              *(LAS u32x4*)(VTT + (buf) * 64 * VLD + vlds) = R[2]; *(LAS u32x4*)(VTT + (buf) * 64 * VLD + vlds + 32 * VLD) = R[3]; } while (0)
        u32x4 rA[4], rB[4];
        P2_LOAD(rA, 0);
        if (nT > 1) P2_LOAD(rB, 1);
        P2_STORE(rA, 0);
        __syncthreads();
#define MIXA_TILE(T, buf) do { \
            const LAS bf16* kt = KT + (buf) * 128 * KLD; const LAS bf16* vt = VTT + (buf) * 64 * VLD; \
            const unsigned long long mw0 = MK[n * 32 + 2 * (T)] >> (4 * g), mw1 = MK[n * 32 + 2 * (T) + 1] >> (4 * g); \
            const int wd4[4] = {(int)(unsigned)mw0, (int)(unsigned)(mw0 >> 32), (int)(unsigned)mw1, (int)(unsigned)(mw1 >> 32)}; \
            f32x4 st[8]; \
            _Pragma("unroll") for (int c8 = 0; c8 < 8; ++c8) { const LAS bf16* kp = kt + (16 * c8 + n) * KLD + 8 * g; \
                const bf16x8 k0 = *(const LAS bf16x8*)kp, k1 = *(const LAS bf16x8*)(kp + 32); \
                st[c8] = MFMA16(k0, qa0, zero4); st[c8] = MFMA16(k1, qa1, st[c8]); } \
            float bm = st[0][0]; \
            _Pragma("unroll") for (int c8 = 0; c8 < 8; ++c8) \
                _Pragma("unroll") for (int i = 0; i < 4; ++i) bm = fmaxf(bm, st[c8][i]);                   \
            bm = fmaxf(bm, __shfl_xor(bm, 16)); bm = fmaxf(bm, __shfl_xor(bm, 32)); \
            const float mn = fmaxf(mrun, bm), alpha = __builtin_amdgcn_exp2f(mrun - mn); mrun = mn; \
            _Pragma("unroll") for (int c8 = 0; c8 < 8; ++c8) \
                _Pragma("unroll") for (int i = 0; i < 4; ++i) { const int mk_ = (wd4[c8 >> 1] << (31 - (16 * (c8 & 1) + i))) >> 31;     \
                    st[c8][i] = __builtin_bit_cast(float, __builtin_bit_cast(int, __builtin_amdgcn_exp2f(st[c8][i] - mn)) & mk_); } \
            _Pragma("unroll") for (int dt = 0; dt < 4; ++dt) o[dt] = o[dt] * alpha; \
            osum = osum * alpha; \
            _Pragma("unroll") for (int kb4 = 0; kb4 < 4; ++kb4) { \
                u32x4 pw; pw.x = pk2(st[2 * kb4][0], st[2 * kb4][1]); pw.y = pk2(st[2 * kb4][2], st[2 * kb4][3]); pw.z = pk2(st[2 * kb4 + 1][0], st[2 * kb4 + 1][1]); pw.w = pk2(st[2 * kb4 + 1][2], st[2 * kb4 + 1][3]); \
                const bf16x8 pb = __builtin_bit_cast(bf16x8, pw); \
                osum = MFMA16(ones8, pb, osum);                                                             \
                _Pragma("unroll") for (int dt = 0; dt < 4; ++dt) { const LAS bf16* vp = vt + (16 * dt + n) * VLD + 32 * kb4 + 4 * g; \
                    const u32x2 lo = *(const LAS u32x2*)vp, hi = *(const LAS u32x2*)(vp + 16); \
                    u32x4 vv; vv.x = lo.x; vv.y = lo.y; vv.z = hi.x; vv.w = hi.y; \
                    o[dt] = MFMA16(__builtin_bit_cast(bf16x8, vv), pb, o[dt]); } } \
        } while (0)
        for (int T0 = 0; T0 < nT; T0 += 2) {
            if (T0 + 2 < nT) P2_LOAD(rA, T0 + 2);
            MIXA_TILE(T0, 0);
            if (T0 + 1 < nT) P2_STORE(rB, 1);
            __syncthreads();
            if (T0 + 1 >= nT) break;
            if (T0 + 3 < nT) P2_LOAD(rB, T0 + 3);
            MIXA_TILE(T0 + 1, 1);
            if (T0 + 2 < nT) P2_STORE(rA, 0);
            __syncthreads();
        }
#undef MIXA_TILE
#undef P2_LOAD
#undef P2_STORE
        const float inv = 1.0f / osum[0];
        bf16* orow = YA + (size_t)(rowbase + n) * 512 + w * 64 + 4 * g;
#pragma unroll
        for (int dt = 0; dt < 4; ++dt) { u32x2 ww; ww.x = pk2(o[dt][0] * inv, o[dt][1] * inv); ww.y = pk2(o[dt][2] * inv, o[dt][3] * inv); *(u32x2*)(orow + dt * 16) = ww; }
    }
    __syncthreads();
}

constexpr int KW_LD = 72;
__device__ __forceinline__ void m1_unit(const bf16* MLQK, const bf16* MLV, const float* IG, const float* LF, const float* conv_w, const float* conv_b,
                                        bf16* QC, bf16* DC, float* DN, float* BCUM, float* CS, LAS unsigned char* lds, int unit) {
    const int c = unit & 31, bh = unit >> 5, h = bh & 3, b = bh >> 2;
    const int tid = threadIdx.x, w = __builtin_amdgcn_readfirstlane(tid >> 6), lane = tid & 63, n = lane & 15, g = lane >> 4;
    const int rowbase = b * SEQ + c * 64;
    LAS float* WK = (LAS float*)lds;
    LAS bf16* KWT = (LAS bf16*)(lds + 1024);
    LAS bf16* VT = (LAS bf16*)(lds + 1024 + 128 * KW_LD * 2);
    if (w == 0) {
        const float lf = LF[(size_t)(rowbase + lane) * 4 + h], ig = IG[(size_t)(rowbase + lane) * 4 + h];
        float bc = lf;
#pragma unroll
        for (int o = 1; o < 64; o <<= 1) { const float tt = __shfl_up(bc, o); if (lane >= o) bc += tt; }
        const float bl = __shfl(bc, 63), gj = bl - bc + ig, mg = wave_max(gj);
        WK[lane] = __expf(gj - mg);
        BCUM[(size_t)(rowbase + lane) * 4 + h] = bc;
        if (lane == 0) { CS[unit * 2] = bl; CS[unit * 2 + 1] = mg; }
    }
    __syncthreads();
    {
        const int isk = (tid >> 4) & 1, cgi = tid & 15, rl = tid >> 5;
        const int ch = isk * 512 + h * 128 + cgi * 8;
        float cw[4][8], cb[8];
#pragma unroll
        for (int j = 0; j < 4; ++j) { const f32x4 a = *(const f32x4*)(conv_w + j * 1024 + ch), bb = *(const f32x4*)(conv_w + j * 1024 + ch + 4);
            cw[j][0] = a[0]; cw[j][1] = a[1]; cw[j][2] = a[2]; cw[j][3] = a[3]; cw[j][4] = bb[0]; cw[j][5] = bb[1]; cw[j][6] = bb[2]; cw[j][7] = bb[3]; }
        { const f32x4 a = *(const f32x4*)(conv_b + ch), bb = *(const f32x4*)(conv_b + ch + 4);
            cb[0] = a[0]; cb[1] = a[1]; cb[2] = a[2]; cb[3] = a[3]; cb[4] = bb[0]; cb[5] = bb[1]; cb[6] = bb[2]; cb[7] = bb[3]; }
        float x[7][8];
#pragma unroll
        for (int rr = 0; rr < 7; ++rr) { const int tl = c * 64 + 4 * rl + rr - 3;
            u32x4 t = {0u, 0u, 0u, 0u};
            if (tl >= 0) t = *(const u32x4*)(MLQK + (size_t)(b * SEQ + tl) * 1024 + ch);
            x[rr][0] = bflo(t.x); x[rr][1] = bfhi(t.x); x[rr][2] = bflo(t.y); x[rr][3] = bfhi(t.y); x[rr][4] = bflo(t.z); x[rr][5] = bfhi(t.z); x[rr][6] = bflo(t.w); x[rr][7] = bfhi(t.w); }
#pragma unroll
        for (int oo = 0; oo < 4; ++oo) { const int jr = 4 * rl + oo; float y[8];
#pragma unroll
            for (int e = 0; e < 8; ++e) { float a = cb[e];
#pragma unroll
                for (int j = 0; j < 4; ++j) a += cw[j][e] * x[oo + j][e];
                a = a * sigmoidf_(a); y[e] = isk ? a * MLK_SCALE : a; }
            u32x4 wv; wv.x = pk2(y[0], y[1]); wv.y = pk2(y[2], y[3]); wv.z = pk2(y[4], y[5]); wv.w = pk2(y[6], y[7]);
            *(u32x4*)(QC + (size_t)(rowbase + jr) * 1024 + ch) = wv;
            if (isk) { const float wk = WK[jr];
#pragma unroll
                for (int e = 0; e < 8; ++e) KWT[(cgi * 8 + e) * KW_LD + jr] = (bf16)f2bf(y[e] * wk); }
        }
#pragma unroll
        for (int q = 0; q < 2; ++q) { const int idx = tid + 512 * q, row = idx >> 4, cgv = idx & 15;
            const u32x4 t = *(const u32x4*)(MLV + (size_t)(rowbase + row) * 512 + h * 128 + cgv * 8);
            LAS bf16* vp = VT + (cgv * 8) * KW_LD + row;
            vp[0 * KW_LD] = (bf16)(t.x & 0xffffu); vp[1 * KW_LD] = (bf16)(t.x >> 16); vp[2 * KW_LD] = (bf16)(t.y & 0xffffu); vp[3 * KW_LD] = (bf16)(t.y >> 16);
            vp[4 * KW_LD] = (bf16)(t.z & 0xffffu); vp[5 * KW_LD] = (bf16)(t.z >> 16); vp[6 * KW_LD] = (bf16)(t.w & 0xffffu); vp[7 * KW_LD] = (bf16)(t.w >> 16); }
    }
    __syncthreads();
    {
        f32x4 acc[8];
#pragma unroll
        for (int et = 0; et < 8; ++et) acc[et] = (f32x4){0.f, 0.f, 0.f, 0.f};
#pragma unroll
        for (int ks = 0; ks < 2; ++ks) { const bf16x8 a = *(const LAS bf16x8*)(KWT + (16 * w + n) * KW_LD + 32 * ks + 8 * g);
#pragma unroll
            for (int et = 0; et < 8; ++et) { const bf16x8 bfr = *(const LAS bf16x8*)(VT + (16 * et + n) * KW_LD + 32 * ks + 8 * g); acc[et] = MFMA16(a, bfr, acc[et]); } }
        bf16* dcu = DC + (size_t)unit * 16384;
#pragma unroll
        for (int et = 0; et < 8; ++et) { u32x2 ww; ww.x = pk2(acc[et][0], acc[et][1]); ww.y = pk2(acc[et][2], acc[et][3]); *(u32x2*)(dcu + (16 * et + n) * 128 + 16 * w + 4 * g) = ww; }
        if (tid < 128) { float s = 0.f;
#pragma unroll 8
            for (int j = 0; j < 64; ++j) s += __builtin_bit_cast(float, (unsigned)KWT[tid * KW_LD + j] << 16);
            DN[(size_t)unit * 128 + tid] = s; }
    }
    __syncthreads();
}

constexpr int CT_LD = 136;
__device__ __forceinline__ void m3_unit(const bf16* QC, const bf16* MLV, bf16* YB, const bf16* MLO, const float* IG, const float* BCUM, const float* MST,
                                        const bf16* DC, const float* DN, const float* gnorm, LAS unsigned char* lds, int unit) {
    const int c = unit & 31, bh = unit >> 5, h = bh & 3, b = bh >> 2;
    const int tid = threadIdx.x, w = __builtin_amdgcn_readfirstlane(tid >> 6), lane = tid & 63, n = lane & 15, g = lane >> 4;
    const int rowbase = b * SEQ + c * 64;
    LAS float* U = (LAS float*)lds; LAS float* R = U + 64; LAS float* WINT = U + 128; LAS float* EMR = U + 192; LAS float* NS = U + 256; LAS float* XCH = U + 384;
    LAS bf16* CT = (LAS bf16*)(lds + 4096);
    LAS bf16* KS = (LAS bf16*)(lds + 4096 + 128 * CT_LD * 2);
    LAS bf16* VT = (LAS bf16*)(lds + 4096 + 128 * CT_LD * 2 + 64 * CT_LD * 2);
    if (w == 0) {
        const float bc = BCUM[(size_t)(rowbase + lane) * 4 + h], ig = IG[(size_t)(rowbase + lane) * 4 + h], mc = MST[unit];
        const float uu = ig - bc; float a = uu;
#pragma unroll
        for (int o = 1; o < 64; o <<= 1) { const float tt = __shfl_up(a, o); if (lane >= o) a = fmaxf(a, tt); }
        const float mrow = bc + fmaxf(a, mc);
        U[lane] = uu; R[lane] = bc - mrow; WINT[lane] = __expf(bc + mc - mrow); EMR[lane] = __expf(-mrow);
    }
    {
        const bf16* dcu = DC + (size_t)unit * 16384;
#pragma unroll
        for (int q = 0; q < 4; ++q) { const int idx = tid + 512 * q, e = idx >> 4, dg = idx & 15; *(LAS u32x4*)(CT + e * CT_LD + dg * 8) = *(const u32x4*)(dcu + idx * 8); }
#pragma unroll
        for (int q = 0; q < 2; ++q) { const int idx = tid + 512 * q, s = idx >> 4, dg = idx & 15;
            *(LAS u32x4*)(KS + s * CT_LD + dg * 8) = *(const u32x4*)(QC + (size_t)(rowbase + s) * 1024 + 512 + h * 128 + dg * 8); }
#pragma unroll
        for (int q = 0; q < 2; ++q) { const int idx = tid + 512 * q, row = idx >> 4, cgv = idx & 15;
            const u32x4 t = *(const u32x4*)(MLV + (size_t)(rowbase + row) * 512 + h * 128 + cgv * 8);
            LAS bf16* vp = VT + (cgv * 8) * KW_LD + row;
            vp[0 * KW_LD] = (bf16)(t.x & 0xffffu); vp[1 * KW_LD] = (bf16)(t.x >> 16); vp[2 * KW_LD] = (bf16)(t.y & 0xffffu); vp[3 * KW_LD] = (bf16)(t.y >> 16);
            vp[4 * KW_LD] = (bf16)(t.z & 0xffffu); vp[5 * KW_LD] = (bf16)(t.z >> 16); vp[6 * KW_LD] = (bf16)(t.w & 0xffffu); vp[7 * KW_LD] = (bf16)(t.w >> 16); }
        if (tid < 128) NS[tid] = DN[(size_t)unit * 128 + tid];
    }
    const int lt = w & 3, eh = w >> 2, l = 16 * lt + n;
    bf16x8 qf[4];
    { const bf16* qrow = QC + (size_t)(rowbase + l) * 1024 + h * 128 + 8 * g;
#pragma unroll
        for (int ks = 0; ks < 4; ++ks) qf[ks] = *(const bf16x8*)(qrow + 32 * ks); }
    __syncthreads();
#ifdef M3_LITE
    {
        const int lt = w & 3, eh = w >> 2, l = 16 * lt + n;
#pragma unroll
        for (int j = 0; j < 4; ++j) { const int e0 = 16 * (4 * eh + j) + 4 * g; float y[4];
#pragma unroll
            for (int i = 0; i < 4; ++i) { const int e = e0 + i;
                y[i] = 0.f;
                if (M3_LITE & 1) y[i] += __builtin_bit_cast(float, (unsigned)CT[e * CT_LD + ((l * 2 + 1) & 127)] << 16);
                if (M3_LITE & 2) y[i] += __builtin_bit_cast(float, (unsigned)KS[l * CT_LD + e] << 16);
                if (M3_LITE & 4) y[i] += __builtin_bit_cast(float, (unsigned)VT[e * KW_LD + l] << 16);
                if (M3_LITE & 8) y[i] += NS[e];
                if (M3_LITE & 16) y[i] += U[l] + R[l];
                if (M3_LITE & 32) y[i] += WINT[l] + EMR[l]; }
            const size_t off = (size_t)(rowbase + l) * 512 + h * 128 + e0;
            u32x2 ww; ww.x = pk2(y[0], y[1]); ww.y = pk2(y[2], y[3]); *(u32x2*)(YB + off) = ww; }
        __syncthreads();
        return;
    }
#endif
    const f32x4 zero4 = {0.f, 0.f, 0.f, 0.f};
    f32x4 sw[4]; const float Rl = R[l], wint = WINT[l], emr = EMR[l];
    float dsum = 0.f;
#pragma unroll
    for (int st = 0; st < 4; ++st) {
        sw[st] = zero4;
        if (st <= lt) { f32x4 acc = zero4;
#pragma unroll
            for (int ks = 0; ks < 4; ++ks) { const bf16x8 a = *(const LAS bf16x8*)(KS + (16 * st + n) * CT_LD + 32 * ks + 8 * g); acc = MFMA16(a, qf[ks], acc); }
#pragma unroll
            for (int i = 0; i < 4; ++i) { const int s = 16 * st + 4 * g + i; const float wgt = (s <= l) ? __expf(U[s] + Rl) : 0.f; sw[st][i] = acc[i] * wgt; dsum += sw[st][i]; } }
    }
    dsum += __shfl_xor(dsum, 16); dsum += __shfl_xor(dsum, 32);
    float qn = 0.f;
#pragma unroll
    for (int ks = 0; ks < 4; ++ks) { const u32x4 qq = __builtin_bit_cast(u32x4, qf[ks]); const LAS float* np = NS + 32 * ks + 8 * g;
        qn += bflo(qq.x) * np[0] + bfhi(qq.x) * np[1] + bflo(qq.y) * np[2] + bfhi(qq.y) * np[3] + bflo(qq.z) * np[4] + bfhi(qq.z) * np[5] + bflo(qq.w) * np[6] + bfhi(qq.w) * np[7]; }
    qn += __shfl_xor(qn, 16); qn += __shfl_xor(qn, 32);
    const float den = wint * qn + dsum;
    const float rden = 1.0f / fmaxf(fabsf(den), emr);
    f32x4 hv[4]; float s1 = 0.f;
#pragma unroll
    for (int j = 0; j < 4; ++j) { const int et = 4 * eh + j;
        f32x4 accS = zero4, accC = zero4;
#pragma unroll
        for (int kb = 0; kb < 2; ++kb) if (2 * kb <= lt) {
            u32x4 pw; pw.x = pk2(sw[2 * kb][0], sw[2 * kb][1]); pw.y = pk2(sw[2 * kb][2], sw[2 * kb][3]); pw.z = pk2(sw[2 * kb + 1][0], sw[2 * kb + 1][1]); pw.w = pk2(sw[2 * kb + 1][2], sw[2 * kb + 1][3]);
            const LAS bf16* vp = VT + (16 * et + n) * KW_LD + 32 * kb + 4 * g;
            const u32x2 lo = *(const LAS u32x2*)vp, hi = *(const LAS u32x2*)(vp + 16);
            u32x4 vv; vv.x = lo.x; vv.y = lo.y; vv.z = hi.x; vv.w = hi.y;
            accS = MFMA16(__builtin_bit_cast(bf16x8, vv), __builtin_bit_cast(bf16x8, pw), accS); }
#pragma unroll
        for (int ks = 0; ks < 4; ++ks) { const bf16x8 a = *(const LAS bf16x8*)(CT + (16 * et + n) * CT_LD + 32 * ks + 8 * g); accC = MFMA16(a, qf[ks], accC); }
#pragma unroll
        for (int i = 0; i < 4; ++i) { hv[j][i] = (wint * accC[i] + accS[i]) * rden; s1 += hv[j][i]; }
    }
    s1 += __shfl_xor(s1, 16); s1 += __shfl_xor(s1, 32);
    const float mloc = s1 * (1.f / 64.f); float q2 = 0.f;
#pragma unroll
    for (int j = 0; j < 4; ++j)
#pragma unroll
        for (int i = 0; i < 4; ++i) { const float dd = hv[j][i] - mloc; q2 += dd * dd; }
    q2 += __shfl_xor(q2, 16); q2 += __shfl_xor(q2, 32);
    if (g == 0) { XCH[(l * 2 + eh) * 2] = mloc; XCH[(l * 2 + eh) * 2 + 1] = q2; }
    __syncthreads();
    {
        const float mo = XCH[(l * 2 + (eh ^ 1)) * 2], qo = XCH[(l * 2 + (eh ^ 1)) * 2 + 1];
        const float mean = 0.5f * (mloc + mo), dm = mloc - mo, m2 = q2 + qo + 32.f * dm * dm;
        const float rstd = 1.0f / sqrtf(m2 * (1.f / 128.f) + LN_EPS);
#pragma unroll
        for (int j = 0; j < 4; ++j) { const int e0 = 16 * (4 * eh + j) + 4 * g;
            const f32x4 gn = *(const f32x4*)(gnorm + h * 128 + e0);
            const size_t off = (size_t)(rowbase + l) * 512 + h * 128 + e0;
            const u32x2 so = *(const u32x2*)(MLO + off);
            const float y0 = (hv[j][0] - mean) * rstd * gn[0] * bflo(so.x), y1 = (hv[j][1] - mean) * rstd * gn[1] * bfhi(so.x);
            const float y2 = (hv[j][2] - mean) * rstd * gn[2] * bflo(so.y), y3 = (hv[j][3] - mean) * rstd * gn[3] * bfhi(so.y);
            u32x2 ww; ww.x = pk2(y0, y1); ww.y = pk2(y2, y3); *(u32x2*)(YB + off) = ww; }
    }
    __syncthreads();
}

#define XB_TMO      128
#define XB_XCNT(j)  (256  + 64 * (j))
#define XB_XSUB(j)  (1280 + 64 * (j))
#define XB_XGEN(j)  (2304 + 64 * (j))
#define XB_TOP      3328
#define XB_TOPGEN   3392
#define XCD_BAR_WORDS 3456
#define XB_SPIN_CAP (1u << 18)

__device__ __forceinline__ unsigned xb_ld(unsigned* p)              { return __hip_atomic_load(p, __ATOMIC_RELAXED, __HIP_MEMORY_SCOPE_AGENT); }
__device__ __forceinline__ unsigned xb_add(unsigned* p, unsigned v) { return __hip_atomic_fetch_add(p, v, __ATOMIC_RELAXED, __HIP_MEMORY_SCOPE_AGENT); }
__device__ __forceinline__ unsigned xb_xcc_id() { return (unsigned)__builtin_amdgcn_s_getreg((3 << 11) | 20) & 0xFu; }
#define XB_SPIN(cond, bar) do { unsigned _sp = 0; while (cond) { __builtin_amdgcn_s_sleep(1); \
    if ((++_sp & 255u) == 0u) { if (xb_ld(&(bar)[XB_TMO])) break; if (_sp > XB_SPIN_CAP) { atomicAdd(&(bar)[XB_TMO], 1u); break; } } } } while (0)

struct XcdBarrier {
    unsigned* bar; unsigned x;
    volatile LAS unsigned* st;
};

__device__ __forceinline__ XcdBarrier xcd_barrier_post(unsigned* bar, volatile LAS unsigned* st) {
    XcdBarrier b; b.bar = bar; b.x = xb_xcc_id(); b.st = st;
    if (threadIdx.x == 0) (void)xb_add(&bar[XB_XCNT(b.x)], 1u);
    return b;
}
__device__ __forceinline__ void xcd_barrier_complete(unsigned* bar, unsigned x, unsigned& nloc, unsigned& nx) {
    const unsigned G = gridDim.x * gridDim.y * gridDim.z;
    unsigned sum, cnt, mine, sp = 0u;
    for (;;) {
        sum = 0u; cnt = 0u; mine = 0u;
#pragma unroll
        for (unsigned j = 0; j < 16; ++j) { const unsigned c = xb_ld(&bar[XB_XCNT(j)]); sum += c; cnt += (c > 0u) ? 1u : 0u; mine = (j == x) ? c : mine; }
        if (sum == G) break;
        __builtin_amdgcn_s_sleep(1);
        if ((++sp & 255u) == 0u) { if (xb_ld(&bar[XB_TMO])) break; if (sp > XB_SPIN_CAP) { atomicAdd(&bar[XB_TMO], 1u); break; } }
    }
    nloc = mine > 0u ? mine : 1u; nx = cnt > 0u ? cnt : 1u;
}

__device__ __forceinline__ void xcd_barrier(const XcdBarrier& b) {
    asm volatile("s_waitcnt vmcnt(0)" ::: "memory");
    __syncthreads();
    if (threadIdx.x == 0) {
        unsigned* bar = b.bar;
        __builtin_amdgcn_s_waitcnt(0);
        unsigned nloc = b.st[0], nx = b.st[1];
        if (nloc == 0u) { xcd_barrier_complete(bar, b.x, nloc, nx); b.st[0] = nloc; b.st[1] = nx; }
        const unsigned old = xb_add(&bar[XB_XSUB(b.x)], 1u);
        const unsigned gen = old / nloc;
        if (old + 1u == (gen + 1u) * nloc) {
            __builtin_amdgcn_fence(__ATOMIC_RELEASE, "agent");
            asm volatile("s_waitcnt vmcnt(0)" ::: "memory");
            const unsigned og = xb_add(&bar[XB_TOP], 1u);
            const unsigned tg = og / nx;
            if (og + 1u == (tg + 1u) * nx) xb_add(&bar[XB_TOPGEN], 1u);
            else XB_SPIN(xb_ld(&bar[XB_TOPGEN]) == tg, bar);
            __builtin_amdgcn_fence(__ATOMIC_ACQUIRE, "agent");
            xb_add(&bar[XB_XGEN(b.x)], 1u);
            asm volatile("s_waitcnt vmcnt(0)" ::: "memory");
        } else {
            XB_SPIN(xb_ld(&bar[XB_XGEN(b.x)]) == gen, bar);
            __builtin_amdgcn_fence(__ATOMIC_ACQUIRE, "agent");
            asm volatile("s_waitcnt vmcnt(0)" ::: "memory");
        }
    }
    __syncthreads();
}

__global__ void __launch_bounds__(NTHR, 2) fwd_kernel(Args args) {
    extern __shared__ __attribute__((aligned(16))) unsigned char lds_raw[];
    LAS unsigned char* lds = (LAS unsigned char*)lds_raw;
    cg::grid_group grid = cg::this_grid();
    const int tid = threadIdx.x, lane = tid & 63, wave = __builtin_amdgcn_readfirstlane(tid >> 6);
    const int G = gridDim.x, bx = blockIdx.x;
    const int gw = bx * NWAVES + wave, NGW = G * NWAVES;
    const int gt = bx * NTHR + tid, NGT = G * NTHR;
    unsigned char* ws = args.ws;
    const int lo = args.ph_lo, hi = args.ph_hi;
#ifndef GEMM_REP
#define GEMM_REP 1
#endif
#ifndef PH_MASK
#define PH_MASK 0xfff
#endif
#define IN(k) (((PH_MASK >> (k)) & 1) && lo <= (k) && (k) < hi)
#define SEAM(k) do { if (IN(k) && IN((k) + 1)) { if ((k) == 0) { asm volatile("s_waitcnt vmcnt(0) lgkmcnt(0)" ::: "memory"); grid.sync(); \
    if (tid == 0) { __builtin_amdgcn_fence(__ATOMIC_ACQUIRE, "agent"); asm volatile("s_waitcnt vmcnt(0)" ::: "memory"); } __syncthreads(); } else { xcd_barrier(xbar); } } } while (0)
    volatile LAS unsigned* xst = (volatile LAS unsigned*)(lds + LDS_BYTES - 64);
    if (tid < 2) xst[tid] = 0u;
    __syncthreads();
    XcdBarrier xbar = xcd_barrier_post((unsigned*)ws, xst);
    float* OUT = (float*)(GAS float*)args.out;
#define INP(k) ((const float*)(const GAS float*)args.in[k])
#define PHASE_PTRS() unsigned char* wsb0 = ws; asm volatile("" : "+s"(wsb0)); GAS unsigned char* wsb = (GAS unsigned char*)wsb0; \
    bf16* WinT = (bf16*)(wsb + WS_WIN); bf16* WgaT = (bf16*)(wsb + WS_WGA); bf16* WgbT = (bf16*)(wsb + WS_WGB); bf16* WuaT = (bf16*)(wsb + WS_WUA); bf16* WubT = (bf16*)(wsb + WS_WUB); \
    bf16* WoutT = (bf16*)(wsb + WS_WOUT); bf16* Wff1T = (bf16*)(wsb + WS_WFF1); bf16* Wff2T = (bf16*)(wsb + WS_WFF2); bf16* WpgT = (bf16*)(wsb + WS_WPG); bf16* WppT = (bf16*)(wsb + WS_WPP); \
    float* COS = (float*)(wsb + WS_COS); float* SIN = (float*)(wsb + WS_SIN); float* WI = (float*)(wsb + WS_WI); float* IG = (float*)(wsb + WS_IG); float* LF = (float*)(wsb + WS_LF); \
    bf16* KA = (bf16*)(wsb + WS_KA); bf16* KI = (bf16*)(wsb + WS_KI); bf16* VAT = (bf16*)(wsb + WS_VAT); \
    float* BCUM = (float*)(wsb + WS_BCUM); float* CS = (float*)(wsb + WS_CS); float* MST = (float*)(wsb + WS_MST); float* DN = (float*)(wsb + WS_DN); \
    bf16* XB = (bf16*)(wsb + WS_XB); bf16* PB = (bf16*)(wsb + WS_PB); bf16* QA = (bf16*)(wsb + WS_QA); bf16* QI = (bf16*)(wsb + WS_QI); bf16* MLQK = (bf16*)(wsb + WS_MLQK); \
    bf16* MLV = (bf16*)(wsb + WS_MLV); bf16* MLO = (bf16*)(wsb + WS_MLO); bf16* QC = (bf16*)(wsb + WS_QC); bf16* DC = (bf16*)(wsb + WS_DC); \
    bf16* TMP = (bf16*)(wsb + WS_TMP); bf16* MRG = (bf16*)(wsb + WS_MRG); bf16* H1 = (bf16*)(wsb + WS_H1); bf16* HF = (bf16*)(wsb + WS_HF); bf16* RB = (bf16*)(wsb + WS_RB); \
    float* PROJ = (float*)(wsb + WS_PROJ); bf16* YA = (bf16*)(wsb + WS_YA); (void)YA; bf16* CST = (bf16*)(wsb + WS_CST); float* NST = (float*)(wsb + WS_NST); (void)CST; (void)NST; \
    (void)WinT; (void)WgaT; (void)WgbT; (void)WuaT; (void)WubT; (void)WoutT; (void)Wff1T; (void)Wff2T; (void)WpgT; (void)WppT; (void)COS; (void)SIN; (void)WI; (void)IG; (void)LF; (void)KA; (void)KI; (void)VAT; \
    (void)BCUM; (void)CS; (void)MST; (void)DN; (void)XB; (void)PB; (void)QA; (void)QI; (void)MLQK; (void)MLV; (void)MLO; (void)QC; (void)DC; (void)TMP; (void)MRG; (void)H1; (void)HF; (void)RB; (void)PROJ
#define LAUNDER_I(v) asm volatile("" : "+s"(v))

#ifndef REP0
#define REP0 1
#endif
    if (IN(0)) for (int r0_ = 0; r0_ < REP0; ++r0_) { PHASE_PTRS();
        LAS float* scr = (LAS float*)(lds + wave * 16384);
        const float* w_in = INP(I_WIN); const float* x = INP(I_X);
        constexpr int I_A = 16 * (NWIN / 32), I_G = 16 * 32, I_U = 8 * 32, I_O = 16 * 32, I_1 = 16 * 128, I_2 = 64 * 32, I_PG = 16 * 32, I_PP = 4 * 32;
        constexpr int NITEMS = I_A + 2 * I_G + 2 * I_U + I_O + I_1 + I_2 + I_PG + I_PP;
        for (int it = gw; it < NITEMS; it += NGW) {
            int r = it;
            if (r < I_A) { transpose_item(w_in, 1024, WIN_LD, WinT, NWIN, scr, r, lane, [](int n) { return win_src(n); }); continue; } r -= I_A;
            if (r < I_G) { transpose_item(w_in, 1024, WIN_LD, WgaT, 1024, scr, r, lane, [](int n) { return 3280 + n; }); continue; } r -= I_G;
            if (r < I_G) { transpose_item(w_in, 1024, WIN_LD, WgbT, 1024, scr, r, lane, [](int n) { return 4304 + n; }); continue; } r -= I_G;
            if (r < I_U) { transpose_item(INP(I_WUA), 512, 1024, WuaT, 1024, scr, r, lane, [](int n) { return n; }); continue; } r -= I_U;
            if (r < I_U) { transpose_item(INP(I_WUB), 512, 1024, WubT, 1024, scr, r, lane, [](int n) { return n; }); continue; } r -= I_U;
            if (r < I_O) { transpose_item(INP(I_WOUT), 1024, 1024, WoutT, 1024, scr, r, lane, [](int n) { return n; }); continue; } r -= I_O;
            if (r < I_1) { transpose_item(INP(I_WFF1), 1024, 4096, Wff1T, 4096, scr, r, lane, [](int n) { return n; }); continue; } r -= I_1;
            if (r < I_2) { transpose_item(INP(I_WFF2), 4096, 1024, Wff2T, 1024, scr, r, lane, [](int n) { return n; }); continue; } r -= I_2;
            if (r < I_PG) { transpose_item(INP(I_WPG), 1024, 1024, WpgT, 1024, scr, r, lane, [](int n) { return n; }); continue; } r -= I_PG;
            transpose_item(INP(I_WPP), 256, 1024, WppT, 1024, scr, r, lane, [](int n) { return n; });
        }
        { const f32x4* xs = (const f32x4*)x; u32x4* xd = (u32x4*)XB;
            for (int i = gt; i < M * D / 8; i += 4 * NGT) { f32x4 a[4], b[4];
#pragma unroll
                for (int k = 0; k < 4; ++k) { a[k] = xs[2 * (i + k * NGT)]; b[k] = xs[2 * (i + k * NGT) + 1]; }
#pragma unroll
                for (int k = 0; k < 4; ++k) { u32x4 o; o.x = pk2(a[k][0], a[k][1]); o.y = pk2(a[k][2], a[k][3]); o.z = pk2(b[k][0], b[k][1]); o.w = pk2(b[k][2], b[k][3]); xd[i + k * NGT] = o; } } }
        { const f32x4* ps = (const f32x4*)INP(I_P); u32x4* pd = (u32x4*)PB;
            for (int i = gt; i < M * PLE / 8; i += 4 * NGT) { f32x4 a[4], b[4];
#pragma unroll
                for (int k = 0; k < 4; ++k) { a[k] = ps[2 * (i + k * NGT)]; b[k] = ps[2 * (i + k * NGT) + 1]; }
#pragma unroll
                for (int k = 0; k < 4; ++k) { u32x4 o; o.x = pk2(a[k][0], a[k][1]); o.y = pk2(a[k][2], a[k][3]); o.z = pk2(b[k][0], b[k][1]); o.w = pk2(b[k][2], b[k][3]); pd[i + k * NGT] = o; } } }
        { const int* pos = (const int*)INP(I_POS);
            for (int i = gt; i < M * 32; i += NGT) { const int m = i >> 5, f = i & 31; const double a = (double)pos[m] * INVF[f] * 0.15915494309189535;
                const float rev = (float)(a - floor(a)); COS[i] = __builtin_amdgcn_cosf(rev); SIN[i] = __builtin_amdgcn_sinf(rev); } }
    }
    SEAM(0);
#ifndef REP1
#define REP1 1
#endif
    if (IN(1)) for (int r1_ = 0; r1_ < REP1; ++r1_) { PHASE_PTRS();
        int Kv = D; LAUNDER_I(Kv); pg8::Gemm gm{XB, WinT, M, NWIN, Kv}; pg8::StaticOrder S; S.init(M, NWIN, G, bx);
        EpiWin E{QA, QI, KA, KI, VAT, MLQK, MLV, MLO, WI, IG, LF, COS, SIN, INP(I_BIG), INP(I_BFG)};
        pg8::gemm_phase<EpiWin, pg8::StaticOrder, PG8_ALIGN_EPI, true>(lds, gm, S, E);
    }
    SEAM(1);
    if (IN(2)) { PHASE_PTRS();
#ifdef NO_MIXA
        for (int i = gt; i < M * 512 / 8; i += NGT) ((u32x4*)YA)[i] = (u32x4){0u, 0u, 0u, 0u};
#else
        for (int pr = bx; pr < NB * 64; pr += G) { const int b = pr >> 6, j = pr & 63;
            mixa_unit<7>(QI, KI, WI, QA, YA, KA, VAT, lds, b, 127 - j);
            mixa_unit<7>(QI, KI, WI, QA, YA, KA, VAT, lds, b, j); }
#endif
#ifdef DUPMIXA
        for (int pr = bx; pr < NB * 64; pr += G) { const int b = pr >> 6, j = pr & 63;
            mixa_unit<DUPMIXA>(QI, KI, WI, QA, YA, KA, VAT, lds, b, 127 - j);
            mixa_unit<DUPMIXA>(QI, KI, WI, QA, YA, KA, VAT, lds, b, j); }
#endif
        for (int u = bx; u < 2048; u += G) m1_unit(MLQK, MLV, IG, LF, INP(I_CONVW), INP(I_CONVB), QC, DC, DN, BCUM, CS, lds, u);
    }
    SEAM(2);
#ifndef REP3
#define REP3 1
#endif
    if (IN(3)) for (int r3_ = 0; r3_ < REP3; ++r3_) { PHASE_PTRS();
        for (int item = gt; item < 64 * 2048; item += NGT) { const int bh = item >> 11, rem = item & 2047;
            float st[8] = {0.f, 0.f, 0.f, 0.f, 0.f, 0.f, 0.f, 0.f}; float m = 0.f;
            const bf16* src = DC + (size_t)(bh * 32) * 16384 + rem * 8; bf16* dst = CST + (size_t)(bh * 32) * 16384 + rem * 8;
#pragma unroll 1
            for (int c0 = 0; c0 < 32; c0 += 8) { u32x4 dv[8]; float bl[8], mg[8];
#pragma unroll
                for (int k = 0; k < 8; ++k) { dv[k] = *(const u32x4*)(src + (size_t)(c0 + k) * 16384); bl[k] = CS[(bh * 32 + c0 + k) * 2]; mg[k] = CS[(bh * 32 + c0 + k) * 2 + 1]; }
#pragma unroll
                for (int k = 0; k < 8; ++k) { const float mn = fmaxf(bl[k] + m, mg[k]), a = __expf(bl[k] + m - mn), sg = __expf(mg[k] - mn); m = mn; const u32x4 d = dv[k];
                    u32x4 o; o.x = pk2(st[0], st[1]); o.y = pk2(st[2], st[3]); o.z = pk2(st[4], st[5]); o.w = pk2(st[6], st[7]); *(u32x4*)(dst + (size_t)(c0 + k) * 16384) = o;
                    st[0] = a * st[0] + sg * bflo(d.x); st[1] = a * st[1] + sg * bfhi(d.x); st[2] = a * st[2] + sg * bflo(d.y); st[3] = a * st[3] + sg * bfhi(d.y);
                    st[4] = a * st[4] + sg * bflo(d.z); st[5] = a * st[5] + sg * bfhi(d.z); st[6] = a * st[6] + sg * bflo(d.w); st[7] = a * st[7] + sg * bfhi(d.w); } } }
        for (int item = gt; item < 64 * 128; item += NGT) { const int bh = item >> 7, dd = item & 127; float st = 0.f, m = 0.f;
            for (int c = 0; c < 32; ++c) { const float bl = CS[(bh * 32 + c) * 2], mg = CS[(bh * 32 + c) * 2 + 1];
                if (dd == 0) MST[bh * 32 + c] = m;
                const float mn = fmaxf(bl + m, mg), a = __expf(bl + m - mn), s = __expf(mg - mn); m = mn;
                const float d = DN[(size_t)(bh * 32 + c) * 128 + dd]; NST[(size_t)(bh * 32 + c) * 128 + dd] = st; st = a * st + s * d; } }
    }
    SEAM(3);
#ifndef REP4
#define REP4 1
#endif
    if (IN(4)) for (int r4_ = 0; r4_ < REP4; ++r4_) { PHASE_PTRS();
        for (int u = bx; u < 2048; u += G) m3_unit(QC, MLV, QI  , MLO, IG, BCUM, MST, CST, NST, INP(I_MLNG), lds, u);
    }
    SEAM(4);
#ifndef REP5
#define REP5 1
#endif
    if (IN(5)) for (int r5_ = 0; r5_ < REP5; ++r5_) { PHASE_PTRS();
        pg8::StaticOrder S; S.init(M, D, G, bx);
        { int Kv = D; LAUNDER_I(Kv); pg8::Gemm gm{XB, WgaT, M, D, Kv}; EpiB<0> E{TMP, nullptr, nullptr, nullptr, D}; pg8::gemm_phase<EpiB<0>, pg8::StaticOrder, PG8_ALIGN_EPI, true>(lds, gm, S, E); }
        { int Kv = 512; LAUNDER_I(Kv); pg8::Gemm gm{YA, WuaT, M, D, Kv}; EpiB<1> E{nullptr, OUT, TMP, nullptr, D}; pg8::gemm_phase<EpiB<1>, pg8::StaticOrder, PG8_ALIGN_EPI, true>(lds, gm, S, E); }
        { int Kv = D; LAUNDER_I(Kv); pg8::Gemm gm{XB, WgbT, M, D, Kv}; EpiB<0> E{TMP, nullptr, nullptr, nullptr, D}; pg8::gemm_phase<EpiB<0>, pg8::StaticOrder, PG8_ALIGN_EPI, true>(lds, gm, S, E); }
        { int Kv = 512; LAUNDER_I(Kv); pg8::Gemm gm{QI, WubT, M, D, Kv}; EpiB<2> E{MRG, nullptr, TMP, OUT, D}; pg8::gemm_phase<EpiB<2>, pg8::StaticOrder, PG8_ALIGN_EPI, true>(lds, gm, S, E); }
    }
    SEAM(5);
#ifndef REP6
#define REP6 1
#endif
    if (IN(6)) for (int r6_ = 0; r6_ < REP6; ++r6_) { PHASE_PTRS();
        pg8::StaticOrder S; S.init(M, D, G, bx);
        int Kv = D; LAUNDER_I(Kv); pg8::Gemm gm{MRG, WoutT, M, D, Kv}; EpiF<0> E{OUT, nullptr, INP(I_X), nullptr, D}; pg8::gemm_phase<EpiF<0>, pg8::StaticOrder, PG8_ALIGN_EPI, true>(lds, gm, S, E);
    }
    SEAM(6);
#ifndef REP7
#define REP7 1
#endif
    if (IN(7)) for (int r7_ = 0; r7_ < REP7; ++r7_) { PHASE_PTRS(); for (int m = gw; m < M / 2; m += NGW) ln_row2<true>(OUT + (size_t)m * D, OUT + (size_t)(m + M / 2) * D, INP(I_LN1G), INP(I_LN1B), nullptr, nullptr, H1 + (size_t)m * D, H1 + (size_t)(m + M / 2) * D, lane); }
    SEAM(7);
    if (IN(8)) { PHASE_PTRS();
        pg8::StaticOrder S; S.init(M, FF, G, bx);
        int Kv = D; LAUNDER_I(Kv); pg8::Gemm gm{H1, Wff1T, M, FF, Kv}; EpiB<3> E{HF, nullptr, nullptr, nullptr, FF}; pg8::gemm_phase<EpiB<3>, pg8::StaticOrder, PG8_ALIGN_EPI, true>(lds, gm, S, E);
    }
#ifdef DUP89
    SEAM(8);
    if (IN(8) && true) { PHASE_PTRS();
        pg8::StaticOrder S; S.init(M, FF, G, bx);
        int Kv = D; LAUNDER_I(Kv); pg8::Gemm gm{H1, Wff1T, M, FF, Kv}; EpiB<3> E{HF, nullptr, nullptr, nullptr, FF}; pg8::gemm_phase<EpiB<3>, pg8::StaticOrder, PG8_ALIGN_EPI, true>(lds, gm, S, E);
    }
#endif
    SEAM(8);
    if (IN(9)) { PHASE_PTRS();
        pg8::StaticOrder S; S.init(M, D, G, bx);
        int Kv = FF; LAUNDER_I(Kv); pg8::Gemm gm{HF, Wff2T, M, D, Kv}; EpiF<1> E{OUT, RB, nullptr, H1, D}; pg8::gemm_phase<EpiF<1>, pg8::StaticOrder, PG8_ALIGN_EPI, true>(lds, gm, S, E);
    }
#ifdef DUP89
    SEAM(9);
    if (IN(9) && true) { PHASE_PTRS();
        pg8::StaticOrder S; S.init(M, D, G, bx);
        int Kv = FF; LAUNDER_I(Kv); pg8::Gemm gm{HF, Wff2T, M, D, Kv}; EpiF<1> E{OUT, RB, nullptr, H1, D}; pg8::gemm_phase<EpiF<1>, pg8::StaticOrder, PG8_ALIGN_EPI, true>(lds, gm, S, E);
    }
#endif
    SEAM(9);
    if (IN(10)) { PHASE_PTRS();
        pg8::StaticOrder S; S.init(M, D, G, bx);
#if !defined(P10_ONLY) || P10_ONLY == 1
        { int Kv = PLE; LAUNDER_I(Kv); pg8::Gemm gm{PB, WppT, M, D, Kv}; EpiF<2> E{PROJ, nullptr, nullptr, nullptr, D}; pg8::gemm_phase<EpiF<2>, pg8::StaticOrder, PG8_ALIGN_EPI, true>(lds, gm, S, E); }
#endif
#if !defined(P10_ONLY) || P10_ONLY == 2
        { int Kv = D; LAUNDER_I(Kv); pg8::Gemm gm{RB, WpgT, M, D, Kv}; EpiF<3> E{OUT, nullptr, PROJ, nullptr, D}; pg8::gemm_phase<EpiF<3>, pg8::StaticOrder, PG8_ALIGN_EPI, true>(lds, gm, S, E); }
#endif
    }
    SEAM(10);
    if (IN(11)) { PHASE_PTRS(); for (int m = gw; m < M / 2; m += NGW) ln_row2<false>(OUT + (size_t)m * D, OUT + (size_t)(m + M / 2) * D, INP(I_LN2G), INP(I_LN2B), OUT + (size_t)m * D, OUT + (size_t)(m + M / 2) * D, nullptr, nullptr, lane); }
#undef IN
#undef SEAM
}

extern "C" void kernel_launch(void* const* d_in, const int* in_sizes, int n_in, void* d_out, int out_size, void* d_ws, size_t ws_size, hipStream_t stream) {
    static int grid = 0;
    if (grid == 0) {
        if (n_in != 20 || out_size != M * D || ws_size < WS_END) { fprintf(stderr, "kernel_launch: unexpected problem shape (n_in %d, out %d, ws %zu)\n", n_in, out_size, ws_size); grid = -1; return; }
        int dev = 0, cus = 0, per_cu = 0;
        hipGetDevice(&dev); hipDeviceGetAttribute(&cus, hipDeviceAttributeMultiprocessorCount, dev);
        if (hipFuncSetAttribute((const void*)fwd_kernel, hipFuncAttributeMaxDynamicSharedMemorySize, LDS_BYTES) != hipSuccess) { fprintf(stderr, "kernel_launch: hipFuncSetAttribute failed\n"); grid = -1; return; }
        if (hipOccupancyMaxActiveBlocksPerMultiprocessor(&per_cu, (const void*)fwd_kernel, NTHR, LDS_BYTES) != hipSuccess || per_cu < 1) { fprintf(stderr, "kernel_launch: occupancy query says %d\n", per_cu); per_cu = 1; }
        (void)hipGetLastError();
        grid = cus * (per_cu > 1 ? 1 : per_cu);
        if (grid <= 0) { grid = -1; return; }
    }
    if (grid < 0) return;
    if (hipMemsetAsync(d_ws, 0, 16384, stream) != hipSuccess) { fprintf(stderr, "kernel_launch: memset failed\n"); return; }
    Args a{};
    for (int i = 0; i < 20; ++i) a.in[i] = (const float*)d_in[i];
    a.out = (float*)d_out; a.ws = (unsigned char*)d_ws;
#if MK_ONE
    a.ph_lo = 0; a.ph_hi = NPHASE;
    void* params[] = {&a};
    hipError_t e = hipLaunchCooperativeKernel((const void*)fwd_kernel, dim3(grid), dim3(NTHR), params, LDS_BYTES, stream);
    if (e != hipSuccess) fprintf(stderr, "cooperative launch failed: %s (grid %d)\n", hipGetErrorString(e), grid);
#else
    for (int ph = 0; ph < NPHASE; ++ph) { a.ph_lo = ph; a.ph_hi = ph + 1; hipLaunchKernelGGL(fwd_kernel, dim3(grid), dim3(NTHR), LDS_BYTES, stream, a); }
#endif
}
```

```cpp
#include <hip/hip_runtime.h>
#include <hip/hip_cooperative_groups.h>
#include <cstdio>
#include <cstdint>
namespace cg = cooperative_groups;
#define MK_ONE 1
namespace pg8 {
#define PG8_LAS __attribute__((address_space(3)))
typedef unsigned short bf16_t;
typedef short bf16x8 __attribute__((ext_vector_type(8)));
typedef float f32x4 __attribute__((ext_vector_type(4)));
typedef unsigned u32x4 __attribute__((ext_vector_type(4)));
constexpr int BM = 256, BK = 64, HALF = 128, HTB = HALF * BK * 2  , STAGE_BYTES = 8 * HTB, NXCD = 8, WGM = 8;

__host__ __device__ __forceinline__ int lds_byte(int r, int c) { const int st = (r >> 4) * 2 + (c >> 5), rr = r & 15, cc = c & 31, ob = rr * 64 + cc * 2; return st * 1024 + (ob ^ (((ob >> 9) & 1) << 5)); }
__host__ __device__ __forceinline__ void stage_rc(int b, int& R, int& C) { const int st = b / 1024, sb = b % 1024, swz = sb ^ (((sb >> 9) & 1) << 5); R = (st >> 1) * 16 + swz / 64; C = (st & 1) * 32 + (swz % 64) / 2; }
__host__ __device__ __forceinline__ int perm32(int rho) { const int n = rho >> 4, i = rho & 15; return 8 * (i >> 2) + 4 * n + (i & 3); }

struct Unit { int pm, pn; };
struct Gemm { const bf16_t* A; const bf16_t* Bt; int M, N, K; };

struct StaticOrder {
    int nM, nN, nwg, G, c;
    __host__ __device__ void init(int M, int N, int G_, int c_) { nM = M / BM; nN = N / BM; nwg = nM * nN; G = G_; c = c_; }
    __host__ __device__ bool next(int i, Unit& u) const {
        const long L = (long)i * G + c; if (L >= nwg) return false;
        int wgid = (int)L; { const int q = nwg / NXCD, r = nwg % NXCD, xcd = wgid % NXCD, off = wgid / NXCD; wgid = (xcd < r ? xcd * (q + 1) : r * (q + 1) + (xcd - r) * q) + off; }
        const int nig = WGM * nN, gid = wgid / nig, fm = gid * WGM, gsz = (nM - fm) < WGM ? (nM - fm) : WGM;
        u.pm = fm + ((wgid % nig) % gsz); u.pn = (wgid % nig) / gsz; return true;
    }
    __device__ __forceinline__ void a_ready(const Unit&) const {}
    __device__ __forceinline__ void done(const Unit&) const {}
};

__device__ __forceinline__ unsigned cvt_pk_bf16(float lo, float hi) { unsigned r; asm volatile("v_cvt_pk_bf16_f32 %0, %1, %2" : "=v"(r) : "v"(lo), "v"(hi)); return r; }
template <class Epi, class Sched, bool ALIGN_EPI = false, bool SP2 = false>
__device__ __forceinline__ void gemm_phase(PG8_LAS unsigned char* lds, const Gemm g, const Sched& S, const Epi& E) {
    const int tid = threadIdx.x, wid = __builtin_amdgcn_readfirstlane(tid >> 6), lane = tid & 63, wr = wid >> 2, wc = wid & 3, fr = lane & 15, fq = lane >> 4;
    const int K = g.K, nt = K / BK;
    unsigned voffA[2], voffB[2];
#pragma unroll
    for (int i = 0; i < 2; ++i) { int R, C; stage_rc(tid * 16 + i * 8192, R, C); const int Rb = Epi::PERM ? ((R & ~31) + perm32(R & 31)) : R;
        voffA[i] = (unsigned)(R * K + C) * 2u; voffB[i] = (unsigned)(Rb * K + C) * 2u; }
    const size_t kstep = (size_t)(BK * 2);
    const size_t hstep = (size_t)HALF * K * 2;
    const size_t tstep = 2 * hstep;
    const unsigned ldsw = (unsigned)wid * 1024u;
    const int aoff = lds_byte(wr * 64 + fr, fq * 8), boff = lds_byte(wc * 32 + fr, fq * 8);
#define PG8_SA(b, h) (((b) * 2 + (h)) * HTB)
#define PG8_SB(b, h) ((4 + (b) * 2 + (h)) * HTB)
#define PG8_STAGE(bufoff, gbase, voff) do { _Pragma("unroll") for (int _i = 0; _i < 2; ++_i) \
        __builtin_amdgcn_global_load_lds((const unsigned*)((const char*)(gbase) + (voff)[_i]), (PG8_LAS unsigned*)(lds + (bufoff) + ldsw + _i * 8192), 16, 0, 0); } while (0)
#define PG8_LDA(dst, b, h) do { _Pragma("unroll") for (int m = 0; m < 4; ++m) _Pragma("unroll") for (int k = 0; k < 2; ++k) dst[m][k] = *(const PG8_LAS bf16x8*)(lds + PG8_SA(b, h) + aoff + m * 2048 + k * 1024); } while (0)
#define PG8_LDB(dst, b, h) do { _Pragma("unroll") for (int n = 0; n < 2; ++n) _Pragma("unroll") for (int k = 0; k < 2; ++k) dst[n][k] = *(const PG8_LAS bf16x8*)(lds + PG8_SB(b, h) + boff + n * 2048 + k * 1024); } while (0)
#define PG8_MMA(ai, bj, At, Bt) do { __builtin_amdgcn_s_setprio(1); _Pragma("unroll") for (int m = 0; m < 4; ++m) _Pragma("unroll") for (int n = 0; n < 2; ++n) _Pragma("unroll") for (int k = 0; k < 2; ++k) \
        acc[ai][bj][m][n] = __builtin_amdgcn_mfma_f32_16x16x32_bf16(Bt[n][k], At[m][k], acc[ai][bj][m][n], 0, 0, 0); __builtin_amdgcn_s_setprio(0); } while (0)
#define PG8_WAIT_V(n) asm volatile("s_waitcnt vmcnt(" #n ")" ::: "memory")
#define PG8_WAIT_L(n) asm volatile("s_waitcnt lgkmcnt(" #n ")" ::: "memory")
#define PG8_BAR __builtin_amdgcn_s_barrier()
#define PG8_SCHED __builtin_amdgcn_sched_barrier(0)
    Unit cur, nxt; int ui = 0;
    if (!S.next(0, cur)) return;
    f32x4 acc[2][2][4][2];
#pragma unroll
    for (int a = 0; a < 2; ++a)
#pragma unroll
        for (int b = 0; b < 2; ++b)
#pragma unroll
            for (int m = 0; m < 4; ++m)
#pragma unroll
                for (int n = 0; n < 2; ++n) acc[a][b][m][n] = (f32x4){0.f, 0.f, 0.f, 0.f};
    bf16x8 At[4][2], B0[2][2], B1[2][2];
    const char* cA = (const char*)g.A + (size_t)cur.pm * tstep; const char* cB = (const char*)g.Bt + (size_t)cur.pn * tstep;
    S.a_ready(cur);
    if constexpr (SP2) {
        PG8_STAGE(PG8_SB(0, 0), cB, voffB); PG8_STAGE(PG8_SB(0, 1), cB + hstep, voffB); PG8_STAGE(PG8_SA(0, 0), cA, voffA); PG8_STAGE(PG8_SA(0, 1), cA + hstep, voffA);
        if (wr == 1) PG8_BAR;
        PG8_WAIT_V(2); PG8_BAR;
        PG8_STAGE(PG8_SB(1, 0), cB + kstep, voffB); PG8_STAGE(PG8_SA(1, 0), cA + kstep, voffA); PG8_STAGE(PG8_SB(1, 1), cB + hstep + kstep, voffB);
        PG8_WAIT_V(6); PG8_BAR;
    } else {
        PG8_STAGE(PG8_SB(0, 0), cB, voffB); PG8_STAGE(PG8_SA(0, 0), cA, voffA); PG8_STAGE(PG8_SB(0, 1), cB + hstep, voffB); PG8_STAGE(PG8_SA(0, 1), cA + hstep, voffA);
        if (wr == 1) PG8_BAR;
        PG8_WAIT_V(4); PG8_BAR;
        PG8_STAGE(PG8_SB(1, 0), cB + kstep, voffB); PG8_STAGE(PG8_SA(1, 0), cA + kstep, voffA); PG8_STAGE(PG8_SB(1, 1), cB + hstep + kstep, voffB);
        PG8_WAIT_V(6); PG8_BAR;
    }
    for (;;) {
        const bool has_next = S.next(ui + 1, nxt);
        const char* nA = has_next ? (const char*)g.A + (size_t)nxt.pm * tstep : cA; const char* nB = has_next ? (const char*)g.Bt + (size_t)nxt.pn * tstep : cB;
        for (int t = 0; t < nt; t += 2) {
            const bool last = (t == nt - 2);
            const char* a1 = cA + (size_t)(t + 1) * kstep;
            const char* a2 = last ? nA : cA + (size_t)(t + 2) * kstep; const char* b2 = last ? nB : cB + (size_t)(t + 2) * kstep;
            const char* a3 = a2 + kstep; const char* b3 = b2 + kstep;
            if (last && has_next) S.a_ready(nxt);
            if constexpr (SP2) {
            PG8_LDB(B0, 0, 0); PG8_LDB(B1, 0, 1); PG8_SCHED; PG8_LDA(At, 0, 0); PG8_STAGE(PG8_SA(1, 1), a1 + hstep, voffA);
            PG8_WAIT_V(8); PG8_WAIT_L(0); PG8_BAR; PG8_MMA(0, 0, At, B0); PG8_MMA(0, 1, At, B1); PG8_BAR; PG8_SCHED;
            PG8_LDA(At, 0, 1); PG8_STAGE(PG8_SB(0, 0), b2, voffB); PG8_STAGE(PG8_SB(0, 1), b2 + hstep, voffB); PG8_STAGE(PG8_SA(0, 0), a2, voffA);
            PG8_WAIT_V(8); PG8_WAIT_L(0); PG8_BAR; PG8_MMA(1, 0, At, B0); PG8_MMA(1, 1, At, B1); PG8_BAR; PG8_SCHED;
            PG8_LDB(B0, 1, 0); PG8_LDB(B1, 1, 1); PG8_SCHED; PG8_LDA(At, 1, 0); PG8_STAGE(PG8_SA(0, 1), a2 + hstep, voffA);
            PG8_WAIT_V(8); PG8_WAIT_L(0); PG8_BAR; PG8_MMA(0, 0, At, B0); PG8_MMA(0, 1, At, B1); PG8_BAR; PG8_SCHED;
            PG8_LDA(At, 1, 1); PG8_STAGE(PG8_SB(1, 0), b3, voffB); PG8_STAGE(PG8_SB(1, 1), b3 + hstep, voffB); PG8_STAGE(PG8_SA(1, 0), a3, voffA);
            PG8_WAIT_V(8); PG8_WAIT_L(0); PG8_BAR; PG8_MMA(1, 0, At, B0); PG8_MMA(1, 1, At, B1); PG8_BAR; PG8_SCHED;
            } else {
            PG8_LDB(B0, 0, 0); PG8_SCHED; PG8_LDA(At, 0, 0); PG8_STAGE(PG8_SA(1, 1), a1 + hstep, voffA);
            PG8_WAIT_L(8); PG8_BAR; PG8_WAIT_L(0); PG8_MMA(0, 0, At, B0); PG8_BAR; PG8_SCHED;
            PG8_LDB(B1, 0, 1); PG8_STAGE(PG8_SB(0, 0), b2, voffB);
            PG8_BAR; PG8_WAIT_L(0); PG8_MMA(0, 1, At, B1); PG8_BAR;
            PG8_LDA(At, 0, 1); PG8_STAGE(PG8_SA(0, 0), a2, voffA);
            PG8_BAR; PG8_WAIT_L(0); PG8_MMA(1, 0, At, B0); PG8_BAR; PG8_SCHED;
            PG8_STAGE(PG8_SB(0, 1), b2 + hstep, voffB);
            PG8_WAIT_V(6); PG8_BAR; PG8_MMA(1, 1, At, B1); PG8_BAR;
            PG8_LDB(B0, 1, 0); PG8_SCHED; PG8_LDA(At, 1, 0); PG8_STAGE(PG8_SA(0, 1), a2 + hstep, voffA);
            PG8_WAIT_L(8); PG8_BAR; PG8_WAIT_L(0); PG8_MMA(0, 0, At, B0); PG8_BAR; PG8_SCHED;
            PG8_LDB(B1, 1, 1); PG8_STAGE(PG8_SB(1, 0), b3, voffB);
            PG8_BAR; PG8_WAIT_L(0); PG8_MMA(0, 1, At, B1); PG8_BAR;
            PG8_LDA(At, 1, 1); PG8_STAGE(PG8_SA(1, 0), a3, voffA);
            PG8_BAR; PG8_WAIT_L(0); PG8_MMA(1, 0, At, B0); PG8_BAR; PG8_SCHED;
            PG8_STAGE(PG8_SB(1, 1), b3 + hstep, voffB);
            PG8_WAIT_V(6); PG8_BAR; PG8_MMA(1, 1, At, B1); PG8_BAR;
            }
        }
        if constexpr (ALIGN_EPI) { if (wr == 0) PG8_BAR; }
        if constexpr (!Epi::AFTER_DRAIN) { E(acc, cur, wr, wc, fr, fq); S.done(cur); }
        if (!has_next) break;
#pragma unroll
        for (int a = 0; a < 2; ++a)
#pragma unroll
            for (int b = 0; b < 2; ++b)
#pragma unroll
                for (int m = 0; m < 4; ++m)
#pragma unroll
                    for (int n = 0; n < 2; ++n) acc[a][b][m][n] = (f32x4){0.f, 0.f, 0.f, 0.f};
        cur = nxt; cA = nA; cB = nB; ++ui;
        if constexpr (ALIGN_EPI) { if (wr == 1) PG8_BAR; }
    }
    PG8_WAIT_V(0);
    if constexpr (!ALIGN_EPI) { if (wr == 0) PG8_BAR; }
    PG8_BAR;
    if constexpr (Epi::AFTER_DRAIN) { E.fused(acc, cur, wr, wc, fr, fq, lds, wid, lane); S.done(cur); }
#undef PG8_SA
#undef PG8_SB
#undef PG8_STAGE
#undef PG8_LDA
#undef PG8_LDB
#undef PG8_MMA
#undef PG8_WAIT_V
#undef PG8_WAIT_L
#undef PG8_BAR
#undef PG8_SCHED
}
}

#ifndef PG8_ALIGN_EPI
#define PG8_ALIGN_EPI true
#endif
#ifndef MK_ONE
#define MK_ONE 1
#endif
#define GAS __attribute__((address_space(1)))
#define LAS __attribute__((address_space(3)))
typedef unsigned short bf16;
typedef short bf16x8 __attribute__((ext_vector_type(8)));
typedef float f32x4 __attribute__((ext_vector_type(4)));
typedef unsigned u32x4 __attribute__((ext_vector_type(4)));
typedef unsigned u32x2 __attribute__((ext_vector_type(2)));

constexpr int NWAVES = 8, NTHR = 512;
constexpr int M = 32768, SEQ = 2048, NB = 16, D = 1024, FF = 4096, PLE = 256;
constexpr int NWIN = 3328, WIN_LD = 5328;
constexpr float LN_EPS = 1e-5f;
constexpr float ALPHA = 1.189207115002721f;
constexpr float IDX_W_SCALE = 0.04419417382415922f;
constexpr float QA_SCALE = 0.125f * 1.4426950408889634f;
constexpr float MLK_SCALE = 0.08838834764831845f;
constexpr int LDS_BYTES = 147456;
constexpr int NPHASE = 12;

constexpr size_t MiB = 1u << 20;
constexpr size_t WS_WIN = 1 * MiB, WS_WGA = 8 * MiB, WS_WGB = 10 * MiB, WS_WUA = 12 * MiB, WS_WUB = 13 * MiB, WS_WOUT = 14 * MiB,
                 WS_WFF1 = 16 * MiB, WS_WFF2 = 24 * MiB, WS_WPG = 32 * MiB, WS_WPP = 34 * MiB;
constexpr size_t WS_COS = 35 * MiB, WS_SIN = 39 * MiB, WS_WI = 43 * MiB, WS_IG = 44 * MiB, WS_LF = 44 * MiB + 512 * 1024;
constexpr size_t WS_KA = 45 * MiB, WS_KI = 49 * MiB, WS_VAT = 53 * MiB;
constexpr size_t WS_BCUM = 57 * MiB, WS_CS = 58 * MiB, WS_MST = 59 * MiB, WS_DN = 60 * MiB, WS_NST = 61 * MiB, WS_CST = 208 * MiB;
constexpr size_t WS_XB = 64 * MiB, WS_PB = 128 * MiB, WS_QA = 144 * MiB, WS_QI = 176 * MiB, WS_MLQK = 208 * MiB, WS_MLV = 272 * MiB,
                 WS_MLO = 304 * MiB, WS_QC = 336 * MiB, WS_DC = 400 * MiB, WS_YA = 464 * MiB, WS_END = 496 * MiB;
constexpr size_t WS_TMP = 336 * MiB, WS_MRG = 400 * MiB, WS_H1 = 64 * MiB, WS_HF = 144 * MiB, WS_RB = 400 * MiB, WS_PROJ = 144 * MiB;

__device__ __forceinline__ unsigned f2bf(float f) { unsigned u = __builtin_bit_cast(unsigned, f); return (u + 0x7fffu + ((u >> 16) & 1u)) >> 16; }
typedef float f32x2_t __attribute__((ext_vector_type(2)));
typedef __bf16 bf16x2_t __attribute__((ext_vector_type(2)));
__device__ __forceinline__ unsigned pk2(float lo, float hi) { f32x2_t v = {lo, hi}; bf16x2_t b = __builtin_convertvector(v, bf16x2_t); return __builtin_bit_cast(unsigned, b); }
__device__ __forceinline__ float bflo(unsigned w) { return __builtin_bit_cast(float, w << 16); }
__device__ __forceinline__ float bfhi(unsigned w) { return __builtin_bit_cast(float, w & 0xffff0000u); }
__device__ __forceinline__ float sigmoidf_(float x) { return __builtin_amdgcn_rcpf(1.0f + __expf(-x)); }
#define LDS_WAIT() asm volatile("s_waitcnt lgkmcnt(0)" ::: "memory")

__constant__ double INVF[32] = {1.0, 0.7498942093324559, 0.5623413251903491, 0.4216965034285822, 0.31622776601683794, 0.23713737056616552, 0.1778279410038923, 0.1333521432163324,
    0.1, 0.07498942093324558, 0.05623413251903491, 0.042169650342858224, 0.03162277660168379, 0.023713737056616554, 0.01778279410038923, 0.01333521432163324,
    0.01, 0.007498942093324558, 0.005623413251903491, 0.004216965034285823, 0.0031622776601683794, 0.0023713737056616554, 0.0017782794100389228, 0.001333521432163324,
    0.001, 0.0007498942093324559, 0.0005623413251903491, 0.00042169650342858224, 0.00031622776601683794, 0.00023713737056616554, 0.00017782794100389227, 0.0001333521432163324};

struct Args {
    const float* in[20]; float* out; unsigned char* ws; int ph_lo, ph_hi;
};
enum { I_X = 0, I_P, I_POS, I_WIN, I_CONVW, I_CONVB, I_BIG, I_BFG, I_MLNG, I_WUA, I_WUB, I_WOUT, I_LN1G, I_LN1B, I_WFF1, I_WFF2, I_WPG, I_WPP, I_LN2G, I_LN2B };

__device__ __forceinline__ int win_src(int n) {
    if (n < 512) { const int hh = n >> 6, j = n & 63; return hh * 64 + (j >> 1) + 32 * (j & 1); }
    if (n < 1024) { const int mm = n - 512, hh = mm >> 6, j = mm & 63; return 640 + hh * 64 + (j >> 1) + 32 * (j & 1); }
    if (n < 1280) { const int mm = n - 1024;
        if (mm < 64) return 512 + (mm >> 1) + 32 * (mm & 1);
        if (mm < 128) { const int j = mm - 64; return 1152 + (j >> 1) + 32 * (j & 1); }
        if (mm < 192) return 576 + (mm - 128);
        if (mm < 200) return 1216 + (mm - 192);
        if (mm < 204) return 2760 + (mm - 200);
        if (mm < 208) return 2764 + (mm - 204);
        return -1; }
    if (n < 2304) return 1224 + (n - 1280);
    if (n < 2816) return 2248 + (n - 2304);
    return 2768 + (n - 2816);
}

template <class SrcF>
__device__ __forceinline__ void transpose_item(const float* W, int K, int ldw, bf16* WT, int Nrows, LAS float* scr, int item, int lane, SrcF src) {
    const int nblk = Nrows / 32, kb = item / nblk, nb = item % nblk, k0 = 64 * kb, n0 = 32 * nb;
    const int sc = src(n0 + (lane & 31));
#pragma unroll 8
    for (int i = 0; i < 32; ++i) { const int kk = 2 * i + (lane >> 5); scr[kk * 33 + (lane & 31)] = sc >= 0 ? W[(size_t)(k0 + kk) * ldw + sc] : 0.f; }
    LDS_WAIT(); asm volatile("" ::: "memory");
    const int c = lane & 7;
#pragma unroll
    for (int j = 0; j < 4; ++j) { const int n = (lane >> 3) + 8 * j; const LAS float* s = scr + (8 * c) * 33 + n;
        u32x4 o; o.x = pk2(s[0 * 33], s[1 * 33]); o.y = pk2(s[2 * 33], s[3 * 33]); o.z = pk2(s[4 * 33], s[5 * 33]); o.w = pk2(s[6 * 33], s[7 * 33]);
        *(u32x4*)(WT + (size_t)(n0 + n) * K + k0 + 8 * c) = o; }
    LDS_WAIT(); asm volatile("" ::: "memory");
}

struct EpiWin {
    static constexpr bool PERM = true, AFTER_DRAIN = false;
    bf16 *QA, *QI, *KA, *KI, *VAT, *MLQK, *MLV, *MLO; float *WI, *IG, *LF; const float *COS, *SIN, *b_ig, *b_fg;
    __device__ __forceinline__ void operator()(const f32x4 (&acc)[2][2][4][2], const pg8::Unit& u, int wr, int wc, int fr, int fq) const {
        const int pn = u.pn, row0 = u.pm * 256 + wr * 64 + fr;
#pragma unroll
        for (int ai = 0; ai < 2; ++ai)
#pragma unroll
            for (int m = 0; m < 4; ++m) { const int r = row0 + ai * 128 + m * 16;
#pragma unroll
                for (int bj = 0; bj < 2; ++bj) { const int cl = bj * 128 + wc * 32 + 8 * fq; f32x4 v0 = acc[ai][bj][m][0], v1 = acc[ai][bj][m][1];
                    const bool rope = (pn < 4) || (pn == 4 && cl < 128);
                    if (rope) {
                        const int i0 = (cl & 63) >> 1;
                        const f32x4 c = *(const f32x4*)(COS + (unsigned)r * 32 + i0), s = *(const f32x4*)(SIN + (unsigned)r * 32 + i0);
                        const float sc = (pn < 2) ? QA_SCALE : 1.0f;
                        f32x4 o0, o1;
                        o0[0] = (v0[0] * c[0] - v0[1] * s[0]) * sc; o0[1] = (v0[1] * c[0] + v0[0] * s[0]) * sc;
                        o0[2] = (v0[2] * c[1] - v0[3] * s[1]) * sc; o0[3] = (v0[3] * c[1] + v0[2] * s[1]) * sc;
                        o1[0] = (v1[0] * c[2] - v1[1] * s[2]) * sc; o1[1] = (v1[1] * c[2] + v1[0] * s[2]) * sc;
                        o1[2] = (v1[2] * c[3] - v1[3] * s[3]) * sc; o1[3] = (v1[3] * c[3] + v1[2] * s[3]) * sc;
                        bf16* dst;
                        if (pn < 2) dst = QA + (unsigned)r * 512 + pn * 256 + cl;
                        else if (pn < 4) dst = QI + (unsigned)r * 512 + (pn - 2) * 256 + cl;
                        else dst = (cl < 64) ? (KA + (unsigned)r * 64 + cl) : (KI + (unsigned)r * 64 + (cl - 64));
                        u32x4 w; w.x = pk2(o0[0], o0[1]); w.y = pk2(o0[2], o0[3]); w.z = pk2(o1[0], o1[1]); w.w = pk2(o1[2], o1[3]);
                        *(u32x4*)dst = w;
                    } else if (pn == 4) {
                        if (cl < 192) { const int d0 = cl - 128, b = r >> 11, t = r & 2047; bf16* base = VAT + ((unsigned)(b * 64 + d0)) * 2048 + t;
#pragma unroll
                            for (int j = 0; j < 4; ++j) { base[(unsigned)j * 2048] = (bf16)f2bf(v0[j]); base[(unsigned)(j + 4) * 2048] = (bf16)f2bf(v1[j]); } }
                        else if (cl == 192) { *(f32x4*)(WI + (unsigned)r * 8) = v0 * IDX_W_SCALE; *(f32x4*)(WI + (unsigned)r * 8 + 4) = v1 * IDX_W_SCALE; }
                        else if (cl == 200) { f32x4 ig, lf;
#pragma unroll
                            for (int j = 0; j < 4; ++j) { ig[j] = v0[j] + b_ig[j]; const float f = v1[j] + b_fg[j]; lf[j] = fminf(f, 0.f) - log1pf(__expf(-fabsf(f))); }
                            *(f32x4*)(IG + (unsigned)r * 4) = ig; *(f32x4*)(LF + (unsigned)r * 4) = lf; }
                    } else {
                        bf16* dst;
                        if (pn < 9) dst = MLQK + (unsigned)r * 1024 + (pn - 5) * 256 + cl;
                        else if (pn < 11) dst = MLV + (unsigned)r * 512 + (pn - 9) * 256 + cl;
                        else { dst = MLO + (unsigned)r * 512 + (pn - 11) * 256 + cl;
#pragma unroll
                            for (int j = 0; j < 4; ++j) { v0[j] = sigmoidf_(v0[j]); v1[j] = sigmoidf_(v1[j]); } }
                        u32x4 w; w.x = pk2(v0[0], v0[1]); w.y = pk2(v0[2], v0[3]); w.z = pk2(v1[0], v1[1]); w.w = pk2(v1[2], v1[3]);
                        *(u32x4*)dst = w;
                    }
                }
                asm volatile("" ::: "memory"); }
    }
};

template <int MODE> struct EpiB {
    static constexpr bool PERM = true, AFTER_DRAIN = false;
    bf16* O; float* OF; const bf16* IB; const float* IF; int ldc;
    __device__ __forceinline__ void operator()(const f32x4 (&acc)[2][2][4][2], const pg8::Unit& u, int wr, int wc, int fr, int fq) const {
        const int row0 = u.pm * 256 + wr * 64 + fr, col0 = u.pn * 256 + wc * 32 + 8 * fq;
#pragma unroll
        for (int ai = 0; ai < 2; ++ai)
#pragma unroll
            for (int m = 0; m < 4; ++m) { const unsigned ro = (unsigned)(row0 + ai * 128 + m * 16) * ldc + col0;
#pragma unroll
                for (int bj = 0; bj < 2; ++bj) { const unsigned off = ro + bj * 128; f32x4 v0 = acc[ai][bj][m][0], v1 = acc[ai][bj][m][1];
                    if (MODE == 0) {
#pragma unroll
                        for (int j = 0; j < 4; ++j) { v0[j] = sigmoidf_(v0[j]); v1[j] = sigmoidf_(v1[j]); }
                    } else if (MODE == 3) {
#pragma unroll
                        for (int j = 0; j < 4; ++j) { const float a = fmaxf(v0[j], 0.f), b = fmaxf(v1[j], 0.f); v0[j] = a * a; v1[j] = b * b; }
                    } else {
                        const u32x4 t = *(const u32x4*)(IB + off);
                        v0[0] *= bflo(t.x); v0[1] *= bfhi(t.x); v0[2] *= bflo(t.y); v0[3] *= bfhi(t.y);
                        v1[0] *= bflo(t.z); v1[1] *= bfhi(t.z); v1[2] *= bflo(t.w); v1[3] *= bfhi(t.w);
                        if (MODE == 2) { v0 += *(const f32x4*)(IF + off); v1 += *(const f32x4*)(IF + off + 4); }
                    }
                    if (MODE == 1) { *(f32x4*)(OF + off) = v0; *(f32x4*)(OF + off + 4) = v1; }
                    else { u32x4 w; w.x = pk2(v0[0], v0[1]); w.y = pk2(v0[2], v0[3]); w.z = pk2(v1[0], v1[1]); w.w = pk2(v1[2], v1[3]); *(u32x4*)(O + off) = w; }
                }
                if (MODE == 1 || MODE == 2) asm volatile("" ::: "memory"); }
    }
};
template <int MODE> struct EpiF {
    static constexpr bool PERM = false, AFTER_DRAIN = false;
    float* OF; bf16* O; const float* IF; const bf16* IB; int ldc;
    __device__ __forceinline__ void operator()(const f32x4 (&acc)[2][2][4][2], const pg8::Unit& u, int wr, int wc, int fr, int fq) const {
        const int row0 = u.pm * 256 + wr * 64 + fr, col0 = u.pn * 256 + wc * 32 + 4 * fq;
#pragma unroll
        for (int ai = 0; ai < 2; ++ai)
#pragma unroll
            for (int m = 0; m < 4; ++m) { const unsigned ro = (unsigned)(row0 + ai * 128 + m * 16) * ldc + col0;
#pragma unroll
                for (int bj = 0; bj < 2; ++bj)
#pragma unroll
                    for (int n = 0; n < 2; ++n) { const unsigned off = ro + bj * 128 + n * 16; f32x4 v = acc[ai][bj][m][n];
                        if (MODE == 0) { v += ALPHA * *(const f32x4*)(IF + off); *(f32x4*)(OF + off) = v; }
                        else if (MODE == 1) { const u32x2 t = *(const u32x2*)(IB + off);
                            v[0] += ALPHA * bflo(t.x); v[1] += ALPHA * bfhi(t.x); v[2] += ALPHA * bflo(t.y); v[3] += ALPHA * bfhi(t.y);
                            *(f32x4*)(OF + off) = v; u32x2 w; w.x = pk2(v[0], v[1]); w.y = pk2(v[2], v[3]); *(u32x2*)(O + off) = w; }
                        else if (MODE == 2) { *(f32x4*)(OF + off) = v; }
                        else { const f32x4 pr = *(const f32x4*)(IF + off); f32x4 r = *(const f32x4*)(OF + off);
#pragma unroll
                            for (int j = 0; j < 4; ++j) r[j] += sigmoidf_(v[j]) * pr[j];
                            *(f32x4*)(OF + off) = r; }
                    }
                if (MODE != 2) asm volatile("" ::: "memory"); }
    }
};

__device__ __forceinline__ float wave_sum(float v) {
#pragma unroll
    for (int o = 1; o < 64; o <<= 1) v += __shfl_xor(v, o);
    return v;
}
__device__ __forceinline__ float wave_max(float v) {
#pragma unroll
    for (int o = 1; o < 64; o <<= 1) v = fmaxf(v, __shfl_xor(v, o));
    return v;
}
#define MFMA16(a, b, c) __builtin_amdgcn_mfma_f32_16x16x32_bf16((a), (b), (c), 0, 0, 0)

template <bool TO_BF16>
__device__ __forceinline__ void ln_row2(const float* x0, const float* x1, const float* gam, const float* bet, float* of0, float* of1, bf16* ob0, bf16* ob1, int lane) {
    const f32x4* xr0 = (const f32x4*)x0 + lane; const f32x4* xr1 = (const f32x4*)x1 + lane;
    f32x4 v[4], u[4]; float s = 0.f, t = 0.f;
#pragma unroll
    for (int j = 0; j < 4; ++j) { v[j] = xr0[64 * j]; u[j] = xr1[64 * j]; }
#pragma unroll
    for (int j = 0; j < 4; ++j) { s += (v[j][0] + v[j][1]) + (v[j][2] + v[j][3]); t += (u[j][0] + u[j][1]) + (u[j][2] + u[j][3]); }
#pragma unroll
    for (int o = 1; o < 64; o <<= 1) { s += __shfl_xor(s, o); t += __shfl_xor(t, o); }
    const float mean0 = s * (1.f / 1024.f), mean1 = t * (1.f / 1024.f); float s2 = 0.f, t2 = 0.f;
#pragma unroll
    for (int j = 0; j < 4; ++j) { v[j] = v[j] - mean0; u[j] = u[j] - mean1;
        s2 += (v[j][0] * v[j][0] + v[j][1] * v[j][1]) + (v[j][2] * v[j][2] + v[j][3] * v[j][3]); t2 += (u[j][0] * u[j][0] + u[j][1] * u[j][1]) + (u[j][2] * u[j][2] + u[j][3] * u[j][3]); }
#pragma unroll
    for (int o = 1; o < 64; o <<= 1) { s2 += __shfl_xor(s2, o); t2 += __shfl_xor(t2, o); }
    const float r0 = 1.f / sqrtf(s2 * (1.f / 1024.f) + LN_EPS), r1 = 1.f / sqrtf(t2 * (1.f / 1024.f) + LN_EPS);
#pragma unroll
    for (int j = 0; j < 4; ++j) { const f32x4 g = ((const f32x4*)gam)[lane + 64 * j], b = ((const f32x4*)bet)[lane + 64 * j]; const f32x4 o0 = v[j] * r0 * g + b, o1 = u[j] * r1 * g + b;
        if (TO_BF16) { u32x2 w; w.x = pk2(o0[0], o0[1]); w.y = pk2(o0[2], o0[3]); ((u32x2*)ob0)[lane + 64 * j] = w; w.x = pk2(o1[0], o1[1]); w.y = pk2(o1[2], o1[3]); ((u32x2*)ob1)[lane + 64 * j] = w; }
        else { ((f32x4*)of0)[lane + 64 * j] = o0; ((f32x4*)of1)[lane + 64 * j] = o1; } }
}

constexpr int SC_LD = 2052;
constexpr int MK_OFF = 16 * SC_LD * 4;
template <int MODE>
__device__ __forceinline__ void mixa_p1sel(const bf16* QI, const bf16* KI, const float* WI, LAS unsigned char* lds, int b, int qt, int mkoff  ) {
    const int tid = threadIdx.x, w = __builtin_amdgcn_readfirstlane(tid >> 6), lane = tid & 63, n = lane & 15, g = lane >> 4;
    const int rowbase = b * SEQ + qt * 16, nk16 = qt + 1;
    LAS float* SC = (LAS float*)lds;
    LAS unsigned long long* MK = (LAS unsigned long long*)(lds + MK_OFF + mkoff);
    const f32x4 zero4 = {0.f, 0.f, 0.f, 0.f};
    {
        bf16x8 qf[8][2];
        const bf16* qrow = QI + (size_t)(rowbase + n) * 512 + 8 * g;
#pragma unroll
        for (int h = 0; h < 8; ++h) { qf[h][0] = *(const bf16x8*)(qrow + h * 64); qf[h][1] = *(const bf16x8*)(qrow + h * 64 + 32); }
        const f32x4 w0 = *(const f32x4*)(WI + (size_t)(rowbase + n) * 8), w1 = *(const f32x4*)(WI + (size_t)(rowbase + n) * 8 + 4);
        const float wv[8] = {w0[0], w0[1], w0[2], w0[3], w1[0], w1[1], w1[2], w1[3]};
        const bf16* kbase = KI + (size_t)(b * SEQ + n) * 64 + 8 * g;
        const int ntw = (nk16 > w) ? ((nk16 - w + 7) >> 3) : 0;
        bf16x8 ka[2][2], kbv[2][2];
#define P1_LOAD(dst, g0) do { _Pragma("unroll") for (int i_ = 0; i_ < 2; ++i_) { int ti_ = (g0) * 2 + i_; ti_ = ti_ < ntw ? ti_ : (ntw - 1); const bf16* p_ = kbase + (size_t)(w + 8 * ti_) * 1024; \
            dst[i_][0] = *(const bf16x8*)p_; dst[i_][1] = *(const bf16x8*)(p_ + 32); } } while (0)
#define P1_COMP(src, g0) do { _Pragma("unroll") for (int i_ = 0; i_ < 2; ++i_) { const int ti_ = (g0) * 2 + i_; if (ti_ < ntw) { const int kt = w + 8 * ti_; f32x4 sc = zero4; \
            _Pragma("unroll") for (int h = 0; h < 8; ++h) { f32x4 a = MFMA16(src[i_][0], qf[h][0], zero4); a = MFMA16(src[i_][1], qf[h][1], a); \
                _Pragma("unroll") for (int i = 0; i < 4; ++i) sc[i] += fmaxf(a[i], 0.f) * wv[h]; } \
            if (kt == qt) { _Pragma("unroll") for (int i = 0; i < 4; ++i) if (4 * g + i > n) sc[i] = -INFINITY; } \
            *(LAS f32x4*)(SC + n * SC_LD + kt * 16 + 4 * g) = sc; } } } while (0)
        if (ntw > 0) {
            const int ng = (ntw + 1) >> 1;
            P1_LOAD(ka, 0);
            for (int g0 = 0; g0 < ng; g0 += 2) {
                if (g0 + 1 < ng) P1_LOAD(kbv, g0 + 1);
                P1_COMP(ka, g0);
                if (g0 + 1 >= ng) break;
                if (g0 + 2 < ng) P1_LOAD(ka, g0 + 2);
                P1_COMP(kbv, g0 + 1);
            }
        }
#undef P1_LOAD
#undef P1_COMP
    }
    __syncthreads();
#ifndef SELREP
#define SELREP 1
#endif
#pragma unroll 1
    for (int qq_ = 0; qq_ < ((MODE & 4) ? 2 * SELREP : 0); ++qq_) { const int qq = qq_ & 1;
        const int nq = 2 * w + qq, t = qt * 16 + nq, Lr = 16 * nk16, nj = (Lr + 63) >> 6;
        unsigned key[32];
#pragma unroll
        for (int j = 0; j < 32; ++j) { const int idx = lane + 64 * j; float v = SC[nq * SC_LD + idx]; v = (idx < Lr) ? v : -INFINITY;
            const unsigned uu = __builtin_bit_cast(unsigned, v); key[j] = (uu & 0x80000000u) ? ~uu : (uu | 0x80000000u); }
        if (t + 1 <= 256) {
            { const int lo = lane * 64; unsigned long long mm = 0ull;
              if (lo + 63 <= t) mm = ~0ull; else if (lo <= t) mm = (2ull << (t - lo)) - 1ull;
              if (lane < 32) MK[nq * 32 + lane] = mm; }
        } else {
#define SEL_CNT(OP, N, TH, OUT) do { _Pragma("unroll") for (int j = 0; j < (N); j += 4) { unsigned long long m0_, m1_, m2_, m3_; \
        asm("v_cmp_" OP "_u32_e64 %0, %4, %8\n\tv_cmp_" OP "_u32_e64 %1, %5, %8\n\tv_cmp_" OP "_u32_e64 %2, %6, %8\n\tv_cmp_" OP "_u32_e64 %3, %7, %8" \
            : "=&s"(m0_), "=&s"(m1_), "=&s"(m2_), "=&s"(m3_) : "v"(key[j]), "v"(key[j + 1]), "v"(key[j + 2]), "v"(key[j + 3]), "v"(TH)); \
        OUT += __builtin_popcountll(m0_) + __builtin_popcountll(m1_) + __builtin_popcountll(m2_) + __builtin_popcountll(m3_); } } while (0)
#define SEL_CNT_NJ(OP, TH, OUT) do { if (nj <= 8) SEL_CNT(OP, 8, TH, OUT); else if (nj <= 16) SEL_CNT(OP, 16, TH, OUT); else if (nj <= 24) SEL_CNT(OP, 24, TH, OUT); else SEL_CNT(OP, 32, TH, OUT); } while (0)
            unsigned T = 0u; bool exact = false;
#pragma unroll 1
            for (int bit = (MODE & 8) ? -1 : 31; bit >= 0; --bit) {
                const unsigned cand = T | (1u << bit); int cnt = 0;
                SEL_CNT_NJ("ge", cand, cnt);
                if (cnt >= 256) { T = cand; if (cnt == 256) { exact = true; break; } }
            }
            int need = 0x7fffffff;
            if (!exact) { int cgt = 0; SEL_CNT_NJ("gt", T, cgt); need = 256 - cgt; }
#undef SEL_CNT
#undef SEL_CNT_NJ
            unsigned wlo = 0u, whi = 0u;
            if (exact) {
#pragma unroll
                for (int j = 0; j < 32; ++j) if (j < nj) { unsigned long long m_; asm("v_cmp_ge_u32_e64 %0, %1, %2" : "=s"(m_) : "v"(key[j]), "v"(T));
                    wlo = (lane == j) ? (unsigned)m_ : wlo; whi = (lane == j) ? (unsigned)(m_ >> 32) : whi; }
            } else {
                int tb = 0; const unsigned long long ltm = (1ull << lane) - 1ull;
#pragma unroll
                for (int j = 0; j < 32; ++j) if (j < nj) { const bool eq = key[j] == T; const unsigned long long eqm = __ballot(eq);
                    const int myrank = tb + __popcll(eqm & ltm);
                    const unsigned long long selm = __ballot(key[j] > T || (eq && myrank < need)); tb += __popcll(eqm);
                    wlo = (lane == j) ? (unsigned)selm : wlo; whi = (lane == j) ? (unsigned)(selm >> 32) : whi; }
            }
            if (lane < 32) MK[nq * 32 + lane] = ((unsigned long long)whi << 32) | wlo;
        }
    }
    __syncthreads();
}

__device__ __forceinline__ void mixa_pass2_pair(const bf16* QA, bf16* YA, const bf16* KA, const bf16* VAT, LAS unsigned char* lds, int b, int qtA, int qtB) {
    const int tid = threadIdx.x, w = __builtin_amdgcn_readfirstlane(tid >> 6), lane = tid & 63, n = lane & 15, g = lane >> 4;
    const int rowA = b * SEQ + qtA * 16, rowB = b * SEQ + qtB * 16;
    const LAS unsigned long long* MKA = (const LAS unsigned long long*)(lds + MK_OFF);
    const LAS unsigned long long* MKB = (const LAS unsigned long long*)(lds + MK_OFF + 4096);
    const f32x4 zero4 = {0.f, 0.f, 0.f, 0.f};
    constexpr int KLD = 72, VLD = 136;
    LAS bf16* KT = (LAS bf16*)lds;
    LAS bf16* VTT = (LAS bf16*)(lds + 2 * 128 * KLD * 2);
    const bf16* qrA = QA + (size_t)(rowA + n) * 512 + w * 64 + 8 * g; const bf16* qrB = QA + (size_t)(rowB + n) * 512 + w * 64 + 8 * g;
    const bf16x8 qA0 = *(const bf16x8*)qrA, qA1 = *(const bf16x8*)(qrA + 32), qB0 = *(const bf16x8*)qrB, qB1 = *(const bf16x8*)(qrB + 32);
    f32x4 oA[4] = {zero4, zero4, zero4, zero4}, oB[4] = {zero4, zero4, zero4, zero4}, sumA = zero4, sumB = zero4; float mA = -1e30f, mB = -1e30f;
    const u32x4 onesw = {0x3f803f80u, 0x3f803f80u, 0x3f803f80u, 0x3f803f80u}; const bf16x8 ones8 = __builtin_bit_cast(bf16x8, onesw);
    const int nTA = (qtA + 8) >> 3, nTB = (qtB + 8) >> 3;
    const int kr0 = tid >> 3, kc = tid & 7, vd0 = tid >> 4, vc = tid & 15;
    const bf16* kg = KA + (size_t)(b * SEQ + kr0) * 64 + kc * 8;
    const bf16* vg = VAT + (size_t)(b * 64 + vd0) * 2048 + vc * 8;
    const int klds = kr0 * KLD + kc * 8, vlds = vd0 * VLD + vc * 8;
#define P2_LOAD(R, T) do { R[0] = *(const u32x4*)(kg + (size_t)(T) * 8192); R[1] = *(const u32x4*)(kg + (size_t)(T) * 8192 + 4096); \
                           R[2] = *(const u32x4*)(vg + (T) * 128); R[3] = *(const u32x4*)(vg + (T) * 128 + 32 * 2048); } while (0)
#define P2_STORE(R, buf) do { *(LAS u32x4*)(KT + (buf) * 128 * KLD + klds) = R[0]; *(LAS u32x4*)(KT + (buf) * 128 * KLD + klds + 64 * KLD) = R[1]; \
                              *(LAS u32x4*)(VTT + (buf) * 64 * VLD + vlds) = R[2]; *(LAS u32x4*)(VTT + (buf) * 64 * VLD + vlds + 32 * VLD) = R[3]; } while (0)
#define P2_SOFT(ST, MKP, T, MR, O, SUM) do { \
        const unsigned long long w0_ = MKP[n * 32 + 2 * (T)] >> (4 * g), w1_ = MKP[n * 32 + 2 * (T) + 1] >> (4 * g); \
        const int wd4_[4] = {(int)(unsigned)w0_, (int)(unsigned)(w0_ >> 32), (int)(unsigned)w1_, (int)(unsigned)(w1_ >> 32)}; \
        float bm_ = ST[0][0]; \
        _Pragma("unroll") for (int c8 = 0; c8 < 8; ++c8) _Pragma("unroll") for (int i = 0; i < 4; ++i) bm_ = fmaxf(bm_, ST[c8][i]); \
        bm_ = fmaxf(bm_, __shfl_xor(bm_, 16)); bm_ = fmaxf(bm_, __shfl_xor(bm_, 32)); \
        const float mn_ = fmaxf(MR, bm_), al_ = __builtin_amdgcn_exp2f(MR - mn_); MR = mn_; \
        _Pragma("unroll") for (int c8 = 0; c8 < 8; ++c8) _Pragma("unroll") for (int i = 0; i < 4; ++i) { const int mk_ = (wd4_[c8 >> 1] << (31 - (16 * (c8 & 1) + i))) >> 31; \
            ST[c8][i] = __builtin_bit_cast(float, __builtin_bit_cast(int, __builtin_amdgcn_exp2f(ST[c8][i] - mn_)) & mk_); } \
        _Pragma("unroll") for (int dt = 0; dt < 4; ++dt) O[dt] = O[dt] * al_; \
        SUM = SUM * al_; } while (0)
#define P2_PACK(ST, kb4) ({ u32x4 pw_; pw_.x = pk2(ST[2 * (kb4)][0], ST[2 * (kb4)][1]); pw_.y = pk2(ST[2 * (kb4)][2], ST[2 * (kb4)][3]); \
        pw_.z = pk2(ST[2 * (kb4) + 1][0], ST[2 * (kb4) + 1][1]); pw_.w = pk2(ST[2 * (kb4) + 1][2], ST[2 * (kb4) + 1][3]); __builtin_bit_cast(bf16x8, pw_); })
#define P2_TILE(T, buf, DUAL) do { \
        const LAS bf16* kt = KT + (buf) * 128 * KLD; const LAS bf16* vt = VTT + (buf) * 64 * VLD; \
        f32x4 sA[8], sB[8]; \
        _Pragma("unroll") for (int c8 = 0; c8 < 8; ++c8) { const LAS bf16* kp = kt + (16 * c8 + n) * KLD + 8 * g; \
            const bf16x8 k0 = *(const LAS bf16x8*)kp, k1 = *(const LAS bf16x8*)(kp + 32); \
            sA[c8] = MFMA16(k0, qA0, zero4); sA[c8] = MFMA16(k1, qA1, sA[c8]); \
            if (DUAL) { sB[c8] = MFMA16(k0, qB0, zero4); sB[c8] = MFMA16(k1, qB1, sB[c8]); } } \
        P2_SOFT(sA, MKA, T, mA, oA, sumA); \
        if (DUAL) P2_SOFT(sB, MKB, T, mB, oB, sumB); \
        _Pragma("unroll") for (int kb4 = 0; kb4 < 4; ++kb4) { \
            const bf16x8 pA = P2_PACK(sA, kb4); bf16x8 pB = pA; if (DUAL) pB = P2_PACK(sB, kb4); \
            sumA = MFMA16(ones8, pA, sumA); if (DUAL) sumB = MFMA16(ones8, pB, sumB); \
            _Pragma("unroll") for (int dt = 0; dt < 4; ++dt) { const LAS bf16* vp = vt + (16 * dt + n) * VLD + 32 * kb4 + 4 * g; \
                const u32x2 lo = *(const LAS u32x2*)vp, hi = *(const LAS u32x2*)(vp + 16); \
                u32x4 vv; vv.x = lo.x; vv.y = lo.y; vv.z = hi.x; vv.w = hi.y; const bf16x8 vb = __builtin_bit_cast(bf16x8, vv); \
                oA[dt] = MFMA16(vb, pA, oA[dt]); if (DUAL) oB[dt] = MFMA16(vb, pB, oB[dt]); } } \
    } while (0)
#define P2_STEP(T, buf) do { if ((T) < nTB) P2_TILE(T, buf, true); else P2_TILE(T, buf, false); } while (0)
    u32x4 rA[4], rB[4];
    P2_LOAD(rA, 0);
    if (nTA > 1) P2_LOAD(rB, 1);
    P2_STORE(rA, 0);
    __syncthreads();
    for (int T0 = 0; T0 < nTA; T0 += 2) {
        if (T0 + 2 < nTA) P2_LOAD(rA, T0 + 2);
        P2_STEP(T0, 0);
        if (T0 + 1 < nTA) P2_STORE(rB, 1);
        __syncthreads();
        if (T0 + 1 >= nTA) break;
        if (T0 + 3 < nTA) P2_LOAD(rB, T0 + 3);
        P2_STEP(T0 + 1, 1);
        if (T0 + 2 < nTA) P2_STORE(rA, 0);
        __syncthreads();
    }
#undef P2_STEP
#undef P2_TILE
#undef P2_PACK
#undef P2_SOFT
#undef P2_LOAD
#undef P2_STORE
    { const float inv = 1.0f / sumA[0]; bf16* orow = YA + (size_t)(rowA + n) * 512 + w * 64 + 4 * g;
#pragma unroll
        for (int dt = 0; dt < 4; ++dt) { u32x2 ww; ww.x = pk2(oA[dt][0] * inv, oA[dt][1] * inv); ww.y = pk2(oA[dt][2] * inv, oA[dt][3] * inv); *(u32x2*)(orow + dt * 16) = ww; } }
    { const float inv = 1.0f / sumB[0]; bf16* orow = YA + (size_t)(rowB + n) * 512 + w * 64 + 4 * g;
#pragma unroll
        for (int dt = 0; dt < 4; ++dt) { u32x2 ww; ww.x = pk2(oB[dt][0] * inv, oB[dt][1] * inv); ww.y = pk2(oB[dt][2] * inv, oB[dt][3] * inv); *(u32x2*)(orow + dt * 16) = ww; } }
    __syncthreads();
}

constexpr int KW_LD = 72;
__device__ __forceinline__ void m1_unit(const bf16* MLQK, const bf16* MLV, const float* IG, const float* LF, const float* conv_w, const float* conv_b,
                                        bf16* QC, bf16* DC, float* DN, float* BCUM, float* CS, LAS unsigned char* lds, int unit) {
    const int c = unit & 31, bh = unit >> 5, h = bh & 3, b = bh >> 2;
    const int tid = threadIdx.x, w = __builtin_amdgcn_readfirstlane(tid >> 6), lane = tid & 63, n = lane & 15, g = lane >> 4;
    const int rowbase = b * SEQ + c * 64;
    LAS float* WK = (LAS float*)lds;
    LAS bf16* KWT = (LAS bf16*)(lds + 1024);
    LAS bf16* VT = (LAS bf16*)(lds + 1024 + 128 * KW_LD * 2);
    if (w == 0) {
        const float lf = LF[(size_t)(rowbase + lane) * 4 + h], ig = IG[(size_t)(rowbase + lane) * 4 + h];
        float bc = lf;
#pragma unroll
        for (int o = 1; o < 64; o <<= 1) { const float tt = __shfl_up(bc, o); if (lane >= o) bc += tt; }
        const float bl = __shfl(bc, 63), gj = bl - bc + ig, mg = wave_max(gj);
        WK[lane] = __expf(gj - mg);
        BCUM[(size_t)(rowbase + lane) * 4 + h] = bc;
        if (lane == 0) { CS[unit * 2] = bl; CS[unit * 2 + 1] = mg; }
    }
    __syncthreads();
    {
        const int isk = (tid >> 4) & 1, cgi = tid & 15, rl = tid >> 5;
        const int ch = isk * 512 + h * 128 + cgi * 8;
        float cw[4][8], cb[8];
#pragma unroll
        for (int j = 0; j < 4; ++j) { const f32x4 a = *(const f32x4*)(conv_w + j * 1024 + ch), bb = *(const f32x4*)(conv_w + j * 1024 + ch + 4);
            cw[j][0] = a[0]; cw[j][1] = a[1]; cw[j][2] = a[2]; cw[j][3] = a[3]; cw[j][4] = bb[0]; cw[j][5] = bb[1]; cw[j][6] = bb[2]; cw[j][7] = bb[3]; }
        { const f32x4 a = *(const f32x4*)(conv_b + ch), bb = *(const f32x4*)(conv_b + ch + 4);
            cb[0] = a[0]; cb[1] = a[1]; cb[2] = a[2]; cb[3] = a[3]; cb[4] = bb[0]; cb[5] = bb[1]; cb[6] = bb[2]; cb[7] = bb[3]; }
        float x[7][8];
#pragma unroll
        for (int rr = 0; rr < 7; ++rr) { const int tl = c * 64 + 4 * rl + rr - 3;
            u32x4 t = {0u, 0u, 0u, 0u};
            if (tl >= 0) t = *(const u32x4*)(MLQK + (size_t)(b * SEQ + tl) * 1024 + ch);
            x[rr][0] = bflo(t.x); x[rr][1] = bfhi(t.x); x[rr][2] = bflo(t.y); x[rr][3] = bfhi(t.y); x[rr][4] = bflo(t.z); x[rr][5] = bfhi(t.z); x[rr][6] = bflo(t.w); x[rr][7] = bfhi(t.w); }
#pragma unroll
        for (int oo = 0; oo < 4; ++oo) { const int jr = 4 * rl + oo; float y[8];
#pragma unroll
            for (int e = 0; e < 8; ++e) { float a = cb[e];
#pragma unroll
                for (int j = 0; j < 4; ++j) a += cw[j][e] * x[oo + j][e];
                a = a * sigmoidf_(a); y[e] = isk ? a * MLK_SCALE : a; }
            u32x4 wv; wv.x = pk2(y[0], y[1]); wv.y = pk2(y[2], y[3]); wv.z = pk2(y[4], y[5]); wv.w = pk2(y[6], y[7]);
            *(u32x4*)(QC + (size_t)(rowbase + jr) * 1024 + ch) = wv;
            if (isk) { const float wk = WK[jr];
#pragma unroll
                for (int e = 0; e < 8; ++e) KWT[(cgi * 8 + e) * KW_LD + jr] = (bf16)f2bf(y[e] * wk); }
        }
#pragma unroll
        for (int q = 0; q < 2; ++q) { const int idx = tid + 512 * q, row = idx >> 4, cgv = idx & 15;
            const u32x4 t = *(const u32x4*)(MLV + (size_t)(rowbase + row) * 512 + h * 128 + cgv * 8);
            LAS bf16* vp = VT + (cgv * 8) * KW_LD + row;
            vp[0 * KW_LD] = (bf16)(t.x & 0xffffu); vp[1 * KW_LD] = (bf16)(t.x >> 16); vp[2 * KW_LD] = (bf16)(t.y & 0xffffu); vp[3 * KW_LD] = (bf16)(t.y >> 16);
            vp[4 * KW_LD] = (bf16)(t.z & 0xffffu); vp[5 * KW_LD] = (bf16)(t.z >> 16); vp[6 * KW_LD] = (bf16)(t.w & 0xffffu); vp[7 * KW_LD] = (bf16)(t.w >> 16); }
    }
    __syncthreads();
    {
        f32x4 acc[8];
#pragma unroll
        for (int et = 0; et < 8; ++et) acc[et] = (f32x4){0.f, 0.f, 0.f, 0.f};
#pragma unroll
        for (int ks = 0; ks < 2; ++ks) { const bf16x8 a = *(const LAS bf16x8*)(KWT + (16 * w + n) * KW_LD + 32 * ks + 8 * g);
#pragma unroll
            for (int et = 0; et < 8; ++et) { const bf16x8 bfr = *(const LAS bf16x8*)(VT + (16 * et + n) * KW_LD + 32 * ks + 8 * g); acc[et] = MFMA16(a, bfr, acc[et]); } }
        bf16* dcu = DC + (size_t)unit * 16384;
#pragma unroll
        for (int et = 0; et < 8; ++et) { u32x2 ww; ww.x = pk2(acc[et][0], acc[et][1]); ww.y = pk2(acc[et][2], acc[et][3]); *(u32x2*)(dcu + (16 * et + n) * 128 + 16 * w + 4 * g) = ww; }
        if (tid < 128) { float s = 0.f;
#pragma unroll 8
            for (int j = 0; j < 64; ++j) s += __builtin_bit_cast(float, (unsigned)KWT[tid * KW_LD + j] << 16);
            DN[(size_t)unit * 128 + tid] = s; }
    }
    __syncthreads();
}

constexpr int CT_LD = 136;
__device__ __forceinline__ void m3_unit(const bf16* QC, const bf16* MLV, bf16* YB, const bf16* MLO, const float* IG, const float* BCUM, const float* MST,
                                        const bf16* DC, const float* DN, const float* gnorm, LAS unsigned char* lds, int unit) {
    const int c = unit & 31, bh = unit >> 5, h = bh & 3, b = bh >> 2;
    const int tid = threadIdx.x, w = __builtin_amdgcn_readfirstlane(tid >> 6), lane = tid & 63, n = lane & 15, g = lane >> 4;
    const int rowbase = b * SEQ + c * 64;
    LAS float* U = (LAS float*)lds; LAS float* R = U + 64; LAS float* WINT = U + 128; LAS float* EMR = U + 192; LAS float* NS = U + 256; LAS float* XCH = U + 384;
    LAS bf16* CT = (LAS bf16*)(lds + 4096);
    LAS bf16* KS = (LAS bf16*)(lds + 4096 + 128 * CT_LD * 2);
    LAS bf16* VT = (LAS bf16*)(lds + 4096 + 128 * CT_LD * 2 + 64 * CT_LD * 2);
    if (w == 0) {
        const float bc = BCUM[(size_t)(rowbase + lane) * 4 + h], ig = IG[(size_t)(rowbase + lane) * 4 + h], mc = MST[unit];
        const float uu = ig - bc; float a = uu;
#pragma unroll
        for (int o = 1; o < 64; o <<= 1) { const float tt = __shfl_up(a, o); if (lane >= o) a = fmaxf(a, tt); }
        const float mrow = bc + fmaxf(a, mc);
        U[lane] = uu; R[lane] = bc - mrow; WINT[lane] = __expf(bc + mc - mrow); EMR[lane] = __expf(-mrow);
    }
    {
        const bf16* dcu = DC + (size_t)unit * 16384;
#pragma unroll
        for (int q = 0; q < 4; ++q) { const int idx = tid + 512 * q, e = idx >> 4, dg = idx & 15; *(LAS u32x4*)(CT + e * CT_LD + dg * 8) = *(const u32x4*)(dcu + idx * 8); }
#pragma unroll
        for (int q = 0; q < 2; ++q) { const int idx = tid + 512 * q, s = idx >> 4, dg = idx & 15;
            *(LAS u32x4*)(KS + s * CT_LD + dg * 8) = *(const u32x4*)(QC + (size_t)(rowbase + s) * 1024 + 512 + h * 128 + dg * 8); }
#pragma unroll
        for (int q = 0; q < 2; ++q) { const int idx = tid + 512 * q, row = idx >> 4, cgv = idx & 15;
            const u32x4 t = *(const u32x4*)(MLV + (size_t)(rowbase + row) * 512 + h * 128 + cgv * 8);
            LAS bf16* vp = VT + (cgv * 8) * KW_LD + row;
            vp[0 * KW_LD] = (bf16)(t.x & 0xffffu); vp[1 * KW_LD] = (bf16)(t.x >> 16); vp[2 * KW_LD] = (bf16)(t.y & 0xffffu); vp[3 * KW_LD] = (bf16)(t.y >> 16);
            vp[4 * KW_LD] = (bf16)(t.z & 0xffffu); vp[5 * KW_LD] = (bf16)(t.z >> 16); vp[6 * KW_LD] = (bf16)(t.w & 0xffffu); vp[7 * KW_LD] = (bf16)(t.w >> 16); }
        if (tid < 128) NS[tid] = DN[(size_t)unit * 128 + tid];
    }
    const int lt = w & 3, eh = w >> 2, l = 16 * lt + n;
    bf16x8 qf[4];
    { const bf16* qrow = QC + (size_t)(rowbase + l) * 1024 + h * 128 + 8 * g;
#pragma unroll
        for (int ks = 0; ks < 4; ++ks) qf[ks] = *(const bf16x8*)(qrow + 32 * ks); }
    __syncthreads();
#ifdef M3_LITE
    {
        const int lt = w & 3, eh = w >> 2, l = 16 * lt + n;
#pragma unroll
        for (int j = 0; j < 4; ++j) { const int e0 = 16 * (4 * eh + j) + 4 * g; float y[4];
#pragma unroll
            for (int i = 0; i < 4; ++i) { const int e = e0 + i;
                y[i] = 0.f;
                if (M3_LITE & 1) y[i] += __builtin_bit_cast(float, (unsigned)CT[e * CT_LD + ((l * 2 + 1) & 127)] << 16);
                if (M3_LITE & 2) y[i] += __builtin_bit_cast(float, (unsigned)KS[l * CT_LD + e] << 16);
                if (M3_LITE & 4) y[i] += __builtin_bit_cast(float, (unsigned)VT[e * KW_LD + l] << 16);
                if (M3_LITE & 8) y[i] += NS[e];
                if (M3_LITE & 16) y[i] += U[l] + R[l];
                if (M3_LITE & 32) y[i] += WINT[l] + EMR[l]; }
            const size_t off = (size_t)(rowbase + l) * 512 + h * 128 + e0;
            u32x2 ww; ww.x = pk2(y[0], y[1]); ww.y = pk2(y[2], y[3]); *(u32x2*)(YB + off) = ww; }
        __syncthreads();
        return;
    }
#endif
    const f32x4 zero4 = {0.f, 0.f, 0.f, 0.f};
    f32x4 sw[4]; const float Rl = R[l], wint = WINT[l], emr = EMR[l];
    float dsum = 0.f;
#pragma unroll
    for (int st = 0; st < 4; ++st) {
        sw[st] = zero4;
        if (st <= lt) { f32x4 acc = zero4;
#pragma unroll
            for (int ks = 0; ks < 4; ++ks) { const bf16x8 a = *(const LAS bf16x8*)(KS + (16 * st + n) * CT_LD + 32 * ks + 8 * g); acc = MFMA16(a, qf[ks], acc); }
#pragma unroll
            for (int i = 0; i < 4; ++i) { const int s = 16 * st + 4 * g + i; const float wgt = (s <= l) ? __expf(U[s] + Rl) : 0.f; sw[st][i] = acc[i] * wgt; dsum += sw[st][i]; } }
    }
    dsum += __shfl_xor(dsum, 16); dsum += __shfl_xor(dsum, 32);
    float qn = 0.f;
#pragma unroll
    for (int ks = 0; ks < 4; ++ks) { const u32x4 qq = __builtin_bit_cast(u32x4, qf[ks]); const LAS float* np = NS + 32 * ks + 8 * g;
        qn += bflo(qq.x) * np[0] + bfhi(qq.x) * np[1] + bflo(qq.y) * np[2] + bfhi(qq.y) * np[3] + bflo(qq.z) * np[4] + bfhi(qq.z) * np[5] + bflo(qq.w) * np[6] + bfhi(qq.w) * np[7]; }
    qn += __shfl_xor(qn, 16); qn += __shfl_xor(qn, 32);
    const float den = wint * qn + dsum;
    const float rden = 1.0f / fmaxf(fabsf(den), emr);
    f32x4 hv[4]; float s1 = 0.f;
#pragma unroll
    for (int j = 0; j < 4; ++j) { const int et = 4 * eh + j;
        f32x4 accS = zero4, accC = zero4;
#pragma unroll
        for (int kb = 0; kb < 2; ++kb) if (2 * kb <= lt) {
            u32x4 pw; pw.x = pk2(sw[2 * kb][0], sw[2 * kb][1]); pw.y = pk2(sw[2 * kb][2], sw[2 * kb][3]); pw.z = pk2(sw[2 * kb + 1][0], sw[2 * kb + 1][1]); pw.w = pk2(sw[2 * kb + 1][2], sw[2 * kb + 1][3]);
            const LAS bf16* vp = VT + (16 * et + n) * KW_LD + 32 * kb + 4 * g;
            const u32x2 lo = *(const LAS u32x2*)vp, hi = *(const LAS u32x2*)(vp + 16);
            u32x4 vv; vv.x = lo.x; vv.y = lo.y; vv.z = hi.x; vv.w = hi.y;
            accS = MFMA16(__builtin_bit_cast(bf16x8, vv), __builtin_bit_cast(bf16x8, pw), accS); }
#pragma unroll
        for (int ks = 0; ks < 4; ++ks) { const bf16x8 a = *(const LAS bf16x8*)(CT + (16 * et + n) * CT_LD + 32 * ks + 8 * g); accC = MFMA16(a, qf[ks], accC); }
#pragma unroll
        for (int i = 0; i < 4; ++i) { hv[j][i] = (wint * accC[i] + accS[i]) * rden; s1 += hv[j][i]; }
    }
    s1 += __shfl_xor(s1, 16); s1 += __shfl_xor(s1, 32);
    const float mloc = s1 * (1.f / 64.f); float q2 = 0.f;
#pragma unroll
    for (int j = 0; j < 4; ++j)
#pragma unroll
        for (int i = 0; i < 4; ++i) { const float dd = hv[j][i] - mloc; q2 += dd * dd; }
    q2 += __shfl_xor(q2, 16); q2 += __shfl_xor(q2, 32);
    if (g == 0) { XCH[(l * 2 + eh) * 2] = mloc; XCH[(l * 2 + eh) * 2 + 1] = q2; }
    __syncthreads();
    {
        const float mo = XCH[(l * 2 + (eh ^ 1)) * 2], qo = XCH[(l * 2 + (eh ^ 1)) * 2 + 1];
        const float mean = 0.5f * (mloc + mo), dm = mloc - mo, m2 = q2 + qo + 32.f * dm * dm;
        const float rstd = 1.0f / sqrtf(m2 * (1.f / 128.f) + LN_EPS);
#pragma unroll
        for (int j = 0; j < 4; ++j) { const int e0 = 16 * (4 * eh + j) + 4 * g;
            const f32x4 gn = *(const f32x4*)(gnorm + h * 128 + e0);
            const size_t off = (size_t)(rowbase + l) * 512 + h * 128 + e0;
            const u32x2 so = *(const u32x2*)(MLO + off);
            const float y0 = (hv[j][0] - mean) * rstd * gn[0] * bflo(so.x), y1 = (hv[j][1] - mean) * rstd * gn[1] * bfhi(so.x);
            const float y2 = (hv[j][2] - mean) * rstd * gn[2] * bflo(so.y), y3 = (hv[j][3] - mean) * rstd * gn[3] * bfhi(so.y);
            u32x2 ww; ww.x = pk2(y0, y1); ww.y = pk2(y2, y3); *(u32x2*)(YB + off) = ww; }
    }
    __syncthreads();
}

#define XB_TMO      128
#define XB_XCNT(j)  (256  + 64 * (j))
#define XB_XSUB(j)  (1280 + 64 * (j))
#define XB_XGEN(j)  (2304 + 64 * (j))
#define XB_TOP      3328
#define XB_TOPGEN   3392
#define XCD_BAR_WORDS 3456
#define XB_SPIN_CAP (1u << 18)

__device__ __forceinline__ unsigned xb_ld(unsigned* p)              { return __hip_atomic_load(p, __ATOMIC_RELAXED, __HIP_MEMORY_SCOPE_AGENT); }
__device__ __forceinline__ unsigned xb_add(unsigned* p, unsigned v) { return __hip_atomic_fetch_add(p, v, __ATOMIC_RELAXED, __HIP_MEMORY_SCOPE_AGENT); }
__device__ __forceinline__ unsigned xb_xcc_id() { return (unsigned)__builtin_amdgcn_s_getreg((3 << 11) | 20) & 0xFu; }
#define XB_SPIN(cond, bar) do { unsigned _sp = 0; while (cond) { __builtin_amdgcn_s_sleep(1); \
    if ((++_sp & 255u) == 0u) { if (xb_ld(&(bar)[XB_TMO])) break; if (_sp > XB_SPIN_CAP) { atomicAdd(&(bar)[XB_TMO], 1u); break; } } } } while (0)

struct XcdBarrier {
    unsigned* bar; unsigned x;
    volatile LAS unsigned* st;
};

__device__ __forceinline__ XcdBarrier xcd_barrier_post(unsigned* bar, volatile LAS unsigned* st) {
    XcdBarrier b; b.bar = bar; b.x = xb_xcc_id(); b.st = st;
    if (threadIdx.x == 0) (void)xb_add(&bar[XB_XCNT(b.x)], 1u);
    return b;
}
__device__ __forceinline__ void xcd_barrier_complete(unsigned* bar, unsigned x, unsigned& nloc, unsigned& nx) {
    const unsigned G = gridDim.x * gridDim.y * gridDim.z;
    unsigned sum, cnt, mine, sp = 0u;
    for (;;) {
        sum = 0u; cnt = 0u; mine = 0u;
#pragma unroll
        for (unsigned j = 0; j < 16; ++j) { const unsigned c = xb_ld(&bar[XB_XCNT(j)]); sum += c; cnt += (c > 0u) ? 1u : 0u; mine = (j == x) ? c : mine; }
        if (sum == G) break;
        __builtin_amdgcn_s_sleep(1);
        if ((++sp & 255u) == 0u) { if (xb_ld(&bar[XB_TMO])) break; if (sp > XB_SPIN_CAP) { atomicAdd(&bar[XB_TMO], 1u); break; } }
    }
    nloc = mine > 0u ? mine : 1u; nx = cnt > 0u ? cnt : 1u;
}

__device__ __forceinline__ void xcd_barrier(const XcdBarrier& b) {
    asm volatile("s_waitcnt vmcnt(0)" ::: "memory");
    __syncthreads();
    if (threadIdx.x == 0) {
        unsigned* bar = b.bar;
        __builtin_amdgcn_s_waitcnt(0);
        unsigned nloc = b.st[0], nx = b.st[1];
        if (nloc == 0u) { xcd_barrier_complete(bar, b.x, nloc, nx); b.st[0] = nloc; b.st[1] = nx; }
        const unsigned old = xb_add(&bar[XB_XSUB(b.x)], 1u);
        const unsigned gen = old / nloc;
        if (old + 1u == (gen + 1u) * nloc) {
            __builtin_amdgcn_fence(__ATOMIC_RELEASE, "agent");
            asm volatile("s_waitcnt vmcnt(0)" ::: "memory");
            const unsigned og = xb_add(&bar[XB_TOP], 1u);
            const unsigned tg = og / nx;
            if (og + 1u == (tg + 1u) * nx) xb_add(&bar[XB_TOPGEN], 1u);
            else XB_SPIN(xb_ld(&bar[XB_TOPGEN]) == tg, bar);
            __builtin_amdgcn_fence(__ATOMIC_ACQUIRE, "agent");
            xb_add(&bar[XB_XGEN(b.x)], 1u);
            asm volatile("s_waitcnt vmcnt(0)" ::: "memory");
        } else {
            XB_SPIN(xb_ld(&bar[XB_XGEN(b.x)]) == gen, bar);
            __builtin_amdgcn_fence(__ATOMIC_ACQUIRE, "agent");
            asm volatile("s_waitcnt vmcnt(0)" ::: "memory");
        }
    }
    __syncthreads();
}

__global__ void __launch_bounds__(NTHR, 2) fwd_kernel(Args args) {
    extern __shared__ __attribute__((aligned(16))) unsigned char lds_raw[];
    LAS unsigned char* lds = (LAS unsigned char*)lds_raw;
    cg::grid_group grid = cg::this_grid();
    const int tid = threadIdx.x, lane = tid & 63, wave = __builtin_amdgcn_readfirstlane(tid >> 6);
    const int G = gridDim.x, bx = blockIdx.x;
    const int gw = bx * NWAVES + wave, NGW = G * NWAVES;
    const int gt = bx * NTHR + tid, NGT = G * NTHR;
    unsigned char* ws = args.ws;
    const int lo = args.ph_lo, hi = args.ph_hi;
#ifndef GEMM_REP
#define GEMM_REP 1
#endif
#ifndef PH_MASK
#define PH_MASK 0xfff
#endif
#define IN(k) (((PH_MASK >> (k)) & 1) && lo <= (k) && (k) < hi)
#define SEAM(k) do { if (IN(k) && IN((k) + 1)) { xcd_barrier(xbar); } } while (0)
    volatile LAS unsigned* xst = (volatile LAS unsigned*)(lds + LDS_BYTES - 64);
    if (tid < 2) xst[tid] = 0u;
    __syncthreads();
    XcdBarrier xbar = xcd_barrier_post((unsigned*)ws, xst);
    if (lo == 0 && hi == NPHASE) grid.sync();
    float* OUT = (float*)(GAS float*)args.out;
#define INP(k) ((const float*)(const GAS float*)args.in[k])
#define PHASE_PTRS() unsigned char* wsb0 = ws; asm volatile("" : "+s"(wsb0)); GAS unsigned char* wsb = (GAS unsigned char*)wsb0; \
    bf16* WinT = (bf16*)(wsb + WS_WIN); bf16* WgaT = (bf16*)(wsb + WS_WGA); bf16* WgbT = (bf16*)(wsb + WS_WGB); bf16* WuaT = (bf16*)(wsb + WS_WUA); bf16* WubT = (bf16*)(wsb + WS_WUB); \
    bf16* WoutT = (bf16*)(wsb + WS_WOUT); bf16* Wff1T = (bf16*)(wsb + WS_WFF1); bf16* Wff2T = (bf16*)(wsb + WS_WFF2); bf16* WpgT = (bf16*)(wsb + WS_WPG); bf16* WppT = (bf16*)(wsb + WS_WPP); \
    float* COS = (float*)(wsb + WS_COS); float* SIN = (float*)(wsb + WS_SIN); float* WI = (float*)(wsb + WS_WI); float* IG = (float*)(wsb + WS_IG); float* LF = (float*)(wsb + WS_LF); \
    bf16* KA = (bf16*)(wsb + WS_KA); bf16* KI = (bf16*)(wsb + WS_KI); bf16* VAT = (bf16*)(wsb + WS_VAT); \
    float* BCUM = (float*)(wsb + WS_BCUM); float* CS = (float*)(wsb + WS_CS); float* MST = (float*)(wsb + WS_MST); float* DN = (float*)(wsb + WS_DN); \
    bf16* XB = (bf16*)(wsb + WS_XB); bf16* PB = (bf16*)(wsb + WS_PB); bf16* QA = (bf16*)(wsb + WS_QA); bf16* QI = (bf16*)(wsb + WS_QI); bf16* MLQK = (bf16*)(wsb + WS_MLQK); \
    bf16* MLV = (bf16*)(wsb + WS_MLV); bf16* MLO = (bf16*)(wsb + WS_MLO); bf16* QC = (bf16*)(wsb + WS_QC); bf16* DC = (bf16*)(wsb + WS_DC); \
    bf16* TMP = (bf16*)(wsb + WS_TMP); bf16* MRG = (bf16*)(wsb + WS_MRG); bf16* H1 = (bf16*)(wsb + WS_H1); bf16* HF = (bf16*)(wsb + WS_HF); bf16* RB = (bf16*)(wsb + WS_RB); \
    float* PROJ = (float*)(wsb + WS_PROJ); bf16* YA = (bf16*)(wsb + WS_YA); (void)YA; bf16* CST = (bf16*)(wsb + WS_CST); float* NST = (float*)(wsb + WS_NST); (void)CST; (void)NST; \
    (void)WinT; (void)WgaT; (void)WgbT; (void)WuaT; (void)WubT; (void)WoutT; (void)Wff1T; (void)Wff2T; (void)WpgT; (void)WppT; (void)COS; (void)SIN; (void)WI; (void)IG; (void)LF; (void)KA; (void)KI; (void)VAT; \
    (void)BCUM; (void)CS; (void)MST; (void)DN; (void)XB; (void)PB; (void)QA; (void)QI; (void)MLQK; (void)MLV; (void)MLO; (void)QC; (void)DC; (void)TMP; (void)MRG; (void)H1; (void)HF; (void)RB; (void)PROJ
#define LAUNDER_I(v) asm volatile("" : "+s"(v))

#ifndef REP0
#define REP0 1
#endif
    if (IN(0)) for (int r0_ = 0; r0_ < REP0; ++r0_) { PHASE_PTRS();
        LAS float* scr = (LAS float*)(lds + wave * 16384);
        const float* w_in = INP(I_WIN); const float* x = INP(I_X);
        constexpr int I_A = 16 * (NWIN / 32), I_G = 16 * 32, I_U = 8 * 32, I_O = 16 * 32, I_1 = 16 * 128, I_2 = 64 * 32, I_PG = 16 * 32, I_PP = 4 * 32;
        constexpr int NITEMS = I_A + 2 * I_G + 2 * I_U + I_O + I_1 + I_2 + I_PG + I_PP;
        for (int it = gw; it < NITEMS; it += NGW) {
            int r = it;
            if (r < I_A) { transpose_item(w_in, 1024, WIN_LD, WinT, NWIN, scr, r, lane, [](int n) { return win_src(n); }); continue; } r -= I_A;
            if (r < I_G) { transpose_item(w_in, 1024, WIN_LD, WgaT, 1024, scr, r, lane, [](int n) { return 3280 + n; }); continue; } r -= I_G;
            if (r < I_G) { transpose_item(w_in, 1024, WIN_LD, WgbT, 1024, scr, r, lane, [](int n) { return 4304 + n; }); continue; } r -= I_G;
            if (r < I_U) { transpose_item(INP(I_WUA), 512, 1024, WuaT, 1024, scr, r, lane, [](int n) { return n; }); continue; } r -= I_U;
            if (r < I_U) { transpose_item(INP(I_WUB), 512, 1024, WubT, 1024, scr, r, lane, [](int n) { return n; }); continue; } r -= I_U;
            if (r < I_O) { transpose_item(INP(I_WOUT), 1024, 1024, WoutT, 1024, scr, r, lane, [](int n) { return n; }); continue; } r -= I_O;
            if (r < I_1) { transpose_item(INP(I_WFF1), 1024, 4096, Wff1T, 4096, scr, r, lane, [](int n) { return n; }); continue; } r -= I_1;
            if (r < I_2) { transpose_item(INP(I_WFF2), 4096, 1024, Wff2T, 1024, scr, r, lane, [](int n) { return n; }); continue; } r -= I_2;
            if (r < I_PG) { transpose_item(INP(I_WPG), 1024, 1024, WpgT, 1024, scr, r, lane, [](int n) { return n; }); continue; } r -= I_PG;
            transpose_item(INP(I_WPP), 256, 1024, WppT, 1024, scr, r, lane, [](int n) { return n; });
        }
        { const f32x4* xs = (const f32x4*)x; u32x4* xd = (u32x4*)XB;
            for (int i = gt; i < M * D / 8; i += 4 * NGT) { f32x4 a[4], b[4];
#pragma unroll
                for (int k = 0; k < 4; ++k) { a[k] = xs[2 * (i + k * NGT)]; b[k] = xs[2 * (i + k * NGT) + 1]; }
#pragma unroll
                for (int k = 0; k < 4; ++k) { u32x4 o; o.x = pk2(a[k][0], a[k][1]); o.y = pk2(a[k][2], a[k][3]); o.z = pk2(b[k][0], b[k][1]); o.w = pk2(b[k][2], b[k][3]); xd[i + k * NGT] = o; } } }
        { const f32x4* ps = (const f32x4*)INP(I_P); u32x4* pd = (u32x4*)PB;
            for (int i = gt; i < M * PLE / 8; i += 4 * NGT) { f32x4 a[4], b[4];
#pragma unroll
                for (int k = 0; k < 4; ++k) { a[k] = ps[2 * (i + k * NGT)]; b[k] = ps[2 * (i + k * NGT) + 1]; }
#pragma unroll
                for (int k = 0; k < 4; ++k) { u32x4 o; o.x = pk2(a[k][0], a[k][1]); o.y = pk2(a[k][2], a[k][3]); o.z = pk2(b[k][0], b[k][1]); o.w = pk2(b[k][2], b[k][3]); pd[i + k * NGT] = o; } } }
        { const int* pos = (const int*)INP(I_POS);
            for (int i = gt; i < M * 32; i += NGT) { const int m = i >> 5, f = i & 31; const double a = (double)pos[m] * INVF[f] * 0.15915494309189535;
                const float rev = (float)(a - floor(a)); COS[i] = __builtin_amdgcn_cosf(rev); SIN[i] = __builtin_amdgcn_sinf(rev); } }
    }
    SEAM(0);
#ifndef REP1
#define REP1 1
#endif
    if (IN(1)) for (int r1_ = 0; r1_ < REP1; ++r1_) { PHASE_PTRS();
        int Kv = D; LAUNDER_I(Kv); pg8::Gemm gm{XB, WinT, M, NWIN, Kv}; pg8::StaticOrder S; S.init(M, NWIN, G, bx);
        EpiWin E{QA, QI, KA, KI, VAT, MLQK, MLV, MLO, WI, IG, LF, COS, SIN, INP(I_BIG), INP(I_BFG)};
        pg8::gemm_phase<EpiWin, pg8::StaticOrder, PG8_ALIGN_EPI, true>(lds, gm, S, E);
    }
#ifdef DUP1
    SEAM(1);
#ifndef REP1
#define REP1 1
#endif
    if (IN(1)) for (int r1_ = 0; r1_ < REP1; ++r1_) { PHASE_PTRS();
        int Kv = D; LAUNDER_I(Kv); pg8::Gemm gm{XB, WinT, M, NWIN, Kv}; pg8::StaticOrder S; S.init(M, NWIN, G, bx);
        EpiWin E{QA, QI, KA, KI, VAT, MLQK, MLV, MLO, WI, IG, LF, COS, SIN, INP(I_BIG), INP(I_BFG)};
        pg8::gemm_phase<EpiWin, pg8::StaticOrder, PG8_ALIGN_EPI, true>(lds, gm, S, E);
    }
#endif
    SEAM(1);
    if (IN(2)) { PHASE_PTRS();
#ifdef NO_MIXA
        for (int i = gt; i < M * 512 / 8; i += NGT) ((u32x4*)YA)[i] = (u32x4){0u, 0u, 0u, 0u};
#else
        for (int pr = bx; pr < NB * 64; pr += G) { const int b = pr >> 6, j = pr & 63;
            mixa_p1sel<7>(QI, KI, WI, lds, b, 127 - j, 0);
            mixa_p1sel<7>(QI, KI, WI, lds, b, j, 4096);
            mixa_pass2_pair(QA, YA, KA, VAT, lds, b, 127 - j, j); }
#endif
        for (int u = bx; u < 2048; u += G) m1_unit(MLQK, MLV, IG, LF, INP(I_CONVW), INP(I_CONVB), QC, DC, DN, BCUM, CS, lds, u);
    }
    SEAM(2);
#ifndef REP3
#define REP3 1
#endif
    if (IN(3)) for (int r3_ = 0; r3_ < REP3; ++r3_) { PHASE_PTRS();
        for (int item = gt; item < 64 * 2048; item += NGT) { const int bh = item >> 11, rem = item & 2047;
            float st[8] = {0.f, 0.f, 0.f, 0.f, 0.f, 0.f, 0.f, 0.f}; float m = 0.f;
            const bf16* src = DC + (size_t)(bh * 32) * 16384 + rem * 8; bf16* dst = CST + (size_t)(bh * 32) * 16384 + rem * 8;
#pragma unroll 1
            for (int c0 = 0; c0 < 32; c0 += 8) { u32x4 dv[8]; float bl[8], mg[8];
#pragma unroll
                for (int k = 0; k < 8; ++k) { dv[k] = *(const u32x4*)(src + (size_t)(c0 + k) * 16384); bl[k] = CS[(bh * 32 + c0 + k) * 2]; mg[k] = CS[(bh * 32 + c0 + k) * 2 + 1]; }
#pragma unroll
                for (int k = 0; k < 8; ++k) { const float mn = fmaxf(bl[k] + m, mg[k]), a = __expf(bl[k] + m - mn), sg = __expf(mg[k] - mn); m = mn; const u32x4 d = dv[k];
                    u32x4 o; o.x = pk2(st[0], st[1]); o.y = pk2(st[2], st[3]); o.z = pk2(st[4], st[5]); o.w = pk2(st[6], st[7]); *(u32x4*)(dst + (size_t)(c0 + k) * 16384) = o;
                    st[0] = a * st[0] + sg * bflo(d.x); st[1] = a * st[1] + sg * bfhi(d.x); st[2] = a * st[2] + sg * bflo(d.y); st[3] = a * st[3] + sg * bfhi(d.y);
                    st[4] = a * st[4] + sg * bflo(d.z); st[5] = a * st[5] + sg * bfhi(d.z); st[6] = a * st[6] + sg * bflo(d.w); st[7] = a * st[7] + sg * bfhi(d.w); } } }
        for (int item = gt; item < 64 * 128; item += NGT) { const int bh = item >> 7, dd = item & 127; float st = 0.f, m = 0.f;
            for (int c = 0; c < 32; ++c) { const float bl = CS[(bh * 32 + c) * 2], mg = CS[(bh * 32 + c) * 2 + 1];
                if (dd == 0) MST[bh * 32 + c] = m;
                const float mn = fmaxf(bl + m, mg), a = __expf(bl + m - mn), s = __expf(mg - mn); m = mn;
                const float d = DN[(size_t)(bh * 32 + c) * 128 + dd]; NST[(size_t)(bh * 32 + c) * 128 + dd] = st; st = a * st + s * d; } }
    }
    SEAM(3);
#ifndef REP4
#define REP4 1
#endif
    if (IN(4)) for (int r4_ = 0; r4_ < REP4; ++r4_) { PHASE_PTRS();
        for (int u = bx; u < 2048; u += G) m3_unit(QC, MLV, QI  , MLO, IG, BCUM, MST, CST, NST, INP(I_MLNG), lds, u);
    }
    SEAM(4);
#ifndef REP5
#define REP5 1
#endif
    if (IN(5)) for (int r5_ = 0; r5_ < REP5; ++r5_) { PHASE_PTRS();
        pg8::StaticOrder S; S.init(M, D, G, bx);
        { int Kv = D; LAUNDER_I(Kv); pg8::Gemm gm{XB, WgaT, M, D, Kv}; EpiB<0> E{TMP, nullptr, nullptr, nullptr, D}; pg8::gemm_phase<EpiB<0>, pg8::StaticOrder, PG8_ALIGN_EPI, true>(lds, gm, S, E); }
        { int Kv = 512; LAUNDER_I(Kv); pg8::Gemm gm{YA, WuaT, M, D, Kv}; EpiB<1> E{nullptr, OUT, TMP, nullptr, D}; pg8::gemm_phase<EpiB<1>, pg8::StaticOrder, PG8_ALIGN_EPI, true>(lds, gm, S, E); }
        { int Kv = D; LAUNDER_I(Kv); pg8::Gemm gm{XB, WgbT, M, D, Kv}; EpiB<0> E{TMP, nullptr, nullptr, nullptr, D}; pg8::gemm_phase<EpiB<0>, pg8::StaticOrder, PG8_ALIGN_EPI, true>(lds, gm, S, E); }
        { int Kv = 512; LAUNDER_I(Kv); pg8::Gemm gm{QI, WubT, M, D, Kv}; EpiB<2> E{MRG, nullptr, TMP, OUT, D}; pg8::gemm_phase<EpiB<2>, pg8::StaticOrder, PG8_ALIGN_EPI, true>(lds, gm, S, E); }
    }
    SEAM(5);
#ifndef REP6
#define REP6 1
#endif
    if (IN(6)) for (int r6_ = 0; r6_ < REP6; ++r6_) { PHASE_PTRS();
        pg8::StaticOrder S; S.init(M, D, G, bx);
        int Kv = D; LAUNDER_I(Kv); pg8::Gemm gm{MRG, WoutT, M, D, Kv}; EpiF<0> E{OUT, nullptr, INP(I_X), nullptr, D}; pg8::gemm_phase<EpiF<0>, pg8::StaticOrder, PG8_ALIGN_EPI, true>(lds, gm, S, E);
    }
    SEAM(6);
#ifndef REP7
#define REP7 1
#endif
    if (IN(7)) for (int r7_ = 0; r7_ < REP7; ++r7_) { PHASE_PTRS(); for (int m = gw; m < M / 2; m += NGW) ln_row2<true>(OUT + (size_t)m * D, OUT + (size_t)(m + M / 2) * D, INP(I_LN1G), INP(I_LN1B), nullptr, nullptr, H1 + (size_t)m * D, H1 + (size_t)(m + M / 2) * D, lane); }
    SEAM(7);
    if (IN(8)) { PHASE_PTRS();
        pg8::StaticOrder S; S.init(M, FF, G, bx);
        int Kv = D; LAUNDER_I(Kv); pg8::Gemm gm{H1, Wff1T, M, FF, Kv}; EpiB<3> E{HF, nullptr, nullptr, nullptr, FF}; pg8::gemm_phase<EpiB<3>, pg8::StaticOrder, PG8_ALIGN_EPI, true>(lds, gm, S, E);
    }
#ifdef DUP89
    SEAM(8);
    if (IN(8) && true) { PHASE_PTRS();
        pg8::StaticOrder S; S.init(M, FF, G, bx);
        int Kv = D; LAUNDER_I(Kv); pg8::Gemm gm{H1, Wff1T, M, FF, Kv}; EpiB<3> E{HF, nullptr, nullptr, nullptr, FF}; pg8::gemm_phase<EpiB<3>, pg8::StaticOrder, PG8_ALIGN_EPI, true>(lds, gm, S, E);
    }
#endif
    SEAM(8);
    if (IN(9)) { PHASE_PTRS();
        pg8::StaticOrder S; S.init(M, D, G, bx);
        int Kv = FF; LAUNDER_I(Kv); pg8::Gemm gm{HF, Wff2T, M, D, Kv}; EpiF<1> E{OUT, RB, nullptr, H1, D}; pg8::gemm_phase<EpiF<1>, pg8::StaticOrder, PG8_ALIGN_EPI, true>(lds, gm, S, E);
    }
#ifdef DUP89
    SEAM(9);
    if (IN(9) && true) { PHASE_PTRS();
        pg8::StaticOrder S; S.init(M, D, G, bx);
        int Kv = FF; LAUNDER_I(Kv); pg8::Gemm gm{HF, Wff2T, M, D, Kv}; EpiF<1> E{OUT, RB, nullptr, H1, D}; pg8::gemm_phase<EpiF<1>, pg8::StaticOrder, PG8_ALIGN_EPI, true>(lds, gm, S, E);
    }
#endif
    SEAM(9);
    if (IN(10)) { PHASE_PTRS();
        pg8::StaticOrder S; S.init(M, D, G, bx);
#if !defined(P10_ONLY) || P10_ONLY == 1
        { int Kv = PLE; LAUNDER_I(Kv); pg8::Gemm gm{PB, WppT, M, D, Kv}; EpiF<2> E{PROJ, nullptr, nullptr, nullptr, D}; pg8::gemm_phase<EpiF<2>, pg8::StaticOrder, PG8_ALIGN_EPI, true>(lds, gm, S, E); }
#endif
#if !defined(P10_ONLY) || P10_ONLY == 2
        { int Kv = D; LAUNDER_I(Kv); pg8::Gemm gm{RB, WpgT, M, D, Kv}; EpiF<3> E{OUT, nullptr, PROJ, nullptr, D}; pg8::gemm_phase<EpiF<3>, pg8::StaticOrder, PG8_ALIGN_EPI, true>(lds, gm, S, E); }
#endif
    }
    SEAM(10);
    if (IN(11)) { PHASE_PTRS(); for (int m = gw; m < M / 2; m += NGW) ln_row2<false>(OUT + (size_t)m * D, OUT + (size_t)(m + M / 2) * D, INP(I_LN2G), INP(I_LN2B), OUT + (size_t)m * D, OUT + (size_t)(m + M / 2) * D, nullptr, nullptr, lane); }
#undef IN
#undef SEAM
}

extern "C" void kernel_launch(void* const* d_in, const int* in_sizes, int n_in, void* d_out, int out_size, void* d_ws, size_t ws_size, hipStream_t stream) {
    static int grid = 0;
    if (grid == 0) {
        if (n_in != 20 || out_size != M * D || ws_size < WS_END) { fprintf(stderr, "kernel_launch: unexpected problem shape (n_in %d, out %d, ws %zu)\n", n_in, out_size, ws_size); grid = -1; return; }
        int dev = 0, cus = 0, per_cu = 0;
        hipGetDevice(&dev); hipDeviceGetAttribute(&cus, hipDeviceAttributeMultiprocessorCount, dev);
        if (hipFuncSetAttribute((const void*)fwd_kernel, hipFuncAttributeMaxDynamicSharedMemorySize, LDS_BYTES) != hipSuccess) { fprintf(stderr, "kernel_launch: hipFuncSetAttribute failed\n"); grid = -1; return; }
        if (hipOccupancyMaxActiveBlocksPerMultiprocessor(&per_cu, (const void*)fwd_kernel, NTHR, LDS_BYTES) != hipSuccess || per_cu < 1) { fprintf(stderr, "kernel_launch: occupancy query says %d\n", per_cu); per_cu = 1; }
        (void)hipGetLastError();
        grid = cus * (per_cu > 1 ? 1 : per_cu);
        if (grid <= 0) { grid = -1; return; }
    }
    if (grid < 0) return;
    if (hipMemsetAsync(d_ws, 0, 16384, stream) != hipSuccess) { fprintf(stderr, "kernel_launch: memset failed\n"); return; }
    Args a{};
    for (int i = 0; i < 20; ++i) a.in[i] = (const float*)d_in[i];
    a.out = (float*)d_out; a.ws = (unsigned char*)d_ws;
#if MK_ONE
    a.ph_lo = 0; a.ph_hi = NPHASE;
    void* params[] = {&a};
    hipError_t e = hipLaunchCooperativeKernel((const void*)fwd_kernel, dim3(grid), dim3(NTHR), params, LDS_BYTES, stream);
    if (e != hipSuccess) fprintf(stderr, "cooperative launch failed: %s (grid %d)\n", hipGetErrorString(e), grid);
#else
    for (int ph = 0; ph < NPHASE; ++ph) { a.ph_lo = ph; a.ph_hi = ph + 1; hipLaunchKernelGGL(fwd_kernel, dim3(grid), dim3(NTHR), LDS_BYTES, stream, a); }
#endif
}
```
